# Optimizing an MI355X kernel written in HIP

```python
import jax
import jax.numpy as jnp
from jax import lax
import numpy as np

D_MODEL = 1024
BATCH = 16
SEQ = 2048
DEPTH = 1

HEAD_DIM = 64
FOX_HEADS = 8
RWKV_HEADS = 8
FOX_WIDTH = FOX_HEADS * HEAD_DIM
RWKV_WIDTH = RWKV_HEADS * HEAD_DIM
MIX_WIDTH = FOX_WIDTH + RWKV_WIDTH
DECAY_LORA = 64
A_LORA = 64
GATE_LORA = 160
D_FF = ((8 * D_MODEL + 3 * 256 - 1) // (3 * 256)) * 256
Q_BLOCK = 128
RMS_EPS = 1e-6
GN_EPS = 64e-5
L2_EPS = 1e-12

FOX_SIZES = (FOX_WIDTH, FOX_WIDTH, FOX_WIDTH, FOX_HEADS)
RWKV_SIZES = (RWKV_WIDTH, RWKV_WIDTH, RWKV_WIDTH, DECAY_LORA, A_LORA, GATE_LORA)
N_FOX_COLS = sum(FOX_SIZES)
N_RWKV_COLS = sum(RWKV_SIZES)
IN_COLS = N_FOX_COLS + N_RWKV_COLS

kernel_name = 'hymba_fox_rwkv7_adaln_layer'


def _offsets(sizes):
    return [int(o) for o in np.cumsum(sizes)[:-1]]


def rms_norm(x, gain):
    xf = x.astype(jnp.float32)
    y = xf * lax.rsqrt(jnp.mean(xf * xf, axis=-1, keepdims=True) + RMS_EPS)
    return (y * gain.astype(jnp.float32)).astype(x.dtype)


def modulate(h, shift, scale):
    return h * (1 + scale) + shift


def fox_attention(q, k, v, log_f):
    B, T, H, Dh = q.shape
    cum = jnp.transpose(jnp.cumsum(log_f, axis=1), (0, 2, 1))
    qh = jnp.transpose(q, (0, 2, 1, 3))
    kh = jnp.transpose(k, (0, 2, 1, 3))
    vh = jnp.transpose(v, (0, 2, 1, 3))
    scale = Dh ** -0.5
    outs = []
    for i in range(T // Q_BLOCK):
        lo = i * Q_BLOCK
        hi = lo + Q_BLOCK
        s = jnp.einsum('bhqd,bhkd->bhqk', qh[:, :, lo:hi], kh[:, :, :hi]).astype(jnp.float32) * scale
        s = s + (cum[:, :, lo:hi, None] - cum[:, :, None, :hi])
        causal = jnp.arange(hi)[None, :] <= (lo + jnp.arange(Q_BLOCK))[:, None]
        s = jnp.where(causal, s, -jnp.inf)
        p = jax.nn.softmax(s, axis=-1)
        outs.append(jnp.einsum('bhqk,bhkd->bhqd', p.astype(v.dtype), vh[:, :, :hi]))
    o = jnp.concatenate(outs, axis=2)
    return jnp.transpose(o, (0, 2, 1, 3))


def fox_mixer(p, f_bias, q_gain, k_gain):
    B, T, _ = p.shape
    q, k, v, f_logit = jnp.split(p, _offsets(FOX_SIZES), axis=-1)
    q = rms_norm(q.reshape(B, T, FOX_HEADS, HEAD_DIM), q_gain)
    k = rms_norm(k.reshape(B, T, FOX_HEADS, HEAD_DIM), k_gain)
    v = v.reshape(B, T, FOX_HEADS, HEAD_DIM)
    log_f = jax.nn.log_sigmoid((f_logit + f_bias).astype(jnp.float32))
    o = fox_attention(q, k, v, log_f)
    return o.reshape(B, T, FOX_WIDTH)


def rwkv7_scan(r, decay, k, v, a, b):
    B, T, H, N = r.shape

    def step(S, inp):
        r_t, d_t, k_t, v_t, a_t, b_t = inp
        sa = jnp.einsum('bhvk,bhk->bhv', S, a_t)
        S = S * d_t[:, :, None, :] + sa[..., None] * b_t[:, :, None, :] + v_t[..., None] * k_t[:, :, None, :]
        y = jnp.einsum('bhvk,bhk->bhv', S, r_t)
        return S, y

    xs = tuple(jnp.moveaxis(t, 1, 0) for t in (r, decay, k, v, a, b))
    S0 = jnp.zeros((B, H, N, N), jnp.float32)
    _, y = lax.scan(step, S0, xs)
    return jnp.moveaxis(y, 0, 1)


def rwkv_mixer(p, mu, w0, w2, a0, a2, g2, k_k, k_a, r_k, lnx_g, lnx_b):
    B, T, _ = p.shape
    H, N = RWKV_HEADS, HEAD_DIM
    f32 = jnp.float32
    p_prev = jnp.pad(p, ((0, 0), (1, 0), (0, 0)))[:, :-1]
    p = p + (p_prev - p) * mu
    r, k, v, w_dn, a_dn, g_dn = jnp.split(p, _offsets(RWKV_SIZES), axis=-1)
    w = -jax.nn.softplus(-(w0 + jnp.tanh(w_dn) @ w2)) - 0.5
    decay = jnp.exp(-jnp.exp(w.astype(f32)))
    a = jax.nn.sigmoid(a0 + a_dn @ a2)
    g = jax.nn.sigmoid(g_dn) @ g2
    kk = (k * k_k).astype(f32).reshape(B, T, H, N)
    kk = kk / jnp.maximum(jnp.sqrt(jnp.sum(kk * kk, axis=-1, keepdims=True)), L2_EPS)
    k = k * (1 + (a - 1) * k_a)
    rh = r.astype(f32).reshape(B, T, H, N)
    kh = k.astype(f32).reshape(B, T, H, N)
    vh = v.astype(f32).reshape(B, T, H, N)
    ah = a.astype(f32).reshape(B, T, H, N)
    y = rwkv7_scan(rh, decay.reshape(B, T, H, N), kh, vh, -kk, kk * ah)
    mean = jnp.mean(y, axis=-1, keepdims=True)
    var = jnp.mean(jnp.square(y - mean), axis=-1, keepdims=True)
    y = (y - mean) * lax.rsqrt(var + GN_EPS)
    y = y * lnx_g.astype(f32).reshape(H, N) + lnx_b.astype(f32).reshape(H, N)
    y = y + jnp.sum(rh * kh * r_k.astype(f32), axis=-1, keepdims=True) * vh
    return (y.reshape(B, T, RWKV_WIDTH) * g.astype(f32)).astype(p.dtype)


def swiglu(h, w_gate, w_up, w_down):
    return (jax.nn.silu(h @ w_gate) * (h @ w_up)) @ w_down


def setup_inputs(seed: int = 0) -> dict:
    key = jax.random.key(seed)
    ks = jax.random.split(key, 32)
    f32 = jnp.float32
    L, D = DEPTH, D_MODEL

    def nrm(k, shape, scale):
        return jax.random.normal(k, shape, f32) * scale

    return {
        'x': nrm(ks[0], (BATCH, SEQ, D), 1.0),
        'c': nrm(ks[1], (BATCH, D), 1.0),
        'ada_w': nrm(ks[2], (L, D, 6 * D), 0.5 * D ** -0.5),
        'ada_b': nrm(ks[3], (L, 6 * D), 0.02),
        'norm1_g': 1.0 + nrm(ks[4], (L, D), 0.02),
        'norm2_g': 1.0 + nrm(ks[5], (L, D), 0.02),
        'w_in': nrm(ks[6], (L, D, IN_COLS), D ** -0.5),
        'fox_f_bias': jax.random.uniform(ks[7], (L, FOX_HEADS), f32, 1.0, 4.0),
        'fox_q_gain': 1.0 + nrm(ks[8], (L, FOX_HEADS, HEAD_DIM), 0.02),
        'fox_k_gain': 1.0 + nrm(ks[9], (L, FOX_HEADS, HEAD_DIM), 0.02),
        'rwkv_mu': jax.random.uniform(ks[10], (L, N_RWKV_COLS), f32, 0.0, 1.0),
        'rwkv_w0': jax.random.uniform(ks[11], (L, RWKV_WIDTH), f32, -6.0, -1.0),
        'rwkv_w2': nrm(ks[12], (L, DECAY_LORA, RWKV_WIDTH), 0.5 * DECAY_LORA ** -0.5),
        'rwkv_a0': nrm(ks[13], (L, RWKV_WIDTH), 0.1),
        'rwkv_a2': nrm(ks[14], (L, A_LORA, RWKV_WIDTH), A_LORA ** -0.5),
        'rwkv_g2': nrm(ks[15], (L, GATE_LORA, RWKV_WIDTH), GATE_LORA ** -0.5),
        'rwkv_k_k': 0.85 + nrm(ks[16], (L, RWKV_WIDTH), 0.05),
        'rwkv_k_a': 1.0 + nrm(ks[17], (L, RWKV_WIDTH), 0.05),
        'rwkv_r_k': nrm(ks[18], (L, RWKV_HEADS, HEAD_DIM), 0.1),
        'rwkv_lnx_g': 1.0 + nrm(ks[19], (L, RWKV_WIDTH), 0.02),
        'rwkv_lnx_b': nrm(ks[20], (L, RWKV_WIDTH), 0.02),
        'w_out': nrm(ks[21], (L, MIX_WIDTH, D), MIX_WIDTH ** -0.5),
        'ffn_w_gate': nrm(ks[22], (L, D, D_FF), D ** -0.5),
        'ffn_w_up': nrm(ks[23], (L, D, D_FF), D ** -0.5),
        'ffn_w_down': nrm(ks[24], (L, D_FF, D), D_FF ** -0.5),
    }


def reference(x, c, ada_w, ada_b, norm1_g, norm2_g, w_in, fox_f_bias, fox_q_gain, fox_k_gain,
              rwkv_mu, rwkv_w0, rwkv_w2, rwkv_a0, rwkv_a2, rwkv_g2, rwkv_k_k, rwkv_k_a, rwkv_r_k,
              rwkv_lnx_g, rwkv_lnx_b, w_out, ffn_w_gate, ffn_w_up, ffn_w_down):
    cond = jax.nn.silu(c)
    for l in range(DEPTH):
        mod = cond @ ada_w[l] + ada_b[l]
        sh1, sc1, gt1, sh2, sc2, gt2 = jnp.split(mod[:, None, :], 6, axis=-1)
        h = modulate(rms_norm(x, norm1_g[l]), sh1, sc1)
        p = h @ w_in[l]
        p_fox = p[..., :N_FOX_COLS]
        p_rwkv = p[..., N_FOX_COLS:]
        o_fox = fox_mixer(p_fox, fox_f_bias[l], fox_q_gain[l], fox_k_gain[l])
        o_rwkv = rwkv_mixer(p_rwkv, rwkv_mu[l], rwkv_w0[l], rwkv_w2[l], rwkv_a0[l], rwkv_a2[l],
                            rwkv_g2[l], rwkv_k_k[l], rwkv_k_a[l], rwkv_r_k[l],
                            rwkv_lnx_g[l], rwkv_lnx_b[l])
        mix = jnp.concatenate([o_fox, o_rwkv], axis=-1) @ w_out[l]
        x = x + gt1 * mix
        h2 = modulate(rms_norm(x, norm2_g[l]), sh2, sc2)
        x = x + gt2 * swiglu(h2, ffn_w_gate[l], ffn_w_up[l], ffn_w_down[l])
    return x
```

```cpp
#define MK_N_LAUNCHES 1
#include <hip/hip_runtime.h>
#include <cstdio>
#include <cstdint>
namespace pg8 {
#define PG8_LAS __attribute__((address_space(3)))
typedef unsigned short bf16_t;
typedef short bf16x8 __attribute__((ext_vector_type(8)));
typedef float f32x4 __attribute__((ext_vector_type(4)));
typedef unsigned u32x4 __attribute__((ext_vector_type(4)));
constexpr int BM = 256, BK = 64, HALF = 128, HTB = HALF * BK * 2  , STAGE_BYTES = 8 * HTB, NXCD = 8, WGM = 8;

__host__ __device__ __forceinline__ int lds_byte(int r, int c) { const int st = (r >> 4) * 2 + (c >> 5), rr = r & 15, cc = c & 31, ob = rr * 64 + cc * 2; return st * 1024 + (ob ^ (((ob >> 9) & 1) << 5)); }
__host__ __device__ __forceinline__ void stage_rc(int b, int& R, int& C) { const int st = b / 1024, sb = b % 1024, swz = sb ^ (((sb >> 9) & 1) << 5); R = (st >> 1) * 16 + swz / 64; C = (st & 1) * 32 + (swz % 64) / 2; }
__host__ __device__ __forceinline__ int perm32(int rho) { const int n = rho >> 4, i = rho & 15; return 8 * (i >> 2) + 4 * n + (i & 3); }

struct Unit { int pm, pn; };
struct Gemm { const bf16_t* A; const bf16_t* Bt; int M, N, K; };

struct StaticOrder {
    int nM, nN, nwg, G, c;
    __host__ __device__ void init(int M, int N, int G_, int c_) { nM = M / BM; nN = N / BM; nwg = nM * nN; G = G_; c = c_; }
    __host__ __device__ bool next(int i, Unit& u) const {
        const long L = (long)i * G + c; if (L >= nwg) return false;
        int wgid = (int)L; { const int q = nwg / NXCD, r = nwg % NXCD, xcd = wgid % NXCD, off = wgid / NXCD; wgid = (xcd < r ? xcd * (q + 1) : r * (q + 1) + (xcd - r) * q) + off; }
        const int nig = WGM * nN, gid = wgid / nig, fm = gid * WGM, gsz = (nM - fm) < WGM ? (nM - fm) : WGM;
        u.pm = fm + ((wgid % nig) % gsz); u.pn = (wgid % nig) / gsz; return true;
    }
    __device__ __forceinline__ void a_ready(const Unit&) const {}
    __device__ __forceinline__ void done(const Unit&) const {}
};

__device__ __forceinline__ unsigned cvt_pk_bf16(float lo, float hi) { unsigned r; asm volatile("v_cvt_pk_bf16_f32 %0, %1, %2" : "=v"(r) : "v"(lo), "v"(hi)); return r; }
typedef float f32x2 __attribute__((ext_vector_type(2)));
__device__ __forceinline__ f32x2 gelu_pk(f32x2 v) {
    const f32x2 av = __builtin_elementwise_abs(v), d = av * 0.2316418882f + 1.0f;
    f32x2 t; t.x = __builtin_amdgcn_rcpf(d.x); t.y = __builtin_amdgcn_rcpf(d.y);
    f32x2 q = t * 0.5307027145f + (-0.7265760135f); q = q * t + 0.7107068705f; q = q * t + (-0.142248368f); q = q * t + 0.127414796f; q = q * t;
    const f32x2 s = (v * v) * (-0.72134752044f);
    f32x2 e; e.x = __builtin_amdgcn_exp2f(s.x); e.y = __builtin_amdgcn_exp2f(s.y);
    const f32x2 m = v * (q * e), r = v - m;
    f32x2 o; o.x = v.x < 0.f ? m.x : r.x; o.y = v.y < 0.f ? m.y : r.y; return o;
}

template <int ACT  > struct EpiBf16 {
    static constexpr bool PERM = true, AFTER_DRAIN = false; static_assert(ACT == 0 || ACT == 1, "EpiBf16: ACT is 0 (none) or 1 (gelu_pk)");
    bf16_t* O; int ldc; const float* bias; int split_cols; size_t split_stride; float scale0;
    __device__ __forceinline__ void operator()(const f32x4 (&acc)[2][2][4][2], const Unit& u, int wr, int wc, int fr, int fq) const {
        const int row0 = u.pm * BM + wr * 64 + fr; int colt = u.pn * BM; bf16_t* base = O;
        float sc = 1.f; if (split_cols) { const int t = colt / split_cols; base += (size_t)t * split_stride; colt -= t * split_cols; if (t == 0) sc = scale0; }
        const int col0 = colt + wc * 32 + 8 * fq, bcol0 = u.pn * BM + wc * 32 + 8 * fq;
        f32x4 bv[2][2];
#pragma unroll
        for (int bj = 0; bj < 2; ++bj)
#pragma unroll
            for (int n = 0; n < 2; ++n) bv[bj][n] = bias ? *(const f32x4*)(bias + bcol0 + bj * HALF + 4 * n) : (f32x4){0.f, 0.f, 0.f, 0.f};
#pragma unroll
        for (int ai = 0; ai < 2; ++ai)
#pragma unroll
            for (int m = 0; m < 4; ++m) { bf16_t* rowp = base + (size_t)(row0 + ai * HALF + m * 16) * ldc + col0;
#pragma unroll
                for (int bj = 0; bj < 2; ++bj) { f32x4 v0 = acc[ai][bj][m][0] + bv[bj][0], v1 = acc[ai][bj][m][1] + bv[bj][1];
                    if (ACT == 1) { f32x2 a = gelu_pk((f32x2){v0[0], v0[1]}), b = gelu_pk((f32x2){v0[2], v0[3]}), c = gelu_pk((f32x2){v1[0], v1[1]}), d = gelu_pk((f32x2){v1[2], v1[3]});
                        v0 = (f32x4){a.x, a.y, b.x, b.y}; v1 = (f32x4){c.x, c.y, d.x, d.y}; }
                    v0 = v0 * sc; v1 = v1 * sc; u32x4 w; w.x = cvt_pk_bf16(v0[0], v0[1]); w.y = cvt_pk_bf16(v0[2], v0[3]); w.z = cvt_pk_bf16(v1[0], v1[1]); w.w = cvt_pk_bf16(v1[2], v1[3]);
                    *(u32x4*)(rowp + bj * HALF) = w; } }
    }
};
struct EpiResGate {
    static constexpr bool PERM = false, AFTER_DRAIN = false;
    const float* base; float* out; const float* gate; int ldc; int gate_ld;
    __device__ __forceinline__ void operator()(const f32x4 (&acc)[2][2][4][2], const Unit& u, int wr, int wc, int fr, int fq) const {
        const int b = (u.pm * BM) >> 11; const float* g = gate + (size_t)b * gate_ld;
        const int col0 = u.pn * BM + wc * 32 + 4 * fq;
        f32x4 gv[2][2];
#pragma unroll
        for (int bj = 0; bj < 2; ++bj)
#pragma unroll
            for (int n = 0; n < 2; ++n) gv[bj][n] = *(const f32x4*)(g + col0 + bj * HALF + n * 16);
#pragma unroll
        for (int ai = 0; ai < 2; ++ai)
#pragma unroll
            for (int m = 0; m < 4; ++m) { const size_t off = (size_t)(u.pm * BM + ai * HALF + wr * 64 + m * 16 + fr) * ldc + col0;
                f32x4 bs[2][2];
#pragma unroll
                for (int bj = 0; bj < 2; ++bj)
#pragma unroll
                    for (int n = 0; n < 2; ++n) bs[bj][n] = *(const f32x4*)(base + off + bj * HALF + n * 16);
#pragma unroll
                for (int bj = 0; bj < 2; ++bj)
#pragma unroll
                    for (int n = 0; n < 2; ++n) *(f32x4*)(out + off + bj * HALF + n * 16) = bs[bj][n] + gv[bj][n] * acc[ai][bj][m][n];
                asm volatile("" ::: "memory"); }
    }
};
struct EpiSwiGLU {
    static constexpr bool PERM = true, AFTER_DRAIN = false;
    bf16_t* O; int ldc;
    __device__ __forceinline__ void operator()(const f32x4 (&acc)[2][2][4][2], const Unit& u, int wr, int wc, int fr, int fq) const {
        const int row0 = u.pm * BM + wr * 64 + fr, col0 = u.pn * HALF + wc * 32 + 8 * fq;
#pragma unroll
        for (int ai = 0; ai < 2; ++ai)
#pragma unroll
            for (int m = 0; m < 4; ++m) { bf16_t* rowp = O + (size_t)(row0 + ai * HALF + m * 16) * ldc + col0;
                float hv[8];
#pragma unroll
                for (int n = 0; n < 2; ++n)
#pragma unroll
                    for (int i = 0; i < 4; ++i) { const float g = acc[ai][0][m][n][i], up = acc[ai][1][m][n][i];
                        const float sg = g * __builtin_amdgcn_rcpf(1.0f + __builtin_amdgcn_exp2f(-1.4426950408889634f * g)); hv[4 * n + i] = sg * up; }
                u32x4 w; w.x = cvt_pk_bf16(hv[0], hv[1]); w.y = cvt_pk_bf16(hv[2], hv[3]); w.z = cvt_pk_bf16(hv[4], hv[5]); w.w = cvt_pk_bf16(hv[6], hv[7]);
                *(u32x4*)rowp = w; }
    }
};

template <class Epi, class Sched, bool ALIGN_EPI = false, bool SP2 = false>
__device__ __forceinline__ void gemm_phase(PG8_LAS unsigned char* lds, const Gemm g, const Sched& S, const Epi& E) {
    const int tid = threadIdx.x, wid = __builtin_amdgcn_readfirstlane(tid >> 6), lane = tid & 63, wr = wid >> 2, wc = wid & 3, fr = lane & 15, fq = lane >> 4;
    const int K = g.K, nt = K / BK;
    unsigned voffA[2], voffB[2];
#pragma unroll
    for (int i = 0; i < 2; ++i) { int R, C; stage_rc(tid * 16 + i * 8192, R, C); const int Rb = Epi::PERM ? ((R & ~31) + perm32(R & 31)) : R;
        voffA[i] = (unsigned)(R * K + C) * 2u; voffB[i] = (unsigned)(Rb * K + C) * 2u; }
    const size_t kstep = (size_t)(BK * 2);
    const size_t hstep = (size_t)HALF * K * 2;
    const size_t tstep = 2 * hstep;
    const unsigned ldsw = (unsigned)wid * 1024u;
    const int aoff = lds_byte(wr * 64 + fr, fq * 8), boff = lds_byte(wc * 32 + fr, fq * 8);
#define PG8_SA(b, h) (((b) * 2 + (h)) * HTB)
#define PG8_SB(b, h) ((4 + (b) * 2 + (h)) * HTB)
#define PG8_STAGE(bufoff, gbase, voff) do { _Pragma("unroll") for (int _i = 0; _i < 2; ++_i) \
        __builtin_amdgcn_global_load_lds((const unsigned*)((const char*)(gbase) + (voff)[_i]), (PG8_LAS unsigned*)(lds + (bufoff) + ldsw + _i * 8192), 16, 0, 0); } while (0)
#define PG8_LDA(dst, b, h) do { _Pragma("unroll") for (int m = 0; m < 4; ++m) _Pragma("unroll") for (int k = 0; k < 2; ++k) dst[m][k] = *(const PG8_LAS bf16x8*)(lds + PG8_SA(b, h) + aoff + m * 2048 + k * 1024); } while (0)
#define PG8_LDB(dst, b, h) do { _Pragma("unroll") for (int n = 0; n < 2; ++n) _Pragma("unroll") for (int k = 0; k < 2; ++k) dst[n][k] = *(const PG8_LAS bf16x8*)(lds + PG8_SB(b, h) + boff + n * 2048 + k * 1024); } while (0)
#define PG8_MMA(ai, bj, At, Bt) do { __builtin_amdgcn_s_setprio(1); _Pragma("unroll") for (int m = 0; m < 4; ++m) _Pragma("unroll") for (int n = 0; n < 2; ++n) _Pragma("unroll") for (int k = 0; k < 2; ++k) \
        acc[ai][bj][m][n] = __builtin_amdgcn_mfma_f32_16x16x32_bf16(Bt[n][k], At[m][k], acc[ai][bj][m][n], 0, 0, 0); __builtin_amdgcn_s_setprio(0); } while (0)
#define PG8_WAIT_V(n) asm volatile("s_waitcnt vmcnt(" #n ")" ::: "memory")
#define PG8_WAIT_L(n) asm volatile("s_waitcnt lgkmcnt(" #n ")" ::: "memory")
#define PG8_BAR __builtin_amdgcn_s_barrier()
#define PG8_SCHED __builtin_amdgcn_sched_barrier(0)
    Unit cur, nxt; int ui = 0;
    if (!S.next(0, cur)) return;
    f32x4 acc[2][2][4][2];
#pragma unroll
    for (int a = 0; a < 2; ++a)
#pragma unroll
        for (int b = 0; b < 2; ++b)
#pragma unroll
            for (int m = 0; m < 4; ++m)
#pragma unroll
                for (int n = 0; n < 2; ++n) acc[a][b][m][n] = (f32x4){0.f, 0.f, 0.f, 0.f};
    bf16x8 At[4][2], B0[2][2], B1[2][2];
    const char* cA = (const char*)g.A + (size_t)cur.pm * tstep; const char* cB = (const char*)g.Bt + (size_t)cur.pn * tstep;
    S.a_ready(cur);
    if constexpr (SP2) {
        PG8_STAGE(PG8_SB(0, 0), cB, voffB); PG8_STAGE(PG8_SB(0, 1), cB + hstep, voffB); PG8_STAGE(PG8_SA(0, 0), cA, voffA); PG8_STAGE(PG8_SA(0, 1), cA + hstep, voffA);
        if (wr == 1) PG8_BAR;
        PG8_WAIT_V(2); PG8_BAR;
        PG8_STAGE(PG8_SB(1, 0), cB + kstep, voffB); PG8_STAGE(PG8_SA(1, 0), cA + kstep, voffA); PG8_STAGE(PG8_SB(1, 1), cB + hstep + kstep, voffB);
        PG8_WAIT_V(6); PG8_BAR;
    } else {
        PG8_STAGE(PG8_SB(0, 0), cB, voffB); PG8_STAGE(PG8_SA(0, 0), cA, voffA); PG8_STAGE(PG8_SB(0, 1), cB + hstep, voffB); PG8_STAGE(PG8_SA(0, 1), cA + hstep, voffA);
        if (wr == 1) PG8_BAR;
        PG8_WAIT_V(4); PG8_BAR;
        PG8_STAGE(PG8_SB(1, 0), cB + kstep, voffB); PG8_STAGE(PG8_SA(1, 0), cA + kstep, voffA); PG8_STAGE(PG8_SB(1, 1), cB + hstep + kstep, voffB);
        PG8_WAIT_V(6); PG8_BAR;
    }
    for (;;) {
        const bool has_next = S.next(ui + 1, nxt);
        const char* nA = has_next ? (const char*)g.A + (size_t)nxt.pm * tstep : cA; const char* nB = has_next ? (const char*)g.Bt + (size_t)nxt.pn * tstep : cB;
        for (int t = 0; t < nt; t += 2) {
            const bool last = (t == nt - 2);
            const char* a1 = cA + (size_t)(t + 1) * kstep;
            const char* a2 = last ? nA : cA + (size_t)(t + 2) * kstep; const char* b2 = last ? nB : cB + (size_t)(t + 2) * kstep;
            const char* a3 = a2 + kstep; const char* b3 = b2 + kstep;
            if (last && has_next) S.a_ready(nxt);
            if constexpr (SP2) {
            PG8_LDB(B0, 0, 0); PG8_LDB(B1, 0, 1); PG8_SCHED; PG8_LDA(At, 0, 0); PG8_STAGE(PG8_SA(1, 1), a1 + hstep, voffA);
            PG8_WAIT_V(8); PG8_WAIT_L(0); PG8_BAR; PG8_MMA(0, 0, At, B0); PG8_MMA(0, 1, At, B1); PG8_BAR; PG8_SCHED;
            PG8_LDA(At, 0, 1); PG8_STAGE(PG8_SB(0, 0), b2, voffB); PG8_STAGE(PG8_SB(0, 1), b2 + hstep, voffB); PG8_STAGE(PG8_SA(0, 0), a2, voffA);
            PG8_WAIT_V(8); PG8_WAIT_L(0); PG8_BAR; PG8_MMA(1, 0, At, B0); PG8_MMA(1, 1, At, B1); PG8_BAR; PG8_SCHED;
            PG8_LDB(B0, 1, 0); PG8_LDB(B1, 1, 1); PG8_SCHED; PG8_LDA(At, 1, 0); PG8_STAGE(PG8_SA(0, 1), a2 + hstep, voffA);
            PG8_WAIT_V(8); PG8_WAIT_L(0); PG8_BAR; PG8_MMA(0, 0, At, B0); PG8_MMA(0, 1, At, B1); PG8_BAR; PG8_SCHED;
            PG8_LDA(At, 1, 1); PG8_STAGE(PG8_SB(1, 0), b3, voffB); PG8_STAGE(PG8_SB(1, 1), b3 + hstep, voffB); PG8_STAGE(PG8_SA(1, 0), a3, voffA);
            PG8_WAIT_V(8); PG8_WAIT_L(0); PG8_BAR; PG8_MMA(1, 0, At, B0); PG8_MMA(1, 1, At, B1); PG8_BAR; PG8_SCHED;
            } else {
            PG8_LDB(B0, 0, 0); PG8_SCHED; PG8_LDA(At, 0, 0); PG8_STAGE(PG8_SA(1, 1), a1 + hstep, voffA);
            PG8_WAIT_L(8); PG8_BAR; PG8_WAIT_L(0); PG8_MMA(0, 0, At, B0); PG8_BAR; PG8_SCHED;
            PG8_LDB(B1, 0, 1); PG8_STAGE(PG8_SB(0, 0), b2, voffB);
            PG8_BAR; PG8_WAIT_L(0); PG8_MMA(0, 1, At, B1); PG8_BAR;
            PG8_LDA(At, 0, 1); PG8_STAGE(PG8_SA(0, 0), a2, voffA);
            PG8_BAR; PG8_WAIT_L(0); PG8_MMA(1, 0, At, B0); PG8_BAR; PG8_SCHED;
            PG8_STAGE(PG8_SB(0, 1), b2 + hstep, voffB);
            PG8_WAIT_V(6); PG8_BAR; PG8_MMA(1, 1, At, B1); PG8_BAR;
            PG8_LDB(B0, 1, 0); PG8_SCHED; PG8_LDA(At, 1, 0); PG8_STAGE(PG8_SA(0, 1), a2 + hstep, voffA);
            PG8_WAIT_L(8); PG8_BAR; PG8_WAIT_L(0); PG8_MMA(0, 0, At, B0); PG8_BAR; PG8_SCHED;
            PG8_LDB(B1, 1, 1); PG8_STAGE(PG8_SB(1, 0), b3, voffB);
            PG8_BAR; PG8_WAIT_L(0); PG8_MMA(0, 1, At, B1); PG8_BAR;
            PG8_LDA(At, 1, 1); PG8_STAGE(PG8_SA(1, 0), a3, voffA);
            PG8_BAR; PG8_WAIT_L(0); PG8_MMA(1, 0, At, B0); PG8_BAR; PG8_SCHED;
            PG8_STAGE(PG8_SB(1, 1), b3 + hstep, voffB);
            PG8_WAIT_V(6); PG8_BAR; PG8_MMA(1, 1, At, B1); PG8_BAR;
            }
        }
        if constexpr (ALIGN_EPI) { if (wr == 0) PG8_BAR; }
        if constexpr (!Epi::AFTER_DRAIN) { E(acc, cur, wr, wc, fr, fq); S.done(cur); }
        if (!has_next) break;
#pragma unroll
        for (int a = 0; a < 2; ++a)
#pragma unroll
            for (int b = 0; b < 2; ++b)
#pragma unroll
                for (int m = 0; m < 4; ++m)
#pragma unroll
                    for (int n = 0; n < 2; ++n) acc[a][b][m][n] = (f32x4){0.f, 0.f, 0.f, 0.f};
        cur = nxt; cA = nA; cB = nB; ++ui;
        if constexpr (ALIGN_EPI) { if (wr == 1) PG8_BAR; }
    }
    PG8_WAIT_V(0);
    if constexpr (!ALIGN_EPI) { if (wr == 0) PG8_BAR; }
    PG8_BAR;
    if constexpr (Epi::AFTER_DRAIN) { E.fused(acc, cur, wr, wc, fr, fq, lds, wid, lane); S.done(cur); }
#undef PG8_SA
#undef PG8_SB
#undef PG8_STAGE
#undef PG8_LDA
#undef PG8_LDB
#undef PG8_MMA
#undef PG8_WAIT_V
#undef PG8_WAIT_L
#undef PG8_BAR
#undef PG8_SCHED
}
}

#ifndef PG8_SP2
#define PG8_SP2 true
#endif
#ifndef PG8_ALIGN
#define PG8_ALIGN true
#endif
#include <hip/hip_bf16.h>
#include <cmath>
namespace attn_body {
using bf16=__hip_bfloat16;
using bf16x8=__attribute__((ext_vector_type(8)))short;
using s16x4=__attribute__((ext_vector_type(4)))short;
using f32x16=__attribute__((ext_vector_type(16)))float;
using u32x4=__attribute__((ext_vector_type(4)))unsigned;
constexpr int BATCH=16,NHEAD=8,SEQ=2048,D=64;
constexpr int QP=512,KP=512,VP=3584,OP=1024;
constexpr int NW=8,QBLK=32,QB=QBLK*NW,KVBLK=64,NQB=SEQ/QB;
constexpr int ATTN_UNIT_ROWS=QB;
__device__ __forceinline__ int crow(int r,int hi){return (r&3)+8*(r>>2)+4*hi;}
#define SBAR() __builtin_amdgcn_sched_barrier(0)
__device__ __forceinline__ void cmask(f32x16&p0,f32x16&p1,int jb,int qrel,int hi){
  const float NEG=-INFINITY; int kb=64*jb+4*hi;
  #pragma unroll
  for(int r=0;r<16;++r){int kv=kb+(r&3)+8*(r>>2); if(kv>qrel)p0[r]=NEG; if(kv+32>qrel)p1[r]=NEG;}
}

constexpr int NSLOT=3, SLOTB=8192;
constexpr int LDS_K=0, LDS_V=NSLOT*SLOTB, LDS_WS=2*NSLOT*SLOTB, LDS_OST=LDS_WS+NW*64*4, LDS_KB=LDS_OST+NW*4096, LDS_BYTES=LDS_KB+SEQ*4;
constexpr float C2=0.125f*1.4426950408889634f;
__device__ __forceinline__ void glds16(const void*gsrc,unsigned lds_dst){unsigned keep;
  asm volatile("s_mov_b32 %0, m0\n\ts_mov_b32 m0, %2\n\ts_nop 0\n\tglobal_load_lds_dwordx4 %1, off\n\ts_mov_b32 m0, %0":"=&s"(keep):"v"(gsrc),"s"(lds_dst):"memory");}
__device__ __forceinline__ float max3f(float a,float b,float c){float r;asm("v_max3_f32 %0, %1, %2, %3":"=v"(r):"v"(a),"v"(b),"v"(c));return r;}
__device__ __forceinline__ float max2f(float a,float b){float r;asm("v_max_f32_e32 %0, %1, %2":"=v"(r):"v"(a),"v"(b));return r;}
__device__ __forceinline__ float fadd_s(float a,float b){float r;asm("v_add_f32_e32 %0, %1, %2":"=v"(r):"v"(a),"v"(b));return r;}
__device__ __forceinline__ float fsub_s(float a,float b){float r;asm("v_sub_f32_e32 %0, %1, %2":"=v"(r):"v"(a),"v"(b));return r;}
typedef float f32x2_t __attribute__((ext_vector_type(2))); typedef __bf16 bf16x2_t __attribute__((ext_vector_type(2)));
__device__ __forceinline__ unsigned cvtpk_s(float lo,float hi){f32x2_t v={lo,hi};bf16x2_t b=__builtin_convertvector(v,bf16x2_t);return __builtin_bit_cast(unsigned,b);}
#define WAIT_BAR(N) asm volatile("s_waitcnt vmcnt(" #N ") lgkmcnt(0)\n\ts_barrier":::"memory")

__device__ __forceinline__ void qkt(f32x16&p0,f32x16&p1,const char*Kslot,const bf16x8*qr,const f32x16&negm,int r32,int hi,bf16x8 kb0,bf16x8 kb1,bf16x8 qone){
  p0=__builtin_amdgcn_mfma_f32_32x32x16_bf16(kb0,qone,negm,0,0,0);p1=__builtin_amdgcn_mfma_f32_32x32x16_bf16(kb1,qone,negm,0,0,0);
  const char*kb=Kslot+hi*1024+r32*16;
  #pragma unroll
  for(int d0=0;d0<4;++d0){
    const bf16x8 b0=*reinterpret_cast<const bf16x8*>(kb+d0*2048);
    const bf16x8 b1=*reinterpret_cast<const bf16x8*>(kb+d0*2048+512);
    p0=__builtin_amdgcn_mfma_f32_32x32x16_bf16(b0,qr[d0],p0,0,0,0);p1=__builtin_amdgcn_mfma_f32_32x32x16_bf16(b1,qr[d0],p1,0,0,0);}
}
typedef __attribute__((address_space(3))) const char* lds_cptr;
typedef short v4i16_t __attribute__((ext_vector_type(4)));
__device__ __forceinline__ void kload8(bf16x8*kf,lds_cptr kp){
  kf[0]=*(const __attribute__((address_space(3))) bf16x8*)(kp);      kf[1]=*(const __attribute__((address_space(3))) bf16x8*)(kp+512);
  kf[2]=*(const __attribute__((address_space(3))) bf16x8*)(kp+2048); kf[3]=*(const __attribute__((address_space(3))) bf16x8*)(kp+2560);
  kf[4]=*(const __attribute__((address_space(3))) bf16x8*)(kp+4096); kf[5]=*(const __attribute__((address_space(3))) bf16x8*)(kp+4608);
  kf[6]=*(const __attribute__((address_space(3))) bf16x8*)(kp+6144); kf[7]=*(const __attribute__((address_space(3))) bf16x8*)(kp+6656);
}
__device__ __forceinline__ void kload2(bf16x8*kf,lds_cptr kp,int j){ kf[2*j]=*(const __attribute__((address_space(3))) bf16x8*)(kp+j*2048); kf[2*j+1]=*(const __attribute__((address_space(3))) bf16x8*)(kp+j*2048+512); }
__device__ __forceinline__ s16x4 vtr(lds_cptr p){ return __builtin_bit_cast(s16x4,__builtin_amdgcn_ds_read_tr16_b64_v4i16((__attribute__((address_space(3))) v4i16_t*)p)); }
__device__ __forceinline__ float rowmax(const f32x16&p0,const f32x16&p1){
  float a=max3f(p0[0],p0[1],p1[0]),b=max3f(p0[2],p0[3],p1[1]);a=max3f(a,p1[2],p1[3]);
  #pragma unroll
  for(int r=4;r<16;r+=4){a=max3f(a,p0[r],p0[r+1]);b=max3f(b,p0[r+2],p0[r+3]);a=max3f(a,p1[r],p1[r+1]);b=max3f(b,p1[r+2],p1[r+3]);}
  const float m=max2f(a,b);
  auto rr=__builtin_amdgcn_permlane32_swap(__float_as_uint(m),__float_as_uint(m),false,false);
  return max2f(__uint_as_float(rr[0]),__uint_as_float(rr[1]));
}
__device__ __forceinline__ void pv(f32x16*o,int vb,bf16x8 pa0,bf16x8 pa1,bf16x8 pa2,bf16x8 pa3){
  #pragma unroll
  for(int d0=0;d0<2;++d0){s16x4 lo[4],hi[4];
    #pragma unroll
    for(int ks=0;ks<4;++ks){
      asm volatile("ds_read_b64_tr_b16 %0,%1 offset:%c2":"=&v"(lo[ks]):"v"(vb),"i"(d0*4096+ks*1024):"memory");
      asm volatile("ds_read_b64_tr_b16 %0,%1 offset:%c2":"=&v"(hi[ks]):"v"(vb),"i"(d0*4096+ks*1024+512):"memory");}
    asm volatile("s_waitcnt lgkmcnt(0)":::"memory");SBAR();
    #define PK(k) (bf16x8){lo[k][0],lo[k][1],lo[k][2],lo[k][3],hi[k][0],hi[k][1],hi[k][2],hi[k][3]}
    o[d0]=__builtin_amdgcn_mfma_f32_32x32x16_bf16(pa0,PK(0),o[d0],0,0,0);
    o[d0]=__builtin_amdgcn_mfma_f32_32x32x16_bf16(pa1,PK(1),o[d0],0,0,0);
    o[d0]=__builtin_amdgcn_mfma_f32_32x32x16_bf16(pa2,PK(2),o[d0],0,0,0);
    o[d0]=__builtin_amdgcn_mfma_f32_32x32x16_bf16(pa3,PK(3),o[d0],0,0,0);
    #undef PK
  }
}

#ifndef ATTN_STORE16
#define ATTN_STORE16(p,v) (*(u32x4*)(p)=(v))
#endif
template<int THRL> __device__ __forceinline__ void attn_unit(int b,int h,int qb,const bf16*Q,const bf16*__restrict__ K,const bf16*__restrict__ V,bf16*O,const float*Cum,const float*Lq,char*shm){
  const int tid=threadIdx.x,lane=tid&63,r32=lane&31,hi=lane>>5; const int wid=__builtin_amdgcn_readfirstlane(tid>>6);
  const long rowbase=(long)b*SEQ; const int q0=qb*QB;
  const bf16*Qw=Q+(rowbase+q0+wid*QBLK)*QP+h*D;
  const bf16*Kh=K+rowbase*KP+h*D,*Vh=V+rowbase*VP+h*D;
  const unsigned lds0=(unsigned)(uintptr_t)shm;
  float*wsf=(float*)(shm+LDS_WS)+wid*64;
  const bf16*ksrc=Kh+(long)lane*KP+wid*8;
  const bf16*vsrc=Vh+(long)(16*(wid&3)+(lane>>2))*VP+(wid>>2)*32+(lane&3)*8;
  const unsigned kdst=lds0+LDS_K+wid*1024, vdst=lds0+LDS_V+wid*1024;
  #define DMA_K(t,slot) glds16(ksrc+(long)(t)*KVBLK*KP,(unsigned)__builtin_amdgcn_readfirstlane(kdst+(slot)))
  #define DMA_V(t,slot) glds16(vsrc+(long)(t)*KVBLK*VP,(unsigned)__builtin_amdgcn_readfirstlane(vdst+(slot)))
  const int vb0=(int)(lds0+LDS_V)+((lane>>4)&1)*32+(lane&3)*8+(4*hi+((lane&15)>>2))*64;
  const char*Kbase=shm+LDS_K; bf16x8 kf[8];
  const lds_cptr shm3=(lds_cptr)shm; const lds_cptr kp0=shm3+LDS_K+hi*1024+r32*16; const lds_cptr vp0=shm3+LDS_V+((lane>>4)&1)*32+(lane&3)*8+(4*hi+((lane&15)>>2))*64;
  const int NT=(q0+QB)/KVBLK;
  const float*cum=Cum+((long)b*NHEAD+h)*SEQ; const float c0=cum[q0];
  { __attribute__((address_space(3))) unsigned*kbw=(__attribute__((address_space(3))) unsigned*)(shm3+LDS_KB);
    for(int s=tid;s<q0+QB;s+=NW*64){ const float v=c0-cum[s]; const unsigned vb=__float_as_uint(v); const unsigned hb=(vb+0x7fffu+((vb>>16)&1u))&0xffff0000u; const float lo=v-__uint_as_float(hb);
      const unsigned lb=__float_as_uint(lo); const unsigned lr=(lb+0x7fffu+((lb>>16)&1u))>>16; kbw[s]=(hb>>16)|(lr<<16); } }
  const float qbias=cum[q0+wid*QBLK+r32]-c0;
  const float lq=Lq[h];
  const unsigned himask=hi?0u:0xffffffffu; const unsigned onew=hi?0u:0x3f803f80u;
  const bf16x8 qone=__builtin_bit_cast(bf16x8,(u32x4){onew,0u,0u,0u});
  const __attribute__((address_space(3))) unsigned*kbp=(const __attribute__((address_space(3))) unsigned*)(shm3+LDS_KB)+r32;
  #define KBF(t,half) __builtin_bit_cast(bf16x8,(u32x4){kbp[(t)*KVBLK+(half)*32]&himask,0u,0u,0u})
  DMA_K(0,0);DMA_V(0,0);DMA_K(1,SLOTB);
  bf16x8 qr[4];
  #pragma unroll
  for(int d0=0;d0<4;++d0)qr[d0]=*reinterpret_cast<const bf16x8*>(&Qw[(long)r32*QP+d0*16+hi*8]);
  float mhat=0.f,l_reg=0.f;f32x16 o[2];o[0]=f32x16{};o[1]=f32x16{};f32x16 negm;
  #pragma unroll
  for(int r=0;r<16;++r)negm[r]=qbias;
  asm volatile("":"+v"(negm));
  const int qrel=wid*QBLK+r32;
  #define CMASK(P0,P1,t) do{int jb_=(t)-(NT-4); if(jb_>=0)cmask(P0,P1,jb_,qrel,hi);}while(0)
  bool resc=false;
  #define START(P0,P1) do{ const float rm=rowmax(P0,P1); resc=false; \
    { const float dl=__builtin_fmaxf(rm,lq); mhat=fadd_s(mhat,dl); \
      _Pragma("unroll") for(int r=0;r<16;++r){P0[r]=fsub_s(P0[r],dl);P1[r]=fsub_s(P1[r],dl);} \
      _Pragma("unroll") for(int r=0;r<16;++r)negm[r]=qbias-mhat; asm volatile("":"+v"(negm)); } \
    _Pragma("unroll") for(int r=0;r<16;++r)P0[r]=__builtin_amdgcn_exp2f(P0[r]); }while(0)
  #define RESC() do{ if(resc){ asm volatile("s_waitcnt lgkmcnt(0)":::"memory"); \
      _Pragma("unroll") for(int d_=0;d_<2;++d_) _Pragma("unroll") for(int r=0;r<16;++r)o[d_][r]*=wsf[crow(r,hi)]; } }while(0)
  f32x16 pA0,pA1,pB0,pB1;
  int sl_prev=0,sl_cur=0,sl_next=SLOTB;
  #define ROT() do{sl_prev=sl_cur;sl_cur=sl_next;sl_next=(sl_next==(NSLOT-1)*SLOTB)?0:sl_next+SLOTB;}while(0)
  DMA_K(2,2*SLOTB);
  WAIT_BAR(3);
  qkt(pA0,pA1,Kbase,qr,negm,r32,hi,KBF(0,0),KBF(0,1),qone);asm volatile("s_nop 15\n\ts_nop 7":"+v"(pA0),"+v"(pA1));CMASK(pA0,pA1,0);
  START(pA0,pA1);
  _Pragma("unroll") for(int r=0;r<16;++r)pA1[r]=__builtin_amdgcn_exp2f(pA1[r]);
  WAIT_BAR(0);
  DMA_K(3,0);DMA_V(1,SLOTB);
  ROT();
  kload8(kf,kp0+sl_cur);
  WAIT_BAR(2);
  s16x4 vlo[8],vhi[8]; u32x4 pw0,pw1,pw2,pw3;
  #define PKW(P,B) cvtpk_s(P[B],P[B+1])
  #define PAF(k) __builtin_bit_cast(bf16x8,pw##k)
  #define VFR(i) (bf16x8){vlo[i][0],vlo[i][1],vlo[i][2],vlo[i][3],vhi[i][0],vhi[i][1],vhi[i][2],vhi[i][3]}
  #define PIN(x) asm volatile("":"+v"(x))
  #define MX3(a,b,c) __builtin_fmaxf(__builtin_fmaxf((a),(b)),(c))
  #define GAPA(MF,A0,A1,A2,A3,W0,W1,PW) do{ MF; sacc+=A0; sacc+=A1; sacc+=A2; sacc+=A3; PIN(sacc); W0; W1; PIN(PW); SBAR(); }while(0)
  #define EX(v) __builtin_amdgcn_exp2f(v)
  #define GAPB(MF,X,B) do{ MF; X[B]=EX(X[B]); X[B+1]=EX(X[B+1]); X[B+2]=EX(X[B+2]); X[B+3]=EX(X[B+3]); PIN(X); SBAR(); }while(0)
  #define VRD(i) do{ vlo[i]=vtr(vp_+(((i)>>2)*4096+((i)&3)*1024)); vhi[i]=vtr(vp_+(((i)>>2)*4096+((i)&3)*1024+512)); }while(0)
  #define KRD(G,j) do{ if(G){ kload2(kf,kp0+sl_next,j); SBAR(); } }while(0)
  #define STEP(C0,C1,P0,P1,t,GK,GV,GL) do{ SBAR(); \
    const lds_cptr vp_=vp0+sl_prev; \
    { const bf16x8 kb0_=KBF(t,0),kb1_=KBF(t,1); C0=__builtin_amdgcn_mfma_f32_32x32x16_bf16(kb0_,qone,negm,0,0,0); C1=__builtin_amdgcn_mfma_f32_32x32x16_bf16(kb1_,qone,negm,0,0,0); SBAR(); } \
    VRD(0); SBAR(); float sacc=(P0[0]+P0[1]); \
    GAPA(C0=__builtin_amdgcn_mfma_f32_32x32x16_bf16(kf[0],qr[0],C0,0,0,0), P0[2],P0[3],P0[4],P0[5],     pw0[0]=PKW(P0,0), pw0[1]=PKW(P0,2), pw0); \
    VRD(4); SBAR(); GAPA(C1=__builtin_amdgcn_mfma_f32_32x32x16_bf16(kf[1],qr[0],C1,0,0,0), P0[6],P0[7],P0[8],P0[9],     pw0[2]=PKW(P0,4), pw0[3]=PKW(P0,6), pw0); \
    VRD(1); SBAR(); GAPA(C0=__builtin_amdgcn_mfma_f32_32x32x16_bf16(kf[2],qr[1],C0,0,0,0),   P0[10],P0[11],P0[12],P0[13], pw1[0]=PKW(P0,8), pw1[1]=PKW(P0,10), pw1); \
    VRD(5); SBAR(); GAPA(C1=__builtin_amdgcn_mfma_f32_32x32x16_bf16(kf[3],qr[1],C1,0,0,0),   P0[14],P0[15],P1[0],P1[1],   pw1[2]=PKW(P0,12),pw1[3]=PKW(P0,14), pw1); \
    VRD(2); SBAR(); GAPA(C0=__builtin_amdgcn_mfma_f32_32x32x16_bf16(kf[4],qr[2],C0,0,0,0),   P1[2],P1[3],P1[4],P1[5],     pw2[0]=PKW(P1,0), pw2[1]=PKW(P1,2), pw2); \
    VRD(6); SBAR(); GAPA(C1=__builtin_amdgcn_mfma_f32_32x32x16_bf16(kf[5],qr[2],C1,0,0,0),   P1[6],P1[7],P1[8],P1[9],     pw2[2]=PKW(P1,4), pw2[3]=PKW(P1,6), pw2); \
    VRD(3); SBAR(); GAPA(C0=__builtin_amdgcn_mfma_f32_32x32x16_bf16(kf[6],qr[3],C0,0,0,0),   P1[10],P1[11],P1[12],P1[13], pw3[0]=PKW(P1,8), pw3[1]=PKW(P1,10), pw3); \
    VRD(7); SBAR(); GAPA(C1=__builtin_amdgcn_mfma_f32_32x32x16_bf16(kf[7],qr[3],C1,0,0,0),   P1[14],P1[15],0.f,0.f,       pw3[2]=PKW(P1,12),pw3[3]=PKW(P1,14), pw3); \
    l_reg+=sacc; \
    if(GK){DMA_K((t)+3,sl_cur);} if(GV){DMA_V((t)+1,sl_next);} \
    CMASK(C0,C1,t); \
    { float a=MX3(C0[0],C0[1],C1[0]),b=MX3(C0[2],C0[3],C1[1]); a=MX3(a,C1[2],C1[3]); \
      _Pragma("unroll") for(int r=4;r<16;r+=4){a=MX3(a,C0[r],C0[r+1]);b=MX3(b,C0[r+2],C0[r+3]);a=MX3(a,C1[r],C1[r+1]);b=MX3(b,C1[r+2],C1[r+3]);} \
      float rm=__builtin_fmaxf(a,b); { auto rr=__builtin_amdgcn_permlane32_swap(__float_as_uint(rm),__float_as_uint(rm),false,false); rm=__builtin_fmaxf(__uint_as_float(rr[0]),__uint_as_float(rr[1])); } \
      resc=false; \
      if(__builtin_expect(__any(rm>(float)THRL),0)){ const float dl=__builtin_fmaxf(rm,0.f); mhat+=dl; \
        _Pragma("unroll") for(int r=0;r<16;++r){C0[r]-=dl;C1[r]-=dl;} \
        _Pragma("unroll") for(int r=0;r<16;++r)negm[r]=qbias-mhat; asm volatile("":"+v"(negm)); \
        const float f=__builtin_amdgcn_exp2f(-dl); l_reg*=f; if(hi==0)wsf[r32]=f; resc=true; } } \
    SBAR(); \
    GAPB(o[0]=__builtin_amdgcn_mfma_f32_32x32x16_bf16(PAF(0),VFR(0),o[0],0,0,0), C0,0); \
    GAPB(o[1]=__builtin_amdgcn_mfma_f32_32x32x16_bf16(PAF(0),VFR(4),o[1],0,0,0), C0,4); \
    KRD(GL,0); GAPB(o[0]=__builtin_amdgcn_mfma_f32_32x32x16_bf16(PAF(1),VFR(1),o[0],0,0,0), C0,8); \
    KRD(GL,1); GAPB(o[1]=__builtin_amdgcn_mfma_f32_32x32x16_bf16(PAF(1),VFR(5),o[1],0,0,0), C0,12); \
    KRD(GL,2); GAPB(o[0]=__builtin_amdgcn_mfma_f32_32x32x16_bf16(PAF(2),VFR(2),o[0],0,0,0), C1,0); \
    KRD(GL,3); GAPB(o[1]=__builtin_amdgcn_mfma_f32_32x32x16_bf16(PAF(2),VFR(6),o[1],0,0,0), C1,4); \
    GAPB(o[0]=__builtin_amdgcn_mfma_f32_32x32x16_bf16(PAF(3),VFR(3),o[0],0,0,0), C1,8); \
    GAPB(o[1]=__builtin_amdgcn_mfma_f32_32x32x16_bf16(PAF(3),VFR(7),o[1],0,0,0), C1,12); \
    }while(0)
  int t=1;
  #undef CMASK
  #define CMASK(P0,P1,t) do{}while(0)
  for(;t+5<NT;t+=2){
    STEP(pB0,pB1,pA0,pA1,t,true,true,true);     WAIT_BAR(2); RESC(); ROT();
    STEP(pA0,pA1,pB0,pB1,t+1,true,true,true);   WAIT_BAR(2); RESC(); ROT();
  }
  #undef CMASK
  #define CMASK(P0,P1,t) do{int jb_=(t)-(NT-4); if(jb_>=0)cmask(P0,P1,jb_,qrel,hi);}while(0)
  #define ENDW(tt) do{ if((tt)+3<NT){WAIT_BAR(2);} else if((tt)+2<NT){WAIT_BAR(1);} else {WAIT_BAR(0);} }while(0)
  for(;t+1<NT;t+=2){
    STEP(pB0,pB1,pA0,pA1,t,(t+3<NT),(t+1<NT),(t+1<NT));       ENDW(t);   RESC(); ROT();
    STEP(pA0,pA1,pB0,pB1,t+1,(t+4<NT),(t+2<NT),(t+2<NT));     ENDW(t+1); RESC(); ROT();
  }
  STEP(pB0,pB1,pA0,pA1,NT-1,false,false,false); RESC();
  { float sacc=pB0[0]+pB0[1]; _Pragma("unroll") for(int r=2;r<16;++r)sacc+=pB0[r]; _Pragma("unroll") for(int r=0;r<16;++r)sacc+=pB1[r]; l_reg+=sacc;
    pw0=(u32x4){PKW(pB0,0),PKW(pB0,2),PKW(pB0,4),PKW(pB0,6)};pw1=(u32x4){PKW(pB0,8),PKW(pB0,10),PKW(pB0,12),PKW(pB0,14)};pw2=(u32x4){PKW(pB1,0),PKW(pB1,2),PKW(pB1,4),PKW(pB1,6)};pw3=(u32x4){PKW(pB1,8),PKW(pB1,10),PKW(pB1,12),PKW(pB1,14)};
    SBAR(); pv(o,vb0+sl_cur,PAF(0),PAF(1),PAF(2),PAF(3)); }
  #undef PKW
  #undef PAF
  #undef VFR
  #undef PIN
  #undef MX3
  #undef GAPA
  #undef GAPB
  #undef EX
  #undef VRD
  #undef KRD
  #undef STEP
  #undef ENDW
  {auto rr=__builtin_amdgcn_permlane32_swap(__float_as_uint(l_reg),__float_as_uint(l_reg),false,false);l_reg=__uint_as_float(rr[0])+__uint_as_float(rr[1]);}
  if(hi==0)wsf[32+r32]=l_reg;asm volatile("s_waitcnt lgkmcnt(0)":::"memory");
  float rli[16];
  #pragma unroll
  for(int r=0;r<16;++r)rli[r]=__builtin_amdgcn_rcpf(wsf[32+crow(r,hi)]);
  bf16*Ow=O+(rowbase+q0+wid*QBLK)*OP+h*D;
  { bf16*stg=(bf16*)(shm+LDS_OST)+wid*2048;
    #pragma unroll
    for(int r=0;r<16;++r){const int orow=crow(r,hi);
      #pragma unroll
      for(int d0=0;d0<2;++d0)stg[orow*64+d0*32+r32]=__float2bfloat16(o[d0][r]*rli[r]);}
    asm volatile("s_waitcnt lgkmcnt(0)":::"memory");
    #pragma unroll
    for(int i=0;i<4;++i){const int row=i*8+(lane>>3),ch=lane&7; const u32x4 v=*(const u32x4*)(stg+row*64+ch*8); ATTN_STORE16(Ow+(long)row*OP+ch*8,v);} }
  asm volatile("s_waitcnt lgkmcnt(0)\n\ts_barrier":::"memory");
  #undef KBF
  #undef DMA_K
  #undef DMA_V
  #undef CMASK
  #undef START
  #undef RESC
  #undef ROT
}
constexpr int ATTN_LDS_BYTES=LDS_BYTES;
struct AttnTensors { const bf16* Q; const bf16* K; const bf16* V; bf16* O; const float* Cum; const float* Lq; };
struct AttnUnit { int bh; int qb; };
struct StaticOrder {
  int a,na;
  __device__ __forceinline__ StaticOrder(int a_,int na_):a(a_),na(na_){}
  __device__ __forceinline__ bool next(int i,AttnUnit&u)const{ const int bh=a+(i/NQB)*na; if(a<0||bh>=BATCH*NHEAD)return false; u.bh=bh; u.qb=NQB-1-(i%NQB); return true; }
  __device__ __forceinline__ void a_ready(const AttnUnit&)const{}
  __device__ __forceinline__ void done(const AttnUnit&)const{}
};
template<class Sched,int THRL=16> __device__ __forceinline__ void attn_phase(char*lds,const AttnTensors&T,const Sched&S){
  AttnUnit u;
  for(int i=0;S.next(i,u);++i){ S.a_ready(u); attn_unit<THRL>(u.bh/NHEAD,u.bh%NHEAD,u.qb,T.Q,T.K,T.V,T.O,T.Cum,T.Lq,lds); S.done(u); }
}
#undef SBAR
#undef WAIT_BAR
}
constexpr int NWAVES = 8;
#ifndef MK_N_LAUNCHES
#define MK_N_LAUNCHES 1
#endif
constexpr int PER_PHASE = 9;
constexpr int N_LAUNCHES = MK_N_LAUNCHES;
static_assert(N_LAUNCHES == 1 || N_LAUNCHES == PER_PHASE, "MK_N_LAUNCHES is 1 or 9");

constexpr int BATCH = 16, T = 2048, D = 1024, HD = 64, FOXH = 8, RWKVH = 8, FF = 2816;
constexpr int M = BATCH * T;
constexpr int IN_COLS = 3368;
constexpr int NIN = 3584;
constexpr int PC_Q = 0, PC_K = 512, PC_V = 1024, PC_R = 1536, PC_RK = 2048, PC_RV = 2560, PC_WDN = 3072, PC_ADN = 3136, PC_GDN = 3200, PC_F = 3360;
constexpr int NGU = 2 * FF;
constexpr float RMS_EPS = 1e-6f, GN_EPS = 64e-5f, L2_EPS = 1e-12f;
constexpr float LOG2E = 1.4426950408889634f;

constexpr size_t MiB = 1u << 20, KiB = 1u << 10;
constexpr size_t WS_CTL = 0, CTL_ZERO_BYTES = 64 * KiB;
constexpr size_t WS_WIN = 1 * MiB, WS_WOUT = 8 * MiB, WS_WGU = 10 * MiB, WS_WDN = 21 * MiB;
constexpr size_t WS_W2T = 27 * MiB, WS_A2T = WS_W2T + 64 * KiB, WS_G2T = WS_A2T + 64 * KiB;
constexpr size_t WS_MOD = 27 * MiB + 512 * KiB;
constexpr size_t WS_LQ = 27 * MiB + 960 * KiB;
constexpr size_t WS_CUM = 28 * MiB;
constexpr size_t WS_XN = 32 * MiB;
constexpr size_t WS_QN = 96 * MiB, WS_KN = 128 * MiB;
constexpr size_t WS_MIX = 160 * MiB;
constexpr size_t WS_P = 224 * MiB;
constexpr size_t WS_HH = WS_P;
constexpr size_t WS_END = 448 * MiB;
static_assert(WS_WIN + (size_t)NIN * D * 2 <= WS_WOUT && WS_WGU + (size_t)NGU * D * 2 <= WS_WDN && WS_WDN + (size_t)D * FF * 2 <= WS_W2T && WS_G2T + 512 * 160 * 2 <= WS_MOD && WS_MOD + 16 * 6144 * 4 <= WS_LQ, "ws map");
static_assert(WS_P + (size_t)M * NIN * 2 <= WS_END && WS_HH + (size_t)M * FF * 2 <= WS_END, "ws map");
constexpr int CW_TMO = 0, CW_CODE = 1;
constexpr int CW_BAR = 4096;

constexpr int RING_OFF = 0, RING_BYTES = 131072;
constexpr int LDSCTL_OFF = RING_BYTES, MISC_OFF = LDSCTL_OFF + 320;
constexpr int LDS_BYTES = 147456;
static_assert(MISC_OFF + 128 <= LDS_BYTES, "LDS map");
#define GAS __attribute__((address_space(1)))
#define LAS __attribute__((address_space(3)))
typedef unsigned short bf16;
typedef unsigned v4u __attribute__((ext_vector_type(4)));
typedef float f32x4 __attribute__((ext_vector_type(4)));
typedef short bf16x8 __attribute__((ext_vector_type(8)));
typedef GAS unsigned gu32;
typedef GAS unsigned long long gu64;
#define RLX_AGENT __ATOMIC_RELAXED, __HIP_MEMORY_SCOPE_AGENT
#define LDS_WAIT() asm volatile("s_waitcnt lgkmcnt(0)" ::: "memory")
#define VM_WAIT() asm volatile("s_waitcnt vmcnt(0)" ::: "memory")
__device__ __forceinline__ unsigned long long rt() { return __builtin_amdgcn_s_memrealtime(); }
__device__ __forceinline__ unsigned f2bf(float f) { unsigned u = __builtin_bit_cast(unsigned, f); return (u + 0x7fffu + ((u >> 16) & 1u)) >> 16; }
__device__ __forceinline__ unsigned pk2(float lo, float hi) { return f2bf(lo) | (f2bf(hi) << 16); }

#define XB_TMO      128
#define XB_XCNT(j)  (256  + 64 * (j))
#define XB_XSUB(j)  (1280 + 64 * (j))
#define XB_XGEN(j)  (2304 + 64 * (j))
#define XB_TOP      3328
#define XB_TOPGEN   3392
#define XCD_BAR_WORDS 3456
#define XB_SPIN_CAP (1u << 18)

__device__ __forceinline__ unsigned xb_ld(unsigned* p)              { return __hip_atomic_load(p, __ATOMIC_RELAXED, __HIP_MEMORY_SCOPE_AGENT); }
__device__ __forceinline__ unsigned xb_add(unsigned* p, unsigned v) { return __hip_atomic_fetch_add(p, v, __ATOMIC_RELAXED, __HIP_MEMORY_SCOPE_AGENT); }
__device__ __forceinline__ unsigned xb_xcc_id() { return (unsigned)__builtin_amdgcn_s_getreg((3 << 11) | 20) & 0xFu; }
#define XB_SPIN(cond, bar) do { unsigned _sp = 0; while (cond) { __builtin_amdgcn_s_sleep(1); \
    if ((++_sp & 255u) == 0u) { if (xb_ld(&(bar)[XB_TMO])) break; if (_sp > XB_SPIN_CAP) { atomicAdd(&(bar)[XB_TMO], 1u); break; } } } } while (0)

struct XcdBarrier {
    unsigned* bar; unsigned x;
    volatile LAS unsigned* st;
};

__device__ __forceinline__ XcdBarrier xcd_barrier_post(unsigned* bar, volatile LAS unsigned* st) {
    XcdBarrier b; b.bar = bar; b.x = xb_xcc_id(); b.st = st;
    if (threadIdx.x == 0) (void)xb_add(&bar[XB_XCNT(b.x)], 1u);
    return b;
}
__device__ __forceinline__ void xcd_barrier_complete(unsigned* bar, unsigned x, unsigned& nloc, unsigned& nx) {
    const unsigned G = gridDim.x * gridDim.y * gridDim.z;
    unsigned sum, cnt, mine, sp = 0u;
    for (;;) {
        sum = 0u; cnt = 0u; mine = 0u;
#pragma unroll
        for (unsigned j = 0; j < 16; ++j) { const unsigned c = xb_ld(&bar[XB_XCNT(j)]); sum += c; cnt += (c > 0u) ? 1u : 0u; mine = (j == x) ? c : mine; }
        if (sum == G) break;
        __builtin_amdgcn_s_sleep(1);
        if ((++sp & 255u) == 0u) { if (xb_ld(&bar[XB_TMO])) break; if (sp > XB_SPIN_CAP) { atomicAdd(&bar[XB_TMO], 1u); break; } }
    }
    nloc = mine > 0u ? mine : 1u; nx = cnt > 0u ? cnt : 1u;
}

__device__ __forceinline__ void xcd_barrier(const XcdBarrier& b) {
    asm volatile("s_waitcnt vmcnt(0)" ::: "memory");
    __syncthreads();
    if (threadIdx.x == 0) {
        unsigned* bar = b.bar;
        __builtin_amdgcn_s_waitcnt(0);
        unsigned nloc = b.st[0], nx = b.st[1];
        if (nloc == 0u) { xcd_barrier_complete(bar, b.x, nloc, nx); b.st[0] = nloc; b.st[1] = nx; }
        const unsigned old = xb_add(&bar[XB_XSUB(b.x)], 1u);
        const unsigned gen = old / nloc;
        if (old + 1u == (gen + 1u) * nloc) {
            __builtin_amdgcn_fence(__ATOMIC_RELEASE, "agent");
            asm volatile("s_waitcnt vmcnt(0)" ::: "memory");
            const unsigned og = xb_add(&bar[XB_TOP], 1u);
            const unsigned tg = og / nx;
            if (og + 1u == (tg + 1u) * nx) xb_add(&bar[XB_TOPGEN], 1u);
            else XB_SPIN(xb_ld(&bar[XB_TOPGEN]) == tg, bar);
            __builtin_amdgcn_fence(__ATOMIC_ACQUIRE, "agent");
            xb_add(&bar[XB_XGEN(b.x)], 1u);
            asm volatile("s_waitcnt vmcnt(0)" ::: "memory");
        } else {
            XB_SPIN(xb_ld(&bar[XB_XGEN(b.x)]) == gen, bar);
            __builtin_amdgcn_fence(__ATOMIC_ACQUIRE, "agent");
            asm volatile("s_waitcnt vmcnt(0)" ::: "memory");
        }
    }
    __syncthreads();
}
typedef float f32x2 __attribute__((ext_vector_type(2)));
typedef float f32x16 __attribute__((ext_vector_type(16)));
typedef unsigned v2u __attribute__((ext_vector_type(2)));
struct Frame {
    LAS unsigned char* lds;
    volatile LAS unsigned* MISC;
    gu32* ctl;
    int tid, lane, wave;
    int vcu, G;
    const float* in[25]; float* out; unsigned char* ws;
};
enum { I_X = 0, I_C, I_ADAW, I_ADAB, I_N1G, I_N2G, I_WIN, I_FBIAS, I_QG, I_KG, I_MU, I_W0, I_W2, I_A0, I_A2, I_G2, I_KK, I_KA, I_RK, I_LNG, I_LNB, I_WOUT, I_WG, I_WU, I_WD };

__device__ __forceinline__ float wave_sum(float v) {
#pragma unroll
    for (int o = 1; o < 64; o <<= 1) v += __shfl_xor(v, o);
    return v;
}
__device__ __forceinline__ float wave_max(float v) {
#pragma unroll
    for (int o = 1; o < 64; o <<= 1) v = fmaxf(v, __shfl_xor(v, o));
    return v;
}
template <int CTRL> __device__ __forceinline__ float dpp_f(float x) { return __int_as_float(__builtin_amdgcn_update_dpp(0, __float_as_int(x), CTRL, 0xf, 0xf, true)); }
__device__ __forceinline__ float red16(float x) {
    x += dpp_f<0xB1>(x);
    x += dpp_f<0x4E>(x);
    x += dpp_f<0x141>(x);
    x += dpp_f<0x140>(x);
    return x;
}
__device__ __forceinline__ float red8(float x) {
    x += dpp_f<0xB1>(x); x += dpp_f<0x4E>(x); x += dpp_f<0x141>(x); return x;
}
__device__ __forceinline__ float bf2f(unsigned short h) { return __uint_as_float((unsigned)h << 16); }
__device__ __forceinline__ float sigmoidf_(float x) { return __builtin_amdgcn_rcpf(1.0f + __builtin_amdgcn_exp2f(-LOG2E * x)); }
__device__ __forceinline__ float tanhf_(float x) { return 1.0f - 2.0f * __builtin_amdgcn_rcpf(1.0f + __builtin_amdgcn_exp2f(2.0f * LOG2E * x)); }

template <class RowMap>
__device__ __forceinline__ void p0_transpose_item(const float* W, int K, int N, bf16* WT, int ldk, RowMap rm, LAS float* scr, int item, int lane) {
    const int nblk = (N + 31) / 32, kb = item / nblk, nb = item % nblk, k0 = 64 * kb, n0 = 32 * nb;
    const int nn = n0 + (lane & 31);
#pragma unroll 8
    for (int i = 0; i < 32; ++i) { const int kk = 2 * i + (lane >> 5); scr[kk * 33 + (lane & 31)] = (k0 + kk < K && nn < N) ? W[(size_t)(k0 + kk) * N + nn] : 0.f; }
    LDS_WAIT(); asm volatile("" ::: "memory");
    const int c = lane & 7;
#pragma unroll
    for (int j = 0; j < 4; ++j) { const int n = (lane >> 3) + 8 * j; const LAS float* s = scr + (8 * c) * 33 + n;
        v4u o; o.x = pk2(s[0 * 33], s[1 * 33]); o.y = pk2(s[2 * 33], s[3 * 33]); o.z = pk2(s[4 * 33], s[5 * 33]); o.w = pk2(s[6 * 33], s[7 * 33]);
        if (n0 + n < N && k0 + 8 * c < K) *(GAS v4u*)(WT + (size_t)rm(n0 + n) * ldk + k0 + 8 * c) = o; }
    LDS_WAIT(); asm volatile("" ::: "memory");
}
struct RmId { __device__ __forceinline__ int operator()(int n) const { return n; } };
struct RmWin { __device__ __forceinline__ int operator()(int n) const { return n < 1536 ? n : (n < 1544 ? PC_F + (n - 1536) : (n - 1544) + PC_R); } };
struct RmGate { int up; __device__ __forceinline__ int operator()(int n) const { return (n >> 7) * 256 + (n & 127) + up * 128; } };

__device__ __forceinline__ void p0_prologue(Frame& F) {
    LAS float* scr = (LAS float*)(F.lds + RING_OFF + F.wave * 16384);
    const int gw = F.vcu * NWAVES + F.wave, NGW = F.G * NWAVES;
    bf16* WIN = (bf16*)(F.ws + WS_WIN); bf16* WOUT = (bf16*)(F.ws + WS_WOUT); bf16* WGU = (bf16*)(F.ws + WS_WGU); bf16* WDN = (bf16*)(F.ws + WS_WDN);
    bf16* W2T = (bf16*)(F.ws + WS_W2T); bf16* A2T = (bf16*)(F.ws + WS_A2T); bf16* G2T = (bf16*)(F.ws + WS_G2T);
    if (F.vcu < 6144 / 32) {
        LAS float* sc = (LAS float*)(F.lds + RING_OFF);
        LAS float* red = (LAS float*)(F.lds + RING_OFF + 65536);
        const float* cin = F.in[I_C];
        for (int i = F.tid; i < 16 * 1024; i += NWAVES * 64) { const int b = i >> 10, k = i & 1023; const float v = cin[i]; sc[k * 16 + b] = v * sigmoidf_(v); }
        __syncthreads();
        const int col = F.tid & 31, kg = F.tid >> 5, j0 = F.vcu * 32;
        float acc[16];
#pragma unroll
        for (int b = 0; b < 16; ++b) acc[b] = 0.f;
        const float* wp = F.in[I_ADAW] + (size_t)(kg * 64) * 6144 + j0 + col;
        for (int k = 0; k < 64; ++k) { const float w = wp[(size_t)k * 6144]; const LAS f32x4* s4 = (const LAS f32x4*)(sc + (kg * 64 + k) * 16);
#pragma unroll
            for (int q = 0; q < 4; ++q) { const f32x4 s = s4[q]; acc[4 * q] += s.x * w; acc[4 * q + 1] += s.y * w; acc[4 * q + 2] += s.z * w; acc[4 * q + 3] += s.w * w; } }
#pragma unroll
        for (int b = 0; b < 16; ++b) red[(kg * 16 + b) * 32 + col] = acc[b];
        __syncthreads();
        { const int b = F.tid >> 5; float s = F.in[I_ADAB][j0 + col];
#pragma unroll
          for (int g = 0; g < 16; ++g) s += red[(g * 16 + b) * 32 + col];
          ((float*)(F.ws + WS_MOD))[b * 6144 + j0 + col] = s; }
        __syncthreads();
    }
    constexpr int I_IN = (D / 64) * ((IN_COLS + 31) / 32), I_O = (D / 64) * (D / 32), I_G = (D / 64) * (FF / 32), I_D = (FF / 64) * (D / 32), I_L = 512 / 32, I_LG = 3 * (512 / 32);
    constexpr int NITEMS = I_IN + I_O + 2 * I_G + I_D + 2 * I_L + I_LG;
    for (int it = gw; it < NITEMS; it += NGW) {
        int r = it;
        if (r < I_IN) { p0_transpose_item(F.in[I_WIN], D, IN_COLS, WIN, D, RmWin{}, scr, r, F.lane); continue; } r -= I_IN;
        if (r < I_O) { p0_transpose_item(F.in[I_WOUT], D, D, WOUT, D, RmId{}, scr, r, F.lane); continue; } r -= I_O;
        if (r < I_G) { p0_transpose_item(F.in[I_WG], D, FF, WGU, D, RmGate{0}, scr, r, F.lane); continue; } r -= I_G;
        if (r < I_G) { p0_transpose_item(F.in[I_WU], D, FF, WGU, D, RmGate{1}, scr, r, F.lane); continue; } r -= I_G;
        if (r < I_D) { p0_transpose_item(F.in[I_WD], FF, D, WDN, FF, RmId{}, scr, r, F.lane); continue; } r -= I_D;
        if (r < I_L) { p0_transpose_item(F.in[I_W2], 64, 512, W2T, 64, RmId{}, scr, r, F.lane); continue; } r -= I_L;
        if (r < I_L) { p0_transpose_item(F.in[I_A2], 64, 512, A2T, 64, RmId{}, scr, r, F.lane); continue; } r -= I_L;
        p0_transpose_item(F.in[I_G2], 160, 512, G2T, 160, RmId{}, scr, r, F.lane);
    }
    { const int gt = F.vcu * NWAVES * 64 + F.tid, NGT = F.G * NWAVES * 64; GAS v4u* z = (GAS v4u*)(WIN + (size_t)IN_COLS * D);
      for (int i = gt; i < (NIN - IN_COLS) * D / 8; i += NGT) z[i] = (v4u){0u, 0u, 0u, 0u}; }
    if (gw < FOXH) { const float gq = wave_max(fabsf(F.in[I_QG][gw * 64 + F.lane])), gk = wave_max(fabsf(F.in[I_KG][gw * 64 + F.lane]));
        const float bh = 8.0f * gq * gk * LOG2E * 1.001f; if (F.lane == 0) ((float*)(F.ws + WS_LQ))[gw] = fminf(0.f, 100.f - bh); }
}

__device__ __forceinline__ void xn_pass(Frame& F, const float* x, const float* gain, int shift_off, int scale_off) {
    const int gw = F.vcu * NWAVES + F.wave, NGW = F.G * NWAVES; const float* mod = (const float*)(F.ws + WS_MOD); bf16* XN = (bf16*)(F.ws + WS_XN);
    for (int m = gw; m < M; m += NGW) {
        const GAS f32x4* xr = (const GAS f32x4*)(x + (size_t)m * D) + F.lane; const int b = m >> 11;
        f32x4 v[4]; float s = 0.f;
#pragma unroll
        for (int j = 0; j < 4; ++j) { v[j] = xr[64 * j]; s += (v[j].x * v[j].x + v[j].y * v[j].y) + (v[j].z * v[j].z + v[j].w * v[j].w); }
        const float rs = 1.0f / sqrtf(wave_sum(s) * (1.f / D) + RMS_EPS);
        GAS unsigned long long* o8 = (GAS unsigned long long*)(XN + (size_t)m * D) + F.lane;
#pragma unroll
        for (int j = 0; j < 4; ++j) { const int c = 4 * F.lane + 256 * j;
            const f32x4 g = *(const f32x4*)(gain + c), sc = *(const f32x4*)(mod + b * 6144 + scale_off + c), sh = *(const f32x4*)(mod + b * 6144 + shift_off + c);
            const f32x4 y = (v[j] * rs) * g * (sc + 1.0f) + sh;
            o8[64 * j] = (unsigned long long)pk2(y.x, y.y) | ((unsigned long long)pk2(y.z, y.w) << 32); }
    }
}

__device__ __forceinline__ void fox_prep(Frame& F) {
    const int gw = F.vcu * NWAVES + F.wave, NGW = F.G * NWAVES; const bf16* P = (const bf16*)(F.ws + WS_P); bf16* QN = (bf16*)(F.ws + WS_QN); bf16* KN = (bf16*)(F.ws + WS_KN);
    if (gw < BATCH) {
        const int b = gw; float* CUM = (float*)(F.ws + WS_CUM) + (size_t)b * FOXH * T; const float* fb = F.in[I_FBIAS];
        float bias[8]; float tot[8];
#pragma unroll
        for (int h = 0; h < 8; ++h) { bias[h] = fb[h]; tot[h] = 0.f; }
        const bf16* fp = P + ((size_t)b * T + 32 * F.lane) * NIN + PC_F;
        for (int i = 0; i < 32; ++i) { const v4u w = *(const GAS v4u*)(fp + (size_t)i * NIN); const unsigned ww[4] = {w.x, w.y, w.z, w.w};
#pragma unroll
            for (int h = 0; h < 8; ++h) { const float z = bf2f((unsigned short)(ww[h >> 1] >> (16 * (h & 1)))) + bias[h]; tot[h] += fminf(z, 0.f) - log1pf(expf(-fabsf(z))); } }
        float off[8];
#pragma unroll
        for (int h = 0; h < 8; ++h) { float incl = tot[h];
#pragma unroll
            for (int o = 1; o < 64; o <<= 1) { const float t = __shfl_up(incl, o); if (F.lane >= o) incl += t; }
            off[h] = incl - tot[h]; }
        for (int i = 0; i < 32; ++i) { const v4u w = *(const GAS v4u*)(fp + (size_t)i * NIN); const unsigned ww[4] = {w.x, w.y, w.z, w.w};
#pragma unroll
            for (int h = 0; h < 8; ++h) { const float z = bf2f((unsigned short)(ww[h >> 1] >> (16 * (h & 1)))) + bias[h]; off[h] += fminf(z, 0.f) - log1pf(expf(-fabsf(z)));
                CUM[h * T + 32 * F.lane + i] = off[h] * LOG2E; } }
    }
    const float* qg = F.in[I_QG]; const float* kg = F.in[I_KG];
    f32x4 gq0 = *(const f32x4*)(qg + 8 * F.lane), gq1 = *(const f32x4*)(qg + 8 * F.lane + 4), gk0 = *(const f32x4*)(kg + 8 * F.lane), gk1 = *(const f32x4*)(kg + 8 * F.lane + 4);
    const float C2 = 0.125f * LOG2E;
    for (int m = gw; m < M; m += NGW) {
        const v4u qw = *(const GAS v4u*)(P + (size_t)m * NIN + PC_Q + 8 * F.lane), kw = *(const GAS v4u*)(P + (size_t)m * NIN + PC_K + 8 * F.lane);
        float q[8], k[8]; const unsigned qq[4] = {qw.x, qw.y, qw.z, qw.w}, kk[4] = {kw.x, kw.y, kw.z, kw.w};
        float sq = 0.f, sk = 0.f;
#pragma unroll
        for (int i = 0; i < 8; ++i) { q[i] = bf2f((unsigned short)(qq[i >> 1] >> (16 * (i & 1)))); k[i] = bf2f((unsigned short)(kk[i >> 1] >> (16 * (i & 1)))); sq += q[i] * q[i]; sk += k[i] * k[i]; }
        sq = red8(sq); sk = red8(sk);
        const float rq = C2 / sqrtf(sq * (1.f / 64.f) + RMS_EPS), rk = 1.0f / sqrtf(sk * (1.f / 64.f) + RMS_EPS);
        v4u oq, ok;
        oq.x = pk2(q[0] * rq * gq0.x, q[1] * rq * gq0.y); oq.y = pk2(q[2] * rq * gq0.z, q[3] * rq * gq0.w); oq.z = pk2(q[4] * rq * gq1.x, q[5] * rq * gq1.y); oq.w = pk2(q[6] * rq * gq1.z, q[7] * rq * gq1.w);
        ok.x = pk2(k[0] * rk * gk0.x, k[1] * rk * gk0.y); ok.y = pk2(k[2] * rk * gk0.z, k[3] * rk * gk0.w); ok.z = pk2(k[4] * rk * gk1.x, k[5] * rk * gk1.y); ok.w = pk2(k[6] * rk * gk1.z, k[7] * rk * gk1.w);
        *(GAS v4u*)(QN + (size_t)m * 512 + 8 * F.lane) = oq; *(GAS v4u*)(KN + (size_t)m * 512 + 8 * F.lane) = ok;
    }
}

namespace rwkv {
constexpr int TC = 32;
constexpr int SC_T = 1280;
constexpr int L_SC = 0, L_AS = L_SC + TC * SC_T, L_GS = L_AS + TC * 64 * 4, L_VS = L_GS + 2 * TC * 64 * 4, L_YS = L_VS + TC * 64 * 4, L_BS = L_YS + TC * 64 * 4, L_BYTES = L_BS + TC * 4;
static_assert(L_BYTES <= RING_BYTES, "scan LDS");
__device__ __forceinline__ int crow(int r, int hi) { return (r & 3) + 8 * (r >> 2) + 4 * hi; }
__device__ __forceinline__ void lerp8(float (&x)[8], const bf16* cur, const bf16* prv, bool has_prev, const float* mu) {
    const v4u c = *(const GAS v4u*)cur; v4u p = (v4u){0u, 0u, 0u, 0u}; if (has_prev) p = *(const GAS v4u*)prv;
    const f32x4 m0 = *(const f32x4*)mu, m1 = *(const f32x4*)(mu + 4); const float mm[8] = {m0.x, m0.y, m0.z, m0.w, m1.x, m1.y, m1.z, m1.w};
    const unsigned cc[4] = {c.x, c.y, c.z, c.w}, pp[4] = {p.x, p.y, p.z, p.w};
#pragma unroll
    for (int i = 0; i < 8; ++i) { const float a = bf2f((unsigned short)(cc[i >> 1] >> (16 * (i & 1)))), b = bf2f((unsigned short)(pp[i >> 1] >> (16 * (i & 1)))); x[i] = a + (b - a) * mm[i]; }
}
__device__ __forceinline__ void lerp4(float (&x)[4], const bf16* cur, const bf16* prv, bool has_prev, const float* mu) {
    const v2u c = *(const GAS v2u*)cur; v2u p = (v2u){0u, 0u}; if (has_prev) p = *(const GAS v2u*)prv;
    const f32x4 m0 = *(const f32x4*)mu; const float mm[4] = {m0.x, m0.y, m0.z, m0.w};
    const unsigned cc[2] = {c.x, c.y}, pp[2] = {p.x, p.y};
#pragma unroll
    for (int i = 0; i < 4; ++i) { const float a = bf2f((unsigned short)(cc[i >> 1] >> (16 * (i & 1)))), b = bf2f((unsigned short)(pp[i >> 1] >> (16 * (i & 1)))); x[i] = a + (b - a) * mm[i]; }
}

__device__ __forceinline__ void unit(Frame& F, int b, int h) {
    LAS unsigned char* L = F.lds + RING_OFF;
    LAS float* A_s = (LAS float*)(L + L_AS); LAS float* G_s = (LAS float*)(L + L_GS); LAS float* V_s = (LAS float*)(L + L_VS); LAS float* Y_s = (LAS float*)(L + L_YS); LAS float* B_s = (LAS float*)(L + L_BS);
    const bf16* P = (const bf16*)(F.ws + WS_P); bf16* MIX = (bf16*)(F.ws + WS_MIX);
    const bf16* W2T = (const bf16*)(F.ws + WS_W2T); const bf16* A2T = (const bf16*)(F.ws + WS_A2T); const bf16* G2T = (const bf16*)(F.ws + WS_G2T);
    const float* mu = F.in[I_MU];
    const int lane = F.lane, w = F.wave, hi = lane >> 5, r32 = lane & 31;
    const size_t rowbase = (size_t)b * T;
    const int kg = lane & 15, vr = lane >> 4, v0 = 8 * w + 2 * vr;
    float S0[4] = {0.f, 0.f, 0.f, 0.f}, S1[4] = {0.f, 0.f, 0.f, 0.f};
    const int te = F.tid >> 4, cq = F.tid & 15, c0 = h * 64 + 4 * cq;
    const f32x4 kk4 = *(const f32x4*)(F.in[I_KK] + c0), ka4 = *(const f32x4*)(F.in[I_KA] + c0), rk4 = *(const f32x4*)(F.in[I_RK] + c0), lg4 = *(const f32x4*)(F.in[I_LNG] + c0), lb4 = *(const f32x4*)(F.in[I_LNB] + c0);
    for (int t0 = 0; t0 < T; t0 += TC) {
        {
            const int cb = w & 1; const size_t row = rowbase + t0 + r32; const bool hp = (t0 + r32) > 0;
            f32x16 acc = {};
            int dcol, ks0, ks1, ldw; const bf16* wt;
            if (w < 2) { dcol = PC_WDN; ks0 = 0; ks1 = 4; ldw = 64; wt = W2T; } else if (w < 4) { dcol = PC_ADN; ks0 = 0; ks1 = 4; ldw = 64; wt = A2T; } else { dcol = PC_GDN; ks0 = 5 * ((w >> 1) & 1); ks1 = ks0 + 5; ldw = 160; wt = G2T; }
            wt += (size_t)(h * 64 + 32 * cb + r32) * ldw;
            for (int ks = ks0; ks < ks1; ++ks) { const int k0 = 16 * ks + 8 * hi; float x[8];
                lerp8(x, P + row * NIN + dcol + k0, P + (row - 1) * NIN + dcol + k0, hp, mu + (dcol - PC_R) + k0);
                if (w < 2) {
#pragma unroll
                    for (int i = 0; i < 8; ++i) x[i] = tanhf_(x[i]);
                } else if (w >= 4) {
#pragma unroll
                    for (int i = 0; i < 8; ++i) x[i] = sigmoidf_(x[i]);
                }
                const bf16x8 af = __builtin_bit_cast(bf16x8, (v4u){pk2(x[0], x[1]), pk2(x[2], x[3]), pk2(x[4], x[5]), pk2(x[6], x[7])});
                const bf16x8 bfr = *(const GAS bf16x8*)(wt + k0);
                acc = __builtin_amdgcn_mfma_f32_32x32x16_bf16(af, bfr, acc, 0, 0, 0); }
            const int c = 32 * cb + r32;
            if (w < 2) { const float w0 = F.in[I_W0][h * 64 + c];
#pragma unroll
                for (int r = 0; r < 16; ++r) { const int t = crow(r, hi); const float sg = sigmoidf_(w0 + acc[r]);
                    *(LAS float*)(L + L_SC + t * SC_T + (c >> 2) * 80 + 32 + (c & 3) * 4) = __builtin_amdgcn_exp2f(-0.6065306597126334f * LOG2E * sg); }
            } else if (w < 4) { const float a0 = F.in[I_A0][h * 64 + c];
#pragma unroll
                for (int r = 0; r < 16; ++r) A_s[crow(r, hi) * 64 + c] = sigmoidf_(a0 + acc[r]);
            } else { LAS float* gs = G_s + ((w >> 1) & 1) * TC * 64;
#pragma unroll
                for (int r = 0; r < 16; ++r) gs[crow(r, hi) * 64 + c] = acc[r];
            }
        }
        __syncthreads();
        {
            const size_t row = rowbase + t0 + te; const bool hp = (t0 + te) > 0;
            float r[4], k[4], v[4];
            lerp4(r, P + row * NIN + PC_R + c0, P + (row - 1) * NIN + PC_R + c0, hp, mu + c0);
            lerp4(k, P + row * NIN + PC_RK + c0, P + (row - 1) * NIN + PC_RK + c0, hp, mu + 512 + c0);
            lerp4(v, P + row * NIN + PC_RV + c0, P + (row - 1) * NIN + PC_RV + c0, hp, mu + 1024 + c0);
            const f32x4 a4 = *(const LAS f32x4*)(A_s + te * 64 + 4 * cq);
            const float kkv[4] = {k[0] * kk4.x, k[1] * kk4.y, k[2] * kk4.z, k[3] * kk4.w};
            const float ss = red16((kkv[0] * kkv[0] + kkv[1] * kkv[1]) + (kkv[2] * kkv[2] + kkv[3] * kkv[3]));
            const float inv = 1.0f / fmaxf(sqrtf(ss), L2_EPS);
            const float av[4] = {a4.x, a4.y, a4.z, a4.w}, kav[4] = {ka4.x, ka4.y, ka4.z, ka4.w}, rkv[4] = {rk4.x, rk4.y, rk4.z, rk4.w};
            f32x4 o_a, o_b, o_k, o_r; float bon = 0.f;
#pragma unroll
            for (int i = 0; i < 4; ++i) { const float kn = kkv[i] * inv; const float k2 = k[i] * (1.0f + (av[i] - 1.0f) * kav[i]); o_a[i] = -kn; o_b[i] = kn * av[i]; o_k[i] = k2; o_r[i] = r[i]; bon += r[i] * k2 * rkv[i]; }
            bon = red16(bon);
            LAS unsigned char* rec = L + L_SC + te * SC_T + cq * 80;
            *(LAS f32x4*)(rec) = o_a; *(LAS f32x4*)(rec + 16) = o_b; *(LAS f32x4*)(rec + 48) = o_k; *(LAS f32x4*)(rec + 64) = o_r;
            *(LAS f32x4*)(V_s + te * 64 + 4 * cq) = (f32x4){v[0], v[1], v[2], v[3]};
            if (cq == 0) B_s[te] = bon;
        }
        __syncthreads();
        {
            const LAS unsigned char* rec = L + L_SC + kg * 80; const LAS float* vs = V_s + v0; LAS float* ys = Y_s + v0;
            f32x4 a4 = *(const LAS f32x4*)(rec), b4 = *(const LAS f32x4*)(rec + 16), d4 = *(const LAS f32x4*)(rec + 32), k4 = *(const LAS f32x4*)(rec + 48), r4 = *(const LAS f32x4*)(rec + 64);
            f32x2 vv = *(const LAS f32x2*)(vs);
            for (int t = 0; t < TC; ++t) {
                const int tn = (t + 1 < TC) ? t + 1 : t; const LAS unsigned char* rn = rec + tn * SC_T;
                const f32x4 na = *(const LAS f32x4*)(rn), nb = *(const LAS f32x4*)(rn + 16), nd = *(const LAS f32x4*)(rn + 32), nk = *(const LAS f32x4*)(rn + 48), nr = *(const LAS f32x4*)(rn + 64);
                const f32x2 nv = *(const LAS f32x2*)(vs + tn * 64);
                float sa0 = (S0[0] * a4.x + S0[1] * a4.y) + (S0[2] * a4.z + S0[3] * a4.w), sa1 = (S1[0] * a4.x + S1[1] * a4.y) + (S1[2] * a4.z + S1[3] * a4.w);
                sa0 = red16(sa0); sa1 = red16(sa1);
#pragma unroll
                for (int j = 0; j < 4; ++j) { S0[j] = S0[j] * d4[j] + (sa0 * b4[j] + vv.x * k4[j]); S1[j] = S1[j] * d4[j] + (sa1 * b4[j] + vv.y * k4[j]); }
                float y0 = (S0[0] * r4.x + S0[1] * r4.y) + (S0[2] * r4.z + S0[3] * r4.w), y1 = (S1[0] * r4.x + S1[1] * r4.y) + (S1[2] * r4.z + S1[3] * r4.w);
                y0 = red16(y0); y1 = red16(y1);
                if (kg == 0) *(LAS f32x2*)(ys + t * 64) = (f32x2){y0, y1};
                a4 = na; b4 = nb; d4 = nd; k4 = nk; r4 = nr; vv = nv;
            }
        }
        __syncthreads();
        {
            const f32x4 y = *(const LAS f32x4*)(Y_s + te * 64 + 4 * cq);
            const float mean = red16((y.x + y.y) + (y.z + y.w)) * (1.f / 64.f);
            const f32x4 dy = y - mean;
            const float var = red16((dy.x * dy.x + dy.y * dy.y) + (dy.z * dy.z + dy.w * dy.w)) * (1.f / 64.f);
            const float rstd = 1.0f / sqrtf(var + GN_EPS);
            const f32x4 vv = *(const LAS f32x4*)(V_s + te * 64 + 4 * cq); const float bon = B_s[te];
            const f32x4 g = *(const LAS f32x4*)(G_s + te * 64 + 4 * cq) + *(const LAS f32x4*)(G_s + TC * 64 + te * 64 + 4 * cq);
            const f32x4 o = ((dy * rstd) * lg4 + lb4 + vv * bon) * g;
            *(GAS v2u*)(MIX + (rowbase + t0 + te) * 1024 + 512 + c0) = (v2u){pk2(o.x, o.y), pk2(o.z, o.w)};
        }
        __syncthreads();
    }
}
}

struct Args { const float* in[25]; float* out; unsigned char* ws; int ph_lo, ph_hi, li, pad; };
__global__ void __launch_bounds__(NWAVES * 64, 2) skel_fwd(Args args) {
    extern __shared__ __attribute__((aligned(16))) unsigned char lds[];
    Frame F;
    F.lds = (LAS unsigned char*)lds;
    F.MISC = (volatile LAS unsigned*)(F.lds + MISC_OFF);
    F.tid = threadIdx.x; F.lane = F.tid & 63; F.wave = __builtin_amdgcn_readfirstlane(F.tid >> 6);
    F.G = gridDim.x; { const int bx = blockIdx.x; F.vcu = (F.G % 8 == 0) ? (bx % 8) * (F.G / 8) + bx / 8 : bx; }
#define GRID_BAR(seam) do { if (N_LAUNCHES == PER_PHASE) { if (F.tid == 0) __hip_atomic_store(F.ctl + CW_TMO, 0xBADBA0u | (unsigned)(seam), RLX_AGENT); } \
    else { xcd_barrier(bar); } } while (0)
    unsigned char* ws = args.ws; F.ws = ws;
    F.ctl = (gu32*)(ws + WS_CTL);
#pragma unroll
    for (int i = 0; i < 25; ++i) F.in[i] = args.in[i];
    F.out = args.out;
    for (int u = F.tid; u < (LDS_BYTES - LDSCTL_OFF) / 4; u += NWAVES * 64) ((LAS unsigned*)(F.lds + LDSCTL_OFF))[u] = 0u;
    __syncthreads();
    XcdBarrier bar; bar.bar = (unsigned*)(F.ctl + CW_BAR); bar.x = 0; bar.st = nullptr;
    if (N_LAUNCHES != PER_PHASE) bar = xcd_barrier_post((unsigned*)(F.ctl + CW_BAR), F.MISC + 8);

    const int lo = args.ph_lo, hi = args.ph_hi;
#define IN(k) (lo <= (k) && (k) < hi)
#define BOTH(k) (IN(k) && IN((k) + 1))
    const float* modp = (const float*)(ws + WS_MOD);

    if (IN(0)) { p0_prologue(F); if (BOTH(0)) GRID_BAR(0); }
    if (IN(1)) { xn_pass(F, F.in[I_X], F.in[I_N1G], 0, 1024); if (BOTH(1)) GRID_BAR(1); }
    if (IN(2)) {
        pg8::Gemm g{(const bf16*)(ws + WS_XN), (const bf16*)(ws + WS_WIN), M, NIN, D}; pg8::StaticOrder S; S.init(M, NIN, F.G, (int)blockIdx.x);
        pg8::EpiBf16<0> E{(bf16*)(ws + WS_P), NIN, nullptr, 0, 0, 1.f};
        pg8::gemm_phase<pg8::EpiBf16<0>, pg8::StaticOrder, PG8_ALIGN, PG8_SP2>(F.lds + RING_OFF, g, S, E);
        if (BOTH(2)) GRID_BAR(2);
    }
    if (IN(3)) { fox_prep(F); if (BOTH(3)) GRID_BAR(3); }
    if (IN(4)) {
        const int half = F.G >> 1, me = F.vcu >> 1;
        if ((F.vcu & 1) == 0 && F.vcu < 2 * half) {
            for (int bh = me; bh < BATCH * RWKVH; bh += half) rwkv::unit(F, bh >> 3, bh & 7);
        } else if (F.vcu < 2 * half) {
            static_assert(attn_body::ATTN_LDS_BYTES <= RING_BYTES, "attention LDS");
            const attn_body::AttnTensors AT{(const attn_body::bf16*)(ws + WS_QN), (const attn_body::bf16*)(ws + WS_KN), (const attn_body::bf16*)(ws + WS_P) + PC_V, (attn_body::bf16*)(ws + WS_MIX),
                                            (const float*)(ws + WS_CUM), (const float*)(ws + WS_LQ)};
            const attn_body::StaticOrder S(me, half);
            attn_body::attn_phase<attn_body::StaticOrder>((char*)lds + RING_OFF, AT, S);
        }
        if (BOTH(4)) GRID_BAR(4);
    }
    if (IN(5)) {
        pg8::Gemm g{(const bf16*)(ws + WS_MIX), (const bf16*)(ws + WS_WOUT), M, D, D}; pg8::StaticOrder S; S.init(M, D, F.G, (int)blockIdx.x);
        pg8::EpiResGate E{F.in[I_X], F.out, modp + 2048, D, 6144};
        pg8::gemm_phase<pg8::EpiResGate, pg8::StaticOrder, PG8_ALIGN, PG8_SP2>(F.lds + RING_OFF, g, S, E);
        if (BOTH(5)) GRID_BAR(5);
    }
    if (IN(6)) { xn_pass(F, F.out, F.in[I_N2G], 3072, 4096); if (BOTH(6)) GRID_BAR(6); }
    if (IN(7)) {
        pg8::Gemm g{(const bf16*)(ws + WS_XN), (const bf16*)(ws + WS_WGU), M, NGU, D}; pg8::StaticOrder S; S.init(M, NGU, F.G, (int)blockIdx.x);
        pg8::EpiSwiGLU E{(bf16*)(ws + WS_HH), FF};
        pg8::gemm_phase<pg8::EpiSwiGLU, pg8::StaticOrder, PG8_ALIGN, PG8_SP2>(F.lds + RING_OFF, g, S, E);
        if (BOTH(7)) GRID_BAR(7);
    }
    if (IN(8)) {
        pg8::Gemm g{(const bf16*)(ws + WS_HH), (const bf16*)(ws + WS_WDN), M, D, FF}; pg8::StaticOrder S; S.init(M, D, F.G, (int)blockIdx.x);
        pg8::EpiResGate E{F.out, F.out, modp + 5120, D, 6144};
        pg8::gemm_phase<pg8::EpiResGate, pg8::StaticOrder, PG8_ALIGN, PG8_SP2>(F.lds + RING_OFF, g, S, E);
    }
#undef IN
#undef BOTH
}

extern "C" void kernel_launch(void* const* d_in, const int* in_sizes, int n_in, void* d_out, int out_size, void* d_ws, size_t ws_size, hipStream_t stream) {
    static int grid = 0;
    if (grid == 0) {
        if (n_in != 25 || in_sizes[0] != M * D || out_size != M * D || ws_size < WS_END) { fprintf(stderr, "kernel_launch: unexpected shapes (n_in %d, in0 %d, out %d, ws %zu); nothing launched\n", n_in, n_in > 0 ? in_sizes[0] : -1, out_size, ws_size); grid = -1; return; }
        int dev = 0, cus = 0, per_cu = 0;
        if (hipGetDevice(&dev) != hipSuccess || hipDeviceGetAttribute(&cus, hipDeviceAttributeMultiprocessorCount, dev) != hipSuccess) { fprintf(stderr, "kernel_launch: device query failed\n"); grid = -1; return; }
        if (hipFuncSetAttribute((const void*)skel_fwd, hipFuncAttributeMaxDynamicSharedMemorySize, LDS_BYTES) != hipSuccess) { fprintf(stderr, "kernel_launch: hipFuncSetAttribute failed\n"); grid = -1; return; }
        if (hipOccupancyMaxActiveBlocksPerMultiprocessor(&per_cu, (const void*)skel_fwd, NWAVES * 64, LDS_BYTES) != hipSuccess || per_cu < 1)
            fprintf(stderr, "kernel_launch: note: occupancy query reports %d workgroups per CU\n", per_cu);
        (void)hipGetLastError();
        grid = cus;
    }
    if (grid < 0) return;
    if (hipMemsetAsync((char*)d_ws + WS_CTL, 0, CTL_ZERO_BYTES, stream) != hipSuccess) { fprintf(stderr, "kernel_launch: hipMemsetAsync failed\n"); return; }
    Args a{};
    for (int i = 0; i < 25; ++i) a.in[i] = (const float*)d_in[i];
    a.out = (float*)d_out; a.ws = (unsigned char*)d_ws;
    for (int li = 0; li < N_LAUNCHES; ++li) {
        a.ph_lo = (N_LAUNCHES == PER_PHASE) ? li : 0; a.ph_hi = (N_LAUNCHES == PER_PHASE) ? li + 1 : PER_PHASE; a.li = li;
        hipLaunchKernelGGL(skel_fwd, dim3(grid), dim3(NWAVES * 64), LDS_BYTES, stream, a);
        const hipError_t le = hipPeekAtLastError();
        if (le != hipSuccess) { fprintf(stderr, "kernel_launch: launch %d failed: %s\n", li, hipGetErrorName(le)); break; }
    }
}
```

```cpp
#define MK_N_LAUNCHES 1
#define PROBE_REP 0
#define PROBE_SKIP 0
#include <hip/hip_runtime.h>
#include <cstdio>
#include <cstdint>
namespace pg8 {
#define PG8_LAS __attribute__((address_space(3)))
typedef unsigned short bf16_t;
typedef short bf16x8 __attribute__((ext_vector_type(8)));
typedef float f32x4 __attribute__((ext_vector_type(4)));
typedef unsigned u32x4 __attribute__((ext_vector_type(4)));
constexpr int BM = 256, BK = 64, HALF = 128, HTB = HALF * BK * 2  , STAGE_BYTES = 8 * HTB, NXCD = 8, WGM = 8;

__host__ __device__ __forceinline__ int lds_byte(int r, int c) { const int st = (r >> 4) * 2 + (c >> 5), rr = r & 15, cc = c & 31, ob = rr * 64 + cc * 2; return st * 1024 + (ob ^ (((ob >> 9) & 1) << 5)); }
__host__ __device__ __forceinline__ void stage_rc(int b, int& R, int& C) { const int st = b / 1024, sb = b % 1024, swz = sb ^ (((sb >> 9) & 1) << 5); R = (st >> 1) * 16 + swz / 64; C = (st & 1) * 32 + (swz % 64) / 2; }
__host__ __device__ __forceinline__ int perm32(int rho) { const int n = rho >> 4, i = rho & 15; return 8 * (i >> 2) + 4 * n + (i & 3); }

struct Unit { int pm, pn; };
struct Gemm { const bf16_t* A; const bf16_t* Bt; int M, N, K; };

struct StaticOrder {
    int nM, nN, nwg, G, c;
    __host__ __device__ void init(int M, int N, int G_, int c_) { nM = M / BM; nN = N / BM; nwg = nM * nN; G = G_; c = c_; }
    __host__ __device__ bool next(int i, Unit& u) const {
        const long L = (long)i * G + c; if (L >= nwg) return false;
        int wgid = (int)L; { const int q = nwg / NXCD, r = nwg % NXCD, xcd = wgid % NXCD, off = wgid / NXCD; wgid = (xcd < r ? xcd * (q + 1) : r * (q + 1) + (xcd - r) * q) + off; }
        const int nig = WGM * nN, gid = wgid / nig, fm = gid * WGM, gsz = (nM - fm) < WGM ? (nM - fm) : WGM;
        u.pm = fm + ((wgid % nig) % gsz); u.pn = (wgid % nig) / gsz; return true;
    }
    __device__ __forceinline__ void a_ready(const Unit&) const {}
    __device__ __forceinline__ void done(const Unit&) const {}
};

__device__ __forceinline__ unsigned cvt_pk_bf16(float lo, float hi) { unsigned r; asm volatile("v_cvt_pk_bf16_f32 %0, %1, %2" : "=v"(r) : "v"(lo), "v"(hi)); return r; }
typedef float f32x2 __attribute__((ext_vector_type(2)));
__device__ __forceinline__ f32x2 gelu_pk(f32x2 v) {
    const f32x2 av = __builtin_elementwise_abs(v), d = av * 0.2316418882f + 1.0f;
    f32x2 t; t.x = __builtin_amdgcn_rcpf(d.x); t.y = __builtin_amdgcn_rcpf(d.y);
    f32x2 q = t * 0.5307027145f + (-0.7265760135f); q = q * t + 0.7107068705f; q = q * t + (-0.142248368f); q = q * t + 0.127414796f; q = q * t;
    const f32x2 s = (v * v) * (-0.72134752044f);
    f32x2 e; e.x = __builtin_amdgcn_exp2f(s.x); e.y = __builtin_amdgcn_exp2f(s.y);
    const f32x2 m = v * (q * e), r = v - m;
    f32x2 o; o.x = v.x < 0.f ? m.x : r.x; o.y = v.y < 0.f ? m.y : r.y; return o;
}

template <int ACT  > struct EpiBf16 {
    static constexpr bool PERM = true, AFTER_DRAIN = false; static_assert(ACT == 0 || ACT == 1, "EpiBf16: ACT is 0 (none) or 1 (gelu_pk)");
    bf16_t* O; int ldc; const float* bias; int split_cols; size_t split_stride; float scale0;
    __device__ __forceinline__ void operator()(const f32x4 (&acc)[2][2][4][2], const Unit& u, int wr, int wc, int fr, int fq) const {
        const int row0 = u.pm * BM + wr * 64 + fr; int colt = u.pn * BM; bf16_t* base = O;
        float sc = 1.f; if (split_cols) { const int t = colt / split_cols; base += (size_t)t * split_stride; colt -= t * split_cols; if (t == 0) sc = scale0; }
        const int col0 = colt + wc * 32 + 8 * fq, bcol0 = u.pn * BM + wc * 32 + 8 * fq;
        f32x4 bv[2][2];
#pragma unroll
        for (int bj = 0; bj < 2; ++bj)
#pragma unroll
            for (int n = 0; n < 2; ++n) bv[bj][n] = bias ? *(const f32x4*)(bias + bcol0 + bj * HALF + 4 * n) : (f32x4){0.f, 0.f, 0.f, 0.f};
#pragma unroll
        for (int ai = 0; ai < 2; ++ai)
#pragma unroll
            for (int m = 0; m < 4; ++m) { bf16_t* rowp = base + (size_t)(row0 + ai * HALF + m * 16) * ldc + col0;
#pragma unroll
                for (int bj = 0; bj < 2; ++bj) { f32x4 v0 = acc[ai][bj][m][0] + bv[bj][0], v1 = acc[ai][bj][m][1] + bv[bj][1];
                    if (ACT == 1) { f32x2 a = gelu_pk((f32x2){v0[0], v0[1]}), b = gelu_pk((f32x2){v0[2], v0[3]}), c = gelu_pk((f32x2){v1[0], v1[1]}), d = gelu_pk((f32x2){v1[2], v1[3]});
                        v0 = (f32x4){a.x, a.y, b.x, b.y}; v1 = (f32x4){c.x, c.y, d.x, d.y}; }
                    v0 = v0 * sc; v1 = v1 * sc; u32x4 w; w.x = cvt_pk_bf16(v0[0], v0[1]); w.y = cvt_pk_bf16(v0[2], v0[3]); w.z = cvt_pk_bf16(v1[0], v1[1]); w.w = cvt_pk_bf16(v1[2], v1[3]);
                    *(u32x4*)(rowp + bj * HALF) = w; } }
    }
};
struct EpiResGate {
    static constexpr bool PERM = false, AFTER_DRAIN = false;
    const float* base; float* out; const float* gate; int ldc; int gate_ld;
    __device__ __forceinline__ void operator()(const f32x4 (&acc)[2][2][4][2], const Unit& u, int wr, int wc, int fr, int fq) const {
        const int b = (u.pm * BM) >> 11; const float* g = gate + (size_t)b * gate_ld;
        const int col0 = u.pn * BM + wc * 32 + 4 * fq;
        f32x4 gv[2][2];
#pragma unroll
        for (int bj = 0; bj < 2; ++bj)
#pragma unroll
            for (int n = 0; n < 2; ++n) gv[bj][n] = *(const f32x4*)(g + col0 + bj * HALF + n * 16);
#pragma unroll
        for (int ai = 0; ai < 2; ++ai)
#pragma unroll
            for (int m = 0; m < 4; ++m) { const size_t off = (size_t)(u.pm * BM + ai * HALF + wr * 64 + m * 16 + fr) * ldc + col0;
                f32x4 bs[2][2];
#pragma unroll
                for (int bj = 0; bj < 2; ++bj)
#pragma unroll
                    for (int n = 0; n < 2; ++n) bs[bj][n] = *(const f32x4*)(base + off + bj * HALF + n * 16);
#pragma unroll
                for (int bj = 0; bj < 2; ++bj)
#pragma unroll
                    for (int n = 0; n < 2; ++n) *(f32x4*)(out + off + bj * HALF + n * 16) = bs[bj][n] + gv[bj][n] * acc[ai][bj][m][n];
                asm volatile("" ::: "memory"); }
    }
};
struct EpiSwiGLU {
    static constexpr bool PERM = true, AFTER_DRAIN = false;
    bf16_t* O; int ldc;
    __device__ __forceinline__ void operator()(const f32x4 (&acc)[2][2][4][2], const Unit& u, int wr, int wc, int fr, int fq) const {
        const int row0 = u.pm * BM + wr * 64 + fr, col0 = u.pn * HALF + wc * 32 + 8 * fq;
#pragma unroll
        for (int ai = 0; ai < 2; ++ai)
#pragma unroll
            for (int m = 0; m < 4; ++m) { bf16_t* rowp = O + (size_t)(row0 + ai * HALF + m * 16) * ldc + col0;
                float hv[8];
#pragma unroll
                for (int n = 0; n < 2; ++n)
#pragma unroll
                    for (int i = 0; i < 4; ++i) { const float g = acc[ai][0][m][n][i], up = acc[ai][1][m][n][i];
                        const float sg = g * __builtin_amdgcn_rcpf(1.0f + __builtin_amdgcn_exp2f(-1.4426950408889634f * g)); hv[4 * n + i] = sg * up; }
                u32x4 w; w.x = cvt_pk_bf16(hv[0], hv[1]); w.y = cvt_pk_bf16(hv[2], hv[3]); w.z = cvt_pk_bf16(hv[4], hv[5]); w.w = cvt_pk_bf16(hv[6], hv[7]);
                *(u32x4*)rowp = w; }
    }
};

template <class Epi, class Sched, bool ALIGN_EPI = false, bool SP2 = false>
__device__ __forceinline__ void gemm_phase(PG8_LAS unsigned char* lds, const Gemm g, const Sched& S, const Epi& E) {
    const int tid = threadIdx.x, wid = __builtin_amdgcn_readfirstlane(tid >> 6), lane = tid & 63, wr = wid >> 2, wc = wid & 3, fr = lane & 15, fq = lane >> 4;
    const int K = g.K, nt = K / BK;
    unsigned voffA[2], voffB[2];
#pragma unroll
    for (int i = 0; i < 2; ++i) { int R, C; stage_rc(tid * 16 + i * 8192, R, C); const int Rb = Epi::PERM ? ((R & ~31) + perm32(R & 31)) : R;
        voffA[i] = (unsigned)(R * K + C) * 2u; voffB[i] = (unsigned)(Rb * K + C) * 2u; }
    const size_t kstep = (size_t)(BK * 2);
    const size_t hstep = (size_t)HALF * K * 2;
    const size_t tstep = 2 * hstep;
    const unsigned ldsw = (unsigned)wid * 1024u;
    const int aoff = lds_byte(wr * 64 + fr, fq * 8), boff = lds_byte(wc * 32 + fr, fq * 8);
#define PG8_SA(b, h) (((b) * 2 + (h)) * HTB)
#define PG8_SB(b, h) ((4 + (b) * 2 + (h)) * HTB)
#define PG8_STAGE(bufoff, gbase, voff) do { _Pragma("unroll") for (int _i = 0; _i < 2; ++_i) \
        __builtin_amdgcn_global_load_lds((const unsigned*)((const char*)(gbase) + (voff)[_i]), (PG8_LAS unsigned*)(lds + (bufoff) + ldsw + _i * 8192), 16, 0, 0); } while (0)
#define PG8_LDA(dst, b, h) do { _Pragma("unroll") for (int m = 0; m < 4; ++m) _Pragma("unroll") for (int k = 0; k < 2; ++k) dst[m][k] = *(const PG8_LAS bf16x8*)(lds + PG8_SA(b, h) + aoff + m * 2048 + k * 1024); } while (0)
#define PG8_LDB(dst, b, h) do { _Pragma("unroll") for (int n = 0; n < 2; ++n) _Pragma("unroll") for (int k = 0; k < 2; ++k) dst[n][k] = *(const PG8_LAS bf16x8*)(lds + PG8_SB(b, h) + boff + n * 2048 + k * 1024); } while (0)
#define PG8_MMA(ai, bj, At, Bt) do { __builtin_amdgcn_s_setprio(1); _Pragma("unroll") for (int m = 0; m < 4; ++m) _Pragma("unroll") for (int n = 0; n < 2; ++n) _Pragma("unroll") for (int k = 0; k < 2; ++k) \
        acc[ai][bj][m][n] = __builtin_amdgcn_mfma_f32_16x16x32_bf16(Bt[n][k], At[m][k], acc[ai][bj][m][n], 0, 0, 0); __builtin_amdgcn_s_setprio(0); } while (0)
#define PG8_WAIT_V(n) asm volatile("s_waitcnt vmcnt(" #n ")" ::: "memory")
#define PG8_WAIT_L(n) asm volatile("s_waitcnt lgkmcnt(" #n ")" ::: "memory")
#define PG8_BAR __builtin_amdgcn_s_barrier()
#define PG8_SCHED __builtin_amdgcn_sched_barrier(0)
    Unit cur, nxt; int ui = 0;
    if (!S.next(0, cur)) return;
    f32x4 acc[2][2][4][2];
#pragma unroll
    for (int a = 0; a < 2; ++a)
#pragma unroll
        for (int b = 0; b < 2; ++b)
#pragma unroll
            for (int m = 0; m < 4; ++m)
#pragma unroll
                for (int n = 0; n < 2; ++n) acc[a][b][m][n] = (f32x4){0.f, 0.f, 0.f, 0.f};
    bf16x8 At[4][2], B0[2][2], B1[2][2];
    const char* cA = (const char*)g.A + (size_t)cur.pm * tstep; const char* cB = (const char*)g.Bt + (size_t)cur.pn * tstep;
    S.a_ready(cur);
    if constexpr (SP2) {
        PG8_STAGE(PG8_SB(0, 0), cB, voffB); PG8_STAGE(PG8_SB(0, 1), cB + hstep, voffB); PG8_STAGE(PG8_SA(0, 0), cA, voffA); PG8_STAGE(PG8_SA(0, 1), cA + hstep, voffA);
        if (wr == 1) PG8_BAR;
        PG8_WAIT_V(2); PG8_BAR;
        PG8_STAGE(PG8_SB(1, 0), cB + kstep, voffB); PG8_STAGE(PG8_SA(1, 0), cA + kstep, voffA); PG8_STAGE(PG8_SB(1, 1), cB + hstep + kstep, voffB);
        PG8_WAIT_V(6); PG8_BAR;
    } else {
        PG8_STAGE(PG8_SB(0, 0), cB, voffB); PG8_STAGE(PG8_SA(0, 0), cA, voffA); PG8_STAGE(PG8_SB(0, 1), cB + hstep, voffB); PG8_STAGE(PG8_SA(0, 1), cA + hstep, voffA);
        if (wr == 1) PG8_BAR;
        PG8_WAIT_V(4); PG8_BAR;
        PG8_STAGE(PG8_SB(1, 0), cB + kstep, voffB); PG8_STAGE(PG8_SA(1, 0), cA + kstep, voffA); PG8_STAGE(PG8_SB(1, 1), cB + hstep + kstep, voffB);
        PG8_WAIT_V(6); PG8_BAR;
    }
    for (;;) {
        const bool has_next = S.next(ui + 1, nxt);
        const char* nA = has_next ? (const char*)g.A + (size_t)nxt.pm * tstep : cA; const char* nB = has_next ? (const char*)g.Bt + (size_t)nxt.pn * tstep : cB;
        for (int t = 0; t < nt; t += 2) {
            const bool last = (t == nt - 2);
            const char* a1 = cA + (size_t)(t + 1) * kstep;
            const char* a2 = last ? nA : cA + (size_t)(t + 2) * kstep; const char* b2 = last ? nB : cB + (size_t)(t + 2) * kstep;
            const char* a3 = a2 + kstep; const char* b3 = b2 + kstep;
            if (last && has_next) S.a_ready(nxt);
            if constexpr (SP2) {
            PG8_LDB(B0, 0, 0); PG8_LDB(B1, 0, 1); PG8_SCHED; PG8_LDA(At, 0, 0); PG8_STAGE(PG8_SA(1, 1), a1 + hstep, voffA);
            PG8_WAIT_V(8); PG8_WAIT_L(0); PG8_BAR; PG8_MMA(0, 0, At, B0); PG8_MMA(0, 1, At, B1); PG8_BAR; PG8_SCHED;
            PG8_LDA(At, 0, 1); PG8_STAGE(PG8_SB(0, 0), b2, voffB); PG8_STAGE(PG8_SB(0, 1), b2 + hstep, voffB); PG8_STAGE(PG8_SA(0, 0), a2, voffA);
            PG8_WAIT_V(8); PG8_WAIT_L(0); PG8_BAR; PG8_MMA(1, 0, At, B0); PG8_MMA(1, 1, At, B1); PG8_BAR; PG8_SCHED;
            PG8_LDB(B0, 1, 0); PG8_LDB(B1, 1, 1); PG8_SCHED; PG8_LDA(At, 1, 0); PG8_STAGE(PG8_SA(0, 1), a2 + hstep, voffA);
            PG8_WAIT_V(8); PG8_WAIT_L(0); PG8_BAR; PG8_MMA(0, 0, At, B0); PG8_MMA(0, 1, At, B1); PG8_BAR; PG8_SCHED;
            PG8_LDA(At, 1, 1); PG8_STAGE(PG8_SB(1, 0), b3, voffB); PG8_STAGE(PG8_SB(1, 1), b3 + hstep, voffB); PG8_STAGE(PG8_SA(1, 0), a3, voffA);
            PG8_WAIT_V(8); PG8_WAIT_L(0); PG8_BAR; PG8_MMA(1, 0, At, B0); PG8_MMA(1, 1, At, B1); PG8_BAR; PG8_SCHED;
            } else {
            PG8_LDB(B0, 0, 0); PG8_SCHED; PG8_LDA(At, 0, 0); PG8_STAGE(PG8_SA(1, 1), a1 + hstep, voffA);
            PG8_WAIT_L(8); PG8_BAR; PG8_WAIT_L(0); PG8_MMA(0, 0, At, B0); PG8_BAR; PG8_SCHED;
            PG8_LDB(B1, 0, 1); PG8_STAGE(PG8_SB(0, 0), b2, voffB);
            PG8_BAR; PG8_WAIT_L(0); PG8_MMA(0, 1, At, B1); PG8_BAR;
            PG8_LDA(At, 0, 1); PG8_STAGE(PG8_SA(0, 0), a2, voffA);
            PG8_BAR; PG8_WAIT_L(0); PG8_MMA(1, 0, At, B0); PG8_BAR; PG8_SCHED;
            PG8_STAGE(PG8_SB(0, 1), b2 + hstep, voffB);
            PG8_WAIT_V(6); PG8_BAR; PG8_MMA(1, 1, At, B1); PG8_BAR;
            PG8_LDB(B0, 1, 0); PG8_SCHED; PG8_LDA(At, 1, 0); PG8_STAGE(PG8_SA(0, 1), a2 + hstep, voffA);
            PG8_WAIT_L(8); PG8_BAR; PG8_WAIT_L(0); PG8_MMA(0, 0, At, B0); PG8_BAR; PG8_SCHED;
            PG8_LDB(B1, 1, 1); PG8_STAGE(PG8_SB(1, 0), b3, voffB);
            PG8_BAR; PG8_WAIT_L(0); PG8_MMA(0, 1, At, B1); PG8_BAR;
            PG8_LDA(At, 1, 1); PG8_STAGE(PG8_SA(1, 0), a3, voffA);
            PG8_BAR; PG8_WAIT_L(0); PG8_MMA(1, 0, At, B0); PG8_BAR; PG8_SCHED;
            PG8_STAGE(PG8_SB(1, 1), b3 + hstep, voffB);
            PG8_WAIT_V(6); PG8_BAR; PG8_MMA(1, 1, At, B1); PG8_BAR;
            }
        }
        if constexpr (ALIGN_EPI) { if (wr == 0) PG8_BAR; }
        if constexpr (!Epi::AFTER_DRAIN) { E(acc, cur, wr, wc, fr, fq); S.done(cur); }
        if (!has_next) break;
#pragma unroll
        for (int a = 0; a < 2; ++a)
#pragma unroll
            for (int b = 0; b < 2; ++b)
#pragma unroll
                for (int m = 0; m < 4; ++m)
#pragma unroll
                    for (int n = 0; n < 2; ++n) acc[a][b][m][n] = (f32x4){0.f, 0.f, 0.f, 0.f};
        cur = nxt; cA = nA; cB = nB; ++ui;
        if constexpr (ALIGN_EPI) { if (wr == 1) PG8_BAR; }
    }
    PG8_WAIT_V(0);
    if constexpr (!ALIGN_EPI) { if (wr == 0) PG8_BAR; }
    PG8_BAR;
    if constexpr (Epi::AFTER_DRAIN) { E.fused(acc, cur, wr, wc, fr, fq, lds, wid, lane); S.done(cur); }
#undef PG8_SA
#undef PG8_SB
#undef PG8_STAGE
#undef PG8_LDA
#undef PG8_LDB
#undef PG8_MMA
#undef PG8_WAIT_V
#undef PG8_WAIT_L
#undef PG8_BAR
#undef PG8_SCHED
}
}

#ifndef PG8_SP2
#define PG8_SP2 true
#endif
#ifndef PG8_ALIGN
#define PG8_ALIGN true
#endif
#include <hip/hip_bf16.h>
#include <cmath>
namespace attn_body {
using bf16=__hip_bfloat16;
using bf16x8=__attribute__((ext_vector_type(8)))short;
using s16x4=__attribute__((ext_vector_type(4)))short;
using f32x16=__attribute__((ext_vector_type(16)))float;
using u32x4=__attribute__((ext_vector_type(4)))unsigned;
using f32x4_t=__attribute__((ext_vector_type(4)))float;
constexpr int BATCH=16,NHEAD=8,SEQ=2048,D=64;
constexpr int QP=512,KP=512,VP=3584,OP=1024;
constexpr int NW=8,QBLK=32,QB=QBLK*NW,KVBLK=64,NQB=SEQ/QB;
constexpr int ATTN_UNIT_ROWS=QB;
__device__ __forceinline__ int crow(int r,int hi){return (r&3)+8*(r>>2)+4*hi;}
#define SBAR() __builtin_amdgcn_sched_barrier(0)
__device__ __forceinline__ void cmask(f32x16&p0,f32x16&p1,int jb,int qrel,int hi){
  const float NEG=-INFINITY; int kb=64*jb+4*hi;
  #pragma unroll
  for(int r=0;r<16;++r){int kv=kb+(r&3)+8*(r>>2); if(kv>qrel)p0[r]=NEG; if(kv+32>qrel)p1[r]=NEG;}
}

constexpr int NSLOT=3, SLOTB=8192;
constexpr int LDS_K=0, LDS_V=NSLOT*SLOTB, LDS_WS=2*NSLOT*SLOTB, LDS_OST=LDS_WS+NW*64*4, LDS_KB=LDS_OST+NW*4096, LDS_CUM=LDS_KB+SEQ*4, LDS_WSUM=LDS_CUM+SEQ*4, LDS_BYTES=LDS_WSUM+64;
constexpr float C2=0.125f*1.4426950408889634f;
__device__ __forceinline__ void glds16(const void*gsrc,unsigned lds_dst){unsigned keep;
  asm volatile("s_mov_b32 %0, m0\n\ts_mov_b32 m0, %2\n\ts_nop 0\n\tglobal_load_lds_dwordx4 %1, off\n\ts_mov_b32 m0, %0":"=&s"(keep):"v"(gsrc),"s"(lds_dst):"memory");}
__device__ __forceinline__ float max3f(float a,float b,float c){float r;asm("v_max3_f32 %0, %1, %2, %3":"=v"(r):"v"(a),"v"(b),"v"(c));return r;}
__device__ __forceinline__ float max2f(float a,float b){float r;asm("v_max_f32_e32 %0, %1, %2":"=v"(r):"v"(a),"v"(b));return r;}
__device__ __forceinline__ float fadd_s(float a,float b){float r;asm("v_add_f32_e32 %0, %1, %2":"=v"(r):"v"(a),"v"(b));return r;}
__device__ __forceinline__ float fsub_s(float a,float b){float r;asm("v_sub_f32_e32 %0, %1, %2":"=v"(r):"v"(a),"v"(b));return r;}
typedef float f32x2_t __attribute__((ext_vector_type(2))); typedef __bf16 bf16x2_t __attribute__((ext_vector_type(2)));
__device__ __forceinline__ unsigned cvtpk_s(float lo,float hi){f32x2_t v={lo,hi};bf16x2_t b=__builtin_convertvector(v,bf16x2_t);return __builtin_bit_cast(unsigned,b);}
#define WAIT_BAR(N) asm volatile("s_waitcnt vmcnt(" #N ") lgkmcnt(0)\n\ts_barrier":::"memory")

__device__ __forceinline__ void qkt(f32x16&p0,f32x16&p1,const char*Kslot,const bf16x8*qr,const f32x16&negm,int r32,int hi,bf16x8 kb0,bf16x8 kb1,bf16x8 qone){
  p0=__builtin_amdgcn_mfma_f32_32x32x16_bf16(kb0,qone,negm,0,0,0);p1=__builtin_amdgcn_mfma_f32_32x32x16_bf16(kb1,qone,negm,0,0,0);
  const char*kb=Kslot+hi*1024+r32*16;
  #pragma unroll
  for(int d0=0;d0<4;++d0){
    const bf16x8 b0=*reinterpret_cast<const bf16x8*>(kb+d0*2048);
    const bf16x8 b1=*reinterpret_cast<const bf16x8*>(kb+d0*2048+512);
    p0=__builtin_amdgcn_mfma_f32_32x32x16_bf16(b0,qr[d0],p0,0,0,0);p1=__builtin_amdgcn_mfma_f32_32x32x16_bf16(b1,qr[d0],p1,0,0,0);}
}
typedef __attribute__((address_space(3))) const char* lds_cptr;
typedef short v4i16_t __attribute__((ext_vector_type(4)));
__device__ __forceinline__ void kload8(bf16x8*kf,lds_cptr kp){
  kf[0]=*(const __attribute__((address_space(3))) bf16x8*)(kp);      kf[1]=*(const __attribute__((address_space(3))) bf16x8*)(kp+512);
  kf[2]=*(const __attribute__((address_space(3))) bf16x8*)(kp+2048); kf[3]=*(const __attribute__((address_space(3))) bf16x8*)(kp+2560);
  kf[4]=*(const __attribute__((address_space(3))) bf16x8*)(kp+4096); kf[5]=*(const __attribute__((address_space(3))) bf16x8*)(kp+4608);
  kf[6]=*(const __attribute__((address_space(3))) bf16x8*)(kp+6144); kf[7]=*(const __attribute__((address_space(3))) bf16x8*)(kp+6656);
}
__device__ __forceinline__ void kload2(bf16x8*kf,lds_cptr kp,int j){ kf[2*j]=*(const __attribute__((address_space(3))) bf16x8*)(kp+j*2048); kf[2*j+1]=*(const __attribute__((address_space(3))) bf16x8*)(kp+j*2048+512); }
__device__ __forceinline__ s16x4 vtr(lds_cptr p){ return __builtin_bit_cast(s16x4,__builtin_amdgcn_ds_read_tr16_b64_v4i16((__attribute__((address_space(3))) v4i16_t*)p)); }
__device__ __forceinline__ float rowmax(const f32x16&p0,const f32x16&p1){
  float a=max3f(p0[0],p0[1],p1[0]),b=max3f(p0[2],p0[3],p1[1]);a=max3f(a,p1[2],p1[3]);
  #pragma unroll
  for(int r=4;r<16;r+=4){a=max3f(a,p0[r],p0[r+1]);b=max3f(b,p0[r+2],p0[r+3]);a=max3f(a,p1[r],p1[r+1]);b=max3f(b,p1[r+2],p1[r+3]);}
  const float m=max2f(a,b);
  auto rr=__builtin_amdgcn_permlane32_swap(__float_as_uint(m),__float_as_uint(m),false,false);
  return max2f(__uint_as_float(rr[0]),__uint_as_float(rr[1]));
}
__device__ __forceinline__ void pv(f32x16*o,int vb,bf16x8 pa0,bf16x8 pa1,bf16x8 pa2,bf16x8 pa3){
  #pragma unroll
  for(int d0=0;d0<2;++d0){s16x4 lo[4],hi[4];
    #pragma unroll
    for(int ks=0;ks<4;++ks){
      asm volatile("ds_read_b64_tr_b16 %0,%1 offset:%c2":"=&v"(lo[ks]):"v"(vb),"i"(d0*4096+ks*1024):"memory");
      asm volatile("ds_read_b64_tr_b16 %0,%1 offset:%c2":"=&v"(hi[ks]):"v"(vb),"i"(d0*4096+ks*1024+512):"memory");}
    asm volatile("s_waitcnt lgkmcnt(0)":::"memory");SBAR();
    #define PK(k) (bf16x8){lo[k][0],lo[k][1],lo[k][2],lo[k][3],hi[k][0],hi[k][1],hi[k][2],hi[k][3]}
    o[d0]=__builtin_amdgcn_mfma_f32_32x32x16_bf16(pa0,PK(0),o[d0],0,0,0);
    o[d0]=__builtin_amdgcn_mfma_f32_32x32x16_bf16(pa1,PK(1),o[d0],0,0,0);
    o[d0]=__builtin_amdgcn_mfma_f32_32x32x16_bf16(pa2,PK(2),o[d0],0,0,0);
    o[d0]=__builtin_amdgcn_mfma_f32_32x32x16_bf16(pa3,PK(3),o[d0],0,0,0);
    #undef PK
  }
}

#ifndef ATTN_STORE16
#define ATTN_STORE16(p,v) (*(u32x4*)(p)=(v))
#endif
template<int THRL> __device__ __forceinline__ void attn_unit(int b,int h,int qb,const bf16*Q,const bf16*__restrict__ K,const bf16*__restrict__ V,bf16*O,const float*Cum,const float*Lq,bool newbh,char*shm){
  const int tid=threadIdx.x,lane=tid&63,r32=lane&31,hi=lane>>5; const int wid=__builtin_amdgcn_readfirstlane(tid>>6);
  const long rowbase=(long)b*SEQ; const int q0=qb*QB;
  const bf16*Qw=Q+(rowbase+q0+wid*QBLK)*QP+h*D;
  const bf16*Kh=K+rowbase*KP+h*D,*Vh=V+rowbase*VP+h*D;
  const unsigned lds0=(unsigned)(uintptr_t)shm;
  float*wsf=(float*)(shm+LDS_WS)+wid*64;
  const bf16*ksrc=Kh+(long)lane*KP+wid*8;
  const bf16*vsrc=Vh+(long)(16*(wid&3)+(lane>>2))*VP+(wid>>2)*32+(lane&3)*8;
  const unsigned kdst=lds0+LDS_K+wid*1024, vdst=lds0+LDS_V+wid*1024;
  #define DMA_K(t,slot) glds16(ksrc+(long)(t)*KVBLK*KP,(unsigned)__builtin_amdgcn_readfirstlane(kdst+(slot)))
  #define DMA_V(t,slot) glds16(vsrc+(long)(t)*KVBLK*VP,(unsigned)__builtin_amdgcn_readfirstlane(vdst+(slot)))
  const int vb0=(int)(lds0+LDS_V)+((lane>>4)&1)*32+(lane&3)*8+(4*hi+((lane&15)>>2))*64;
  const char*Kbase=shm+LDS_K; bf16x8 kf[8];
  const lds_cptr shm3=(lds_cptr)shm; const lds_cptr kp0=shm3+LDS_K+hi*1024+r32*16; const lds_cptr vp0=shm3+LDS_V+((lane>>4)&1)*32+(lane&3)*8+(4*hi+((lane&15)>>2))*64;
  const int NT=(q0+QB)/KVBLK;
  __attribute__((address_space(3))) float*cumL=(__attribute__((address_space(3))) float*)(shm3+LDS_CUM);
  if(newbh){ __attribute__((address_space(3))) float*wsum=(__attribute__((address_space(3))) float*)(shm3+LDS_WSUM);
    const float*lf=Cum+((long)b*NHEAD+h)*SEQ; f32x4_t x=*(const f32x4_t*)(lf+4*tid); x.y+=x.x; x.z+=x.y; x.w+=x.z;
    const float tot=x.w; float incl=tot;
    #pragma unroll
    for(int o=1;o<64;o<<=1){ const float t_=__shfl_up(incl,o); if(lane>=o)incl+=t_; }
    if(lane==63)wsum[wid]=incl;
    WAIT_BAR(0);
    float woff=0.f;
    #pragma unroll
    for(int w_=0;w_<NW;++w_){ const float t_=wsum[w_]; if(w_<wid)woff+=t_; }
    const float off=woff+incl-tot; x.x+=off; x.y+=off; x.z+=off; x.w+=off;
    *(__attribute__((address_space(3))) f32x4_t*)(cumL+4*tid)=x;
    WAIT_BAR(0); }
  const __attribute__((address_space(3))) float*cum=cumL; const float c0=cum[q0];
  { __attribute__((address_space(3))) unsigned*kbw=(__attribute__((address_space(3))) unsigned*)(shm3+LDS_KB);
    for(int s=tid;s<q0+QB;s+=NW*64){ const float v=c0-cum[s]; const unsigned vb=__float_as_uint(v); const unsigned hb=(vb+0x7fffu+((vb>>16)&1u))&0xffff0000u; const float lo=v-__uint_as_float(hb);
      const unsigned lb=__float_as_uint(lo); const unsigned lr=(lb+0x7fffu+((lb>>16)&1u))>>16; kbw[s]=(hb>>16)|(lr<<16); } }
  const float qbias=cum[q0+wid*QBLK+r32]-c0;
  const float lq=Lq[h];
  const unsigned himask=hi?0u:0xffffffffu; const unsigned onew=hi?0u:0x3f803f80u;
  const bf16x8 qone=__builtin_bit_cast(bf16x8,(u32x4){onew,0u,0u,0u});
  const __attribute__((address_space(3))) unsigned*kbp=(const __attribute__((address_space(3))) unsigned*)(shm3+LDS_KB)+r32;
  #define KBF(t,half) __builtin_bit_cast(bf16x8,(u32x4){kbp[(t)*KVBLK+(half)*32]&himask,0u,0u,0u})
  DMA_K(0,0);DMA_V(0,0);DMA_K(1,SLOTB);
  bf16x8 qr[4];
  #pragma unroll
  for(int d0=0;d0<4;++d0)qr[d0]=*reinterpret_cast<const bf16x8*>(&Qw[(long)r32*QP+d0*16+hi*8]);
  float mhat=0.f,l_reg=0.f;f32x16 o[2];o[0]=f32x16{};o[1]=f32x16{};f32x16 negm;
  #pragma unroll
  for(int r=0;r<16;++r)negm[r]=qbias;
  asm volatile("":"+v"(negm));
  const int qrel=wid*QBLK+r32;
  #define CMASK(P0,P1,t) do{int jb_=(t)-(NT-4); if(jb_>=0)cmask(P0,P1,jb_,qrel,hi);}while(0)
  bool resc=false;
  #define START(P0,P1) do{ const float rm=rowmax(P0,P1); resc=false; \
    { const float dl=__builtin_fmaxf(rm,lq); mhat=fadd_s(mhat,dl); \
      _Pragma("unroll") for(int r=0;r<16;++r){P0[r]=fsub_s(P0[r],dl);P1[r]=fsub_s(P1[r],dl);} \
      _Pragma("unroll") for(int r=0;r<16;++r)negm[r]=qbias-mhat; asm volatile("":"+v"(negm)); } \
    _Pragma("unroll") for(int r=0;r<16;++r)P0[r]=__builtin_amdgcn_exp2f(P0[r]); }while(0)
  #define RESC() do{ if(resc){ asm volatile("s_waitcnt lgkmcnt(0)":::"memory"); \
      _Pragma("unroll") for(int d_=0;d_<2;++d_) _Pragma("unroll") for(int r=0;r<16;++r)o[d_][r]*=wsf[crow(r,hi)]; } }while(0)
  f32x16 pA0,pA1,pB0,pB1;
  int sl_prev=0,sl_cur=0,sl_next=SLOTB;
  #define ROT() do{sl_prev=sl_cur;sl_cur=sl_next;sl_next=(sl_next==(NSLOT-1)*SLOTB)?0:sl_next+SLOTB;}while(0)
  DMA_K(2,2*SLOTB);
  WAIT_BAR(3);
  qkt(pA0,pA1,Kbase,qr,negm,r32,hi,KBF(0,0),KBF(0,1),qone);asm volatile("s_nop 15\n\ts_nop 7":"+v"(pA0),"+v"(pA1));CMASK(pA0,pA1,0);
  START(pA0,pA1);
  _Pragma("unroll") for(int r=0;r<16;++r)pA1[r]=__builtin_amdgcn_exp2f(pA1[r]);
  WAIT_BAR(0);
  DMA_K(3,0);DMA_V(1,SLOTB);
  ROT();
  kload8(kf,kp0+sl_cur);
  WAIT_BAR(2);
  s16x4 vlo[8],vhi[8]; u32x4 pw0,pw1,pw2,pw3;
  #define PKW(P,B) cvtpk_s(P[B],P[B+1])
  #define PAF(k) __builtin_bit_cast(bf16x8,pw##k)
  #define VFR(i) (bf16x8){vlo[i][0],vlo[i][1],vlo[i][2],vlo[i][3],vhi[i][0],vhi[i][1],vhi[i][2],vhi[i][3]}
  #define PIN(x) asm volatile("":"+v"(x))
  #define MX3(a,b,c) __builtin_fmaxf(__builtin_fmaxf((a),(b)),(c))
  #define GAPA(MF,A0,A1,A2,A3,W0,W1,PW) do{ MF; sacc+=A0; sacc+=A1; sacc+=A2; sacc+=A3; PIN(sacc); W0; W1; PIN(PW); SBAR(); }while(0)
  #define EX(v) __builtin_amdgcn_exp2f(v)
  #define GAPB(MF,X,B) do{ MF; X[B]=EX(X[B]); X[B+1]=EX(X[B+1]); X[B+2]=EX(X[B+2]); X[B+3]=EX(X[B+3]); PIN(X); SBAR(); }while(0)
  #define VRD(i) do{ vlo[i]=vtr(vp_+(((i)>>2)*4096+((i)&3)*1024)); vhi[i]=vtr(vp_+(((i)>>2)*4096+((i)&3)*1024+512)); }while(0)
  #define KRD(G,j) do{ if(G){ kload2(kf,kp0+sl_next,j); SBAR(); } }while(0)
  #define STEP(C0,C1,P0,P1,t,GK,GV,GL) do{ SBAR(); \
    const lds_cptr vp_=vp0+sl_prev; \
    { const bf16x8 kb0_=KBF(t,0),kb1_=KBF(t,1); C0=__builtin_amdgcn_mfma_f32_32x32x16_bf16(kb0_,qone,negm,0,0,0); C1=__builtin_amdgcn_mfma_f32_32x32x16_bf16(kb1_,qone,negm,0,0,0); SBAR(); } \
    VRD(0); SBAR(); float sacc=(P0[0]+P0[1]); \
    GAPA(C0=__builtin_amdgcn_mfma_f32_32x32x16_bf16(kf[0],qr[0],C0,0,0,0), P0[2],P0[3],P0[4],P0[5],     pw0[0]=PKW(P0,0), pw0[1]=PKW(P0,2), pw0); \
    VRD(4); SBAR(); GAPA(C1=__builtin_amdgcn_mfma_f32_32x32x16_bf16(kf[1],qr[0],C1,0,0,0), P0[6],P0[7],P0[8],P0[9],     pw0[2]=PKW(P0,4), pw0[3]=PKW(P0,6), pw0); \
    VRD(1); SBAR(); GAPA(C0=__builtin_amdgcn_mfma_f32_32x32x16_bf16(kf[2],qr[1],C0,0,0,0),   P0[10],P0[11],P0[12],P0[13], pw1[0]=PKW(P0,8), pw1[1]=PKW(P0,10), pw1); \
    VRD(5); SBAR(); GAPA(C1=__builtin_amdgcn_mfma_f32_32x32x16_bf16(kf[3],qr[1],C1,0,0,0),   P0[14],P0[15],P1[0],P1[1],   pw1[2]=PKW(P0,12),pw1[3]=PKW(P0,14), pw1); \
    VRD(2); SBAR(); GAPA(C0=__builtin_amdgcn_mfma_f32_32x32x16_bf16(kf[4],qr[2],C0,0,0,0),   P1[2],P1[3],P1[4],P1[5],     pw2[0]=PKW(P1,0), pw2[1]=PKW(P1,2), pw2); \
    VRD(6); SBAR(); GAPA(C1=__builtin_amdgcn_mfma_f32_32x32x16_bf16(kf[5],qr[2],C1,0,0,0),   P1[6],P1[7],P1[8],P1[9],     pw2[2]=PKW(P1,4), pw2[3]=PKW(P1,6), pw2); \
    VRD(3); SBAR(); GAPA(C0=__builtin_amdgcn_mfma_f32_32x32x16_bf16(kf[6],qr[3],C0,0,0,0),   P1[10],P1[11],P1[12],P1[13], pw3[0]=PKW(P1,8), pw3[1]=PKW(P1,10), pw3); \
    VRD(7); SBAR(); GAPA(C1=__builtin_amdgcn_mfma_f32_32x32x16_bf16(kf[7],qr[3],C1,0,0,0),   P1[14],P1[15],0.f,0.f,       pw3[2]=PKW(P1,12),pw3[3]=PKW(P1,14), pw3); \
    l_reg+=sacc; \
    if(GK){DMA_K((t)+3,sl_cur);} if(GV){DMA_V((t)+1,sl_next);} \
    CMASK(C0,C1,t); \
    { float a=MX3(C0[0],C0[1],C1[0]),b=MX3(C0[2],C0[3],C1[1]); a=MX3(a,C1[2],C1[3]); \
      _Pragma("unroll") for(int r=4;r<16;r+=4){a=MX3(a,C0[r],C0[r+1]);b=MX3(b,C0[r+2],C0[r+3]);a=MX3(a,C1[r],C1[r+1]);b=MX3(b,C1[r+2],C1[r+3]);} \
      float rm=__builtin_fmaxf(a,b); { auto rr=__builtin_amdgcn_permlane32_swap(__float_as_uint(rm),__float_as_uint(rm),false,false); rm=__builtin_fmaxf(__uint_as_float(rr[0]),__uint_as_float(rr[1])); } \
      resc=false; \
      if(__builtin_expect(__any(rm>(float)THRL),0)){ const float dl=__builtin_fmaxf(rm,0.f); mhat+=dl; \
        _Pragma("unroll") for(int r=0;r<16;++r){C0[r]-=dl;C1[r]-=dl;} \
        _Pragma("unroll") for(int r=0;r<16;++r)negm[r]=qbias-mhat; asm volatile("":"+v"(negm)); \
        const float f=__builtin_amdgcn_exp2f(-dl); l_reg*=f; if(hi==0)wsf[r32]=f; resc=true; } } \
    SBAR(); \
    GAPB(o[0]=__builtin_amdgcn_mfma_f32_32x32x16_bf16(PAF(0),VFR(0),o[0],0,0,0), C0,0); \
    GAPB(o[1]=__builtin_amdgcn_mfma_f32_32x32x16_bf16(PAF(0),VFR(4),o[1],0,0,0), C0,4); \
    KRD(GL,0); GAPB(o[0]=__builtin_amdgcn_mfma_f32_32x32x16_bf16(PAF(1),VFR(1),o[0],0,0,0), C0,8); \
    KRD(GL,1); GAPB(o[1]=__builtin_amdgcn_mfma_f32_32x32x16_bf16(PAF(1),VFR(5),o[1],0,0,0), C0,12); \
    KRD(GL,2); GAPB(o[0]=__builtin_amdgcn_mfma_f32_32x32x16_bf16(PAF(2),VFR(2),o[0],0,0,0), C1,0); \
    KRD(GL,3); GAPB(o[1]=__builtin_amdgcn_mfma_f32_32x32x16_bf16(PAF(2),VFR(6),o[1],0,0,0), C1,4); \
    GAPB(o[0]=__builtin_amdgcn_mfma_f32_32x32x16_bf16(PAF(3),VFR(3),o[0],0,0,0), C1,8); \
    GAPB(o[1]=__builtin_amdgcn_mfma_f32_32x32x16_bf16(PAF(3),VFR(7),o[1],0,0,0), C1,12); \
    }while(0)
  int t=1;
  #undef CMASK
  #define CMASK(P0,P1,t) do{}while(0)
  for(;t+5<NT;t+=2){
    STEP(pB0,pB1,pA0,pA1,t,true,true,true);     WAIT_BAR(2); RESC(); ROT();
    STEP(pA0,pA1,pB0,pB1,t+1,true,true,true);   WAIT_BAR(2); RESC(); ROT();
  }
  #undef CMASK
  #define CMASK(P0,P1,t) do{int jb_=(t)-(NT-4); if(jb_>=0)cmask(P0,P1,jb_,qrel,hi);}while(0)
  #define ENDW(tt) do{ if((tt)+3<NT){WAIT_BAR(2);} else if((tt)+2<NT){WAIT_BAR(1);} else {WAIT_BAR(0);} }while(0)
  for(;t+1<NT;t+=2){
    STEP(pB0,pB1,pA0,pA1,t,(t+3<NT),(t+1<NT),(t+1<NT));       ENDW(t);   RESC(); ROT();
    STEP(pA0,pA1,pB0,pB1,t+1,(t+4<NT),(t+2<NT),(t+2<NT));     ENDW(t+1); RESC(); ROT();
  }
  STEP(pB0,pB1,pA0,pA1,NT-1,false,false,false); RESC();
  { float sacc=pB0[0]+pB0[1]; _Pragma("unroll") for(int r=2;r<16;++r)sacc+=pB0[r]; _Pragma("unroll") for(int r=0;r<16;++r)sacc+=pB1[r]; l_reg+=sacc;
    pw0=(u32x4){PKW(pB0,0),PKW(pB0,2),PKW(pB0,4),PKW(pB0,6)};pw1=(u32x4){PKW(pB0,8),PKW(pB0,10),PKW(pB0,12),PKW(pB0,14)};pw2=(u32x4){PKW(pB1,0),PKW(pB1,2),PKW(pB1,4),PKW(pB1,6)};pw3=(u32x4){PKW(pB1,8),PKW(pB1,10),PKW(pB1,12),PKW(pB1,14)};
    SBAR(); pv(o,vb0+sl_cur,PAF(0),PAF(1),PAF(2),PAF(3)); }
  #undef PKW
  #undef PAF
  #undef VFR
  #undef PIN
  #undef MX3
  #undef GAPA
  #undef GAPB
  #undef EX
  #undef VRD
  #undef KRD
  #undef STEP
  #undef ENDW
  {auto rr=__builtin_amdgcn_permlane32_swap(__float_as_uint(l_reg),__float_as_uint(l_reg),false,false);l_reg=__uint_as_float(rr[0])+__uint_as_float(rr[1]);}
  if(hi==0)wsf[32+r32]=l_reg;asm volatile("s_waitcnt lgkmcnt(0)":::"memory");
  float rli[16];
  #pragma unroll
  for(int r=0;r<16;++r)rli[r]=__builtin_amdgcn_rcpf(wsf[32+crow(r,hi)]);
  bf16*Ow=O+(rowbase+q0+wid*QBLK)*OP+h*D;
  { bf16*stg=(bf16*)(shm+LDS_OST)+wid*2048;
    #pragma unroll
    for(int r=0;r<16;++r){const int orow=crow(r,hi);
      #pragma unroll
      for(int d0=0;d0<2;++d0)stg[orow*64+d0*32+r32]=__float2bfloat16(o[d0][r]*rli[r]);}
    asm volatile("s_waitcnt lgkmcnt(0)":::"memory");
    #pragma unroll
    for(int i=0;i<4;++i){const int row=i*8+(lane>>3),ch=lane&7; const u32x4 v=*(const u32x4*)(stg+row*64+ch*8); ATTN_STORE16(Ow+(long)row*OP+ch*8,v);} }
  asm volatile("s_waitcnt lgkmcnt(0)\n\ts_barrier":::"memory");
  #undef KBF
  #undef DMA_K
  #undef DMA_V
  #undef CMASK
  #undef START
  #undef RESC
  #undef ROT
}
constexpr int ATTN_LDS_BYTES=LDS_BYTES;
struct AttnTensors { const bf16* Q; const bf16* K; const bf16* V; bf16* O; const float* Cum; const float* Lq; };
struct AttnUnit { int bh; int qb; };
struct StaticOrder {
  int a,na;
  __device__ __forceinline__ StaticOrder(int a_,int na_):a(a_),na(na_){}
  __device__ __forceinline__ bool next(int i,AttnUnit&u)const{ const int bh=a+(i/NQB)*na; if(a<0||bh>=BATCH*NHEAD)return false; u.bh=bh; u.qb=NQB-1-(i%NQB); return true; }
  __device__ __forceinline__ void a_ready(const AttnUnit&)const{}
  __device__ __forceinline__ void done(const AttnUnit&)const{}
};
template<class Sched,int THRL=16> __device__ __forceinline__ void attn_phase(char*lds,const AttnTensors&T,const Sched&S){
  AttnUnit u; int last_=-1;
  for(int i=0;S.next(i,u);++i){ S.a_ready(u); attn_unit<THRL>(u.bh/NHEAD,u.bh%NHEAD,u.qb,T.Q,T.K,T.V,T.O,T.Cum,T.Lq,u.bh!=last_,lds); last_=u.bh; S.done(u); }
}
#undef SBAR
#undef WAIT_BAR
}
constexpr int NWAVES = 8;
#ifndef MK_N_LAUNCHES
#define MK_N_LAUNCHES 1
#endif
constexpr int PER_PHASE = 9;
constexpr int N_LAUNCHES = MK_N_LAUNCHES;
static_assert(N_LAUNCHES == 1 || N_LAUNCHES == PER_PHASE, "MK_N_LAUNCHES is 1 or 9");

constexpr int BATCH = 16, T = 2048, D = 1024, HD = 64, FOXH = 8, RWKVH = 8, FF = 2816;
constexpr int M = BATCH * T;
constexpr int IN_COLS = 3368;
constexpr int NIN = 3584;
constexpr int PC_Q = 0, PC_K = 512, PC_V = 1024, PC_R = 1536, PC_RK = 2048, PC_RV = 2560, PC_WDN = 3072, PC_ADN = 3136, PC_GDN = 3200, PC_F = 3360;
constexpr int NGU = 2 * FF;
constexpr float RMS_EPS = 1e-6f, GN_EPS = 64e-5f, L2_EPS = 1e-12f;
constexpr float LOG2E = 1.4426950408889634f;

constexpr size_t MiB = 1u << 20, KiB = 1u << 10;
constexpr size_t WS_CTL = 0, CTL_ZERO_BYTES = 64 * KiB;
constexpr size_t WS_WIN = 1 * MiB, WS_WOUT = 8 * MiB, WS_WGU = 10 * MiB, WS_WDN = 21 * MiB;
constexpr size_t WS_W2T = 27 * MiB, WS_A2T = WS_W2T + 64 * KiB, WS_G2T = WS_A2T + 64 * KiB;
constexpr size_t WS_MOD = 27 * MiB + 512 * KiB;
constexpr size_t WS_LQ = 27 * MiB + 960 * KiB;
constexpr size_t WS_CUM = 28 * MiB;
constexpr size_t WS_XN = 32 * MiB;
constexpr size_t WS_QN = 96 * MiB, WS_KN = 128 * MiB;
constexpr size_t WS_MIX = 160 * MiB;
constexpr size_t WS_P = 224 * MiB;
constexpr size_t WS_HH = WS_P;
constexpr size_t WS_END = 448 * MiB;
static_assert(WS_WIN + (size_t)NIN * D * 2 <= WS_WOUT && WS_WGU + (size_t)NGU * D * 2 <= WS_WDN && WS_WDN + (size_t)D * FF * 2 <= WS_W2T && WS_G2T + 512 * 160 * 2 <= WS_MOD && WS_MOD + 16 * 6144 * 4 <= WS_LQ, "ws map");
static_assert(WS_P + (size_t)M * NIN * 2 <= WS_END && WS_HH + (size_t)M * FF * 2 <= WS_END, "ws map");
constexpr int CW_TMO = 0, CW_CODE = 1;
constexpr int CW_BAR = 4096;

constexpr int RING_OFF = 0, RING_BYTES = 131072;
constexpr int LDSCTL_OFF = RING_BYTES, MISC_OFF = LDSCTL_OFF + 320;
constexpr int LDS_BYTES = 147456;
static_assert(MISC_OFF + 128 <= LDS_BYTES, "LDS map");
#define GAS __attribute__((address_space(1)))
#define LAS __attribute__((address_space(3)))
typedef unsigned short bf16;
typedef unsigned v4u __attribute__((ext_vector_type(4)));
typedef float f32x4 __attribute__((ext_vector_type(4)));
typedef short bf16x8 __attribute__((ext_vector_type(8)));
typedef GAS unsigned gu32;
typedef GAS unsigned long long gu64;
#define RLX_AGENT __ATOMIC_RELAXED, __HIP_MEMORY_SCOPE_AGENT
#define LDS_WAIT() asm volatile("s_waitcnt lgkmcnt(0)" ::: "memory")
#define VM_WAIT() asm volatile("s_waitcnt vmcnt(0)" ::: "memory")
__device__ __forceinline__ unsigned long long rt() { return __builtin_amdgcn_s_memrealtime(); }
__device__ __forceinline__ unsigned f2bf(float f) { unsigned u = __builtin_bit_cast(unsigned, f); return (u + 0x7fffu + ((u >> 16) & 1u)) >> 16; }
__device__ __forceinline__ unsigned pk2(float lo, float hi) { return f2bf(lo) | (f2bf(hi) << 16); }

#define XB_TMO      128
#define XB_XCNT(j)  (256  + 64 * (j))
#define XB_XSUB(j)  (1280 + 64 * (j))
#define XB_XGEN(j)  (2304 + 64 * (j))
#define XB_TOP      3328
#define XB_TOPGEN   3392
#define XCD_BAR_WORDS 3456
#define XB_SPIN_CAP (1u << 18)

__device__ __forceinline__ unsigned xb_ld(unsigned* p)              { return __hip_atomic_load(p, __ATOMIC_RELAXED, __HIP_MEMORY_SCOPE_AGENT); }
__device__ __forceinline__ unsigned xb_add(unsigned* p, unsigned v) { return __hip_atomic_fetch_add(p, v, __ATOMIC_RELAXED, __HIP_MEMORY_SCOPE_AGENT); }
__device__ __forceinline__ unsigned xb_xcc_id() { return (unsigned)__builtin_amdgcn_s_getreg((3 << 11) | 20) & 0xFu; }
#define XB_SPIN(cond, bar) do { unsigned _sp = 0; while (cond) { __builtin_amdgcn_s_sleep(1); \
    if ((++_sp & 255u) == 0u) { if (xb_ld(&(bar)[XB_TMO])) break; if (_sp > XB_SPIN_CAP) { atomicAdd(&(bar)[XB_TMO], 1u); break; } } } } while (0)

struct XcdBarrier {
    unsigned* bar; unsigned x;
    volatile LAS unsigned* st;
};

__device__ __forceinline__ XcdBarrier xcd_barrier_post(unsigned* bar, volatile LAS unsigned* st) {
    XcdBarrier b; b.bar = bar; b.x = xb_xcc_id(); b.st = st;
    if (threadIdx.x == 0) (void)xb_add(&bar[XB_XCNT(b.x)], 1u);
    return b;
}
__device__ __forceinline__ void xcd_barrier_complete(unsigned* bar, unsigned x, unsigned& nloc, unsigned& nx) {
    const unsigned G = gridDim.x * gridDim.y * gridDim.z;
    unsigned sum, cnt, mine, sp = 0u;
    for (;;) {
        sum = 0u; cnt = 0u; mine = 0u;
#pragma unroll
        for (unsigned j = 0; j < 16; ++j) { const unsigned c = xb_ld(&bar[XB_XCNT(j)]); sum += c; cnt += (c > 0u) ? 1u : 0u; mine = (j == x) ? c : mine; }
        if (sum == G) break;
        __builtin_amdgcn_s_sleep(1);
        if ((++sp & 255u) == 0u) { if (xb_ld(&bar[XB_TMO])) break; if (sp > XB_SPIN_CAP) { atomicAdd(&bar[XB_TMO], 1u); break; } }
    }
    nloc = mine > 0u ? mine : 1u; nx = cnt > 0u ? cnt : 1u;
}

__device__ __forceinline__ void xcd_barrier(const XcdBarrier& b) {
    asm volatile("s_waitcnt vmcnt(0)" ::: "memory");
    __syncthreads();
    if (threadIdx.x == 0) {
        unsigned* bar = b.bar;
        __builtin_amdgcn_s_waitcnt(0);
        unsigned nloc = b.st[0], nx = b.st[1];
        if (nloc == 0u) { xcd_barrier_complete(bar, b.x, nloc, nx); b.st[0] = nloc; b.st[1] = nx; }
        const unsigned old = xb_add(&bar[XB_XSUB(b.x)], 1u);
        const unsigned gen = old / nloc;
        if (old + 1u == (gen + 1u) * nloc) {
            __builtin_amdgcn_fence(__ATOMIC_RELEASE, "agent");
            asm volatile("s_waitcnt vmcnt(0)" ::: "memory");
            const unsigned og = xb_add(&bar[XB_TOP], 1u);
            const unsigned tg = og / nx;
            if (og + 1u == (tg + 1u) * nx) xb_add(&bar[XB_TOPGEN], 1u);
            else XB_SPIN(xb_ld(&bar[XB_TOPGEN]) == tg, bar);
            __builtin_amdgcn_fence(__ATOMIC_ACQUIRE, "agent");
            xb_add(&bar[XB_XGEN(b.x)], 1u);
            asm volatile("s_waitcnt vmcnt(0)" ::: "memory");
        } else {
            XB_SPIN(xb_ld(&bar[XB_XGEN(b.x)]) == gen, bar);
            __builtin_amdgcn_fence(__ATOMIC_ACQUIRE, "agent");
            asm volatile("s_waitcnt vmcnt(0)" ::: "memory");
        }
    }
    __syncthreads();
}
typedef float f32x2 __attribute__((ext_vector_type(2)));
typedef float f32x16 __attribute__((ext_vector_type(16)));
typedef unsigned v2u __attribute__((ext_vector_type(2)));
struct Frame {
    LAS unsigned char* lds;
    volatile LAS unsigned* MISC;
    gu32* ctl;
    int tid, lane, wave;
    int vcu, G;
    const float* in[25]; float* out; unsigned char* ws;
};
enum { I_X = 0, I_C, I_ADAW, I_ADAB, I_N1G, I_N2G, I_WIN, I_FBIAS, I_QG, I_KG, I_MU, I_W0, I_W2, I_A0, I_A2, I_G2, I_KK, I_KA, I_RK, I_LNG, I_LNB, I_WOUT, I_WG, I_WU, I_WD };

__device__ __forceinline__ float wave_sum(float v) {
#pragma unroll
    for (int o = 1; o < 64; o <<= 1) v += __shfl_xor(v, o);
    return v;
}
__device__ __forceinline__ float wave_max(float v) {
#pragma unroll
    for (int o = 1; o < 64; o <<= 1) v = fmaxf(v, __shfl_xor(v, o));
    return v;
}
template <int CTRL> __device__ __forceinline__ float dpp_f(float x) { return __int_as_float(__builtin_amdgcn_update_dpp(0, __float_as_int(x), CTRL, 0xf, 0xf, true)); }
__device__ __forceinline__ float red16(float x) {
    x += dpp_f<0xB1>(x);
    x += dpp_f<0x4E>(x);
    x += dpp_f<0x141>(x);
    x += dpp_f<0x140>(x);
    return x;
}
__device__ __forceinline__ float red8(float x) {
    x += dpp_f<0xB1>(x); x += dpp_f<0x4E>(x); x += dpp_f<0x141>(x); return x;
}
typedef __bf16 bf16x2_t __attribute__((ext_vector_type(2)));
__device__ __forceinline__ unsigned cvtpk(float lo, float hi) { const f32x2 v = {lo, hi}; const bf16x2_t b = __builtin_convertvector(v, bf16x2_t); return __builtin_bit_cast(unsigned, b); }
__device__ __forceinline__ float bf2f(unsigned short h) { return __uint_as_float((unsigned)h << 16); }
__device__ __forceinline__ float sigmoidf_(float x) { return __builtin_amdgcn_rcpf(1.0f + __builtin_amdgcn_exp2f(-LOG2E * x)); }
__device__ __forceinline__ float tanhf_(float x) { return 1.0f - 2.0f * __builtin_amdgcn_rcpf(1.0f + __builtin_amdgcn_exp2f(2.0f * LOG2E * x)); }

template <class RowMap>
__device__ __forceinline__ void p0_transpose_item(const float* W, int K, int N, bf16* WT, int ldk, RowMap rm, LAS float* scr, int item, int lane) {
    const int nblk = (N + 31) / 32, kb = item / nblk, nb = item % nblk, k0 = 64 * kb, n0 = 32 * nb;
    const int nn = n0 + (lane & 31);
#pragma unroll
    for (int i = 0; i < 32; ++i) { const int kk = 2 * i + (lane >> 5); scr[kk * 33 + (lane & 31)] = (k0 + kk < K && nn < N) ? W[(size_t)(k0 + kk) * N + nn] : 0.f; }
    LDS_WAIT(); asm volatile("" ::: "memory");
    const int c = lane & 7;
#pragma unroll
    for (int j = 0; j < 4; ++j) { const int n = (lane >> 3) + 8 * j; const LAS float* s = scr + (8 * c) * 33 + n;
        v4u o; o.x = pk2(s[0 * 33], s[1 * 33]); o.y = pk2(s[2 * 33], s[3 * 33]); o.z = pk2(s[4 * 33], s[5 * 33]); o.w = pk2(s[6 * 33], s[7 * 33]);
        if (n0 + n < N && k0 + 8 * c < K) *(GAS v4u*)(WT + (size_t)rm(n0 + n) * ldk + k0 + 8 * c) = o; }
    LDS_WAIT(); asm volatile("" ::: "memory");
}
struct RmId { __device__ __forceinline__ int operator()(int n) const { return n; } };
struct RmWin { __device__ __forceinline__ int operator()(int n) const { return n < 1536 ? n : (n < 1544 ? PC_F + (n - 1536) : (n - 1544) + PC_R); } };
struct RmGate { int up; __device__ __forceinline__ int operator()(int n) const { return (n >> 7) * 256 + (n & 127) + up * 128; } };

__device__ __forceinline__ void p0_prologue(Frame& F) {
    LAS float* scr = (LAS float*)(F.lds + RING_OFF + F.wave * 16384);
    const int gw = F.vcu * NWAVES + F.wave, NGW = F.G * NWAVES;
    bf16* WIN = (bf16*)(F.ws + WS_WIN); bf16* WOUT = (bf16*)(F.ws + WS_WOUT); bf16* WGU = (bf16*)(F.ws + WS_WGU); bf16* WDN = (bf16*)(F.ws + WS_WDN);
    bf16* W2T = (bf16*)(F.ws + WS_W2T); bf16* A2T = (bf16*)(F.ws + WS_A2T); bf16* G2T = (bf16*)(F.ws + WS_G2T);
    if (F.vcu < 6144 / 32) {
        LAS float* sc = (LAS float*)(F.lds + RING_OFF);
        LAS float* red = (LAS float*)(F.lds + RING_OFF + 65536);
        const float* cin = F.in[I_C];
        for (int i = F.tid; i < 16 * 1024; i += NWAVES * 64) { const int b = i >> 10, k = i & 1023; const float v = cin[i]; sc[k * 16 + b] = v * sigmoidf_(v); }
        __syncthreads();
        const int col = F.tid & 31, kg = F.tid >> 5, j0 = F.vcu * 32;
        float acc[16];
#pragma unroll
        for (int b = 0; b < 16; ++b) acc[b] = 0.f;
        const float* wp = F.in[I_ADAW] + (size_t)(kg * 64) * 6144 + j0 + col;
        for (int k = 0; k < 64; ++k) { const float w = wp[(size_t)k * 6144]; const LAS f32x4* s4 = (const LAS f32x4*)(sc + (kg * 64 + k) * 16);
#pragma unroll
            for (int q = 0; q < 4; ++q) { const f32x4 s = s4[q]; acc[4 * q] += s.x * w; acc[4 * q + 1] += s.y * w; acc[4 * q + 2] += s.z * w; acc[4 * q + 3] += s.w * w; } }
#pragma unroll
        for (int b = 0; b < 16; ++b) red[(kg * 16 + b) * 32 + col] = acc[b];
        __syncthreads();
        { const int b = F.tid >> 5; float s = F.in[I_ADAB][j0 + col];
#pragma unroll
          for (int g = 0; g < 16; ++g) s += red[(g * 16 + b) * 32 + col];
          ((float*)(F.ws + WS_MOD))[b * 6144 + j0 + col] = s; }
        __syncthreads();
    }
    constexpr int I_IN = (D / 64) * ((IN_COLS + 31) / 32), I_O = (D / 64) * (D / 32), I_G = (D / 64) * (FF / 32), I_D = (FF / 64) * (D / 32), I_L = 512 / 32, I_LG = 3 * (512 / 32);
    constexpr int NITEMS = I_IN + I_O + 2 * I_G + I_D + 2 * I_L + I_LG;
    for (int it = gw; it < NITEMS; it += NGW) {
        int r = it;
        if (r < I_IN) { p0_transpose_item(F.in[I_WIN], D, IN_COLS, WIN, D, RmWin{}, scr, r, F.lane); continue; } r -= I_IN;
        if (r < I_O) { p0_transpose_item(F.in[I_WOUT], D, D, WOUT, D, RmId{}, scr, r, F.lane); continue; } r -= I_O;
        if (r < I_G) { p0_transpose_item(F.in[I_WG], D, FF, WGU, D, RmGate{0}, scr, r, F.lane); continue; } r -= I_G;
        if (r < I_G) { p0_transpose_item(F.in[I_WU], D, FF, WGU, D, RmGate{1}, scr, r, F.lane); continue; } r -= I_G;
        if (r < I_D) { p0_transpose_item(F.in[I_WD], FF, D, WDN, FF, RmId{}, scr, r, F.lane); continue; } r -= I_D;
        if (r < I_L) { p0_transpose_item(F.in[I_W2], 64, 512, W2T, 64, RmId{}, scr, r, F.lane); continue; } r -= I_L;
        if (r < I_L) { p0_transpose_item(F.in[I_A2], 64, 512, A2T, 64, RmId{}, scr, r, F.lane); continue; } r -= I_L;
        p0_transpose_item(F.in[I_G2], 160, 512, G2T, 160, RmId{}, scr, r, F.lane);
    }
    { const int gt = F.vcu * NWAVES * 64 + F.tid, NGT = F.G * NWAVES * 64; GAS v4u* z = (GAS v4u*)(WIN + (size_t)IN_COLS * D);
      for (int i = gt; i < (NIN - IN_COLS) * D / 8; i += NGT) z[i] = (v4u){0u, 0u, 0u, 0u}; }
    if (gw < FOXH) { const float gq = wave_max(fabsf(F.in[I_QG][gw * 64 + F.lane])), gk = wave_max(fabsf(F.in[I_KG][gw * 64 + F.lane]));
        const float bh = 8.0f * gq * gk * LOG2E * 1.001f; if (F.lane == 0) ((float*)(F.ws + WS_LQ))[gw] = fminf(0.f, 100.f - bh); }
}

__device__ __forceinline__ void xn_pass(Frame& F, const float* x, const float* gain, int shift_off, int scale_off) {
    const int gw = F.vcu * NWAVES + F.wave, NGW = F.G * NWAVES; const float* mod = (const float*)(F.ws + WS_MOD); bf16* XN = (bf16*)(F.ws + WS_XN);
    for (int m0 = 2 * gw; m0 < M; m0 += 2 * NGW) {
        f32x4 v[2][4]; float s[2];
#pragma unroll
        for (int q = 0; q < 2; ++q) { const GAS f32x4* xr = (const GAS f32x4*)(x + (size_t)(m0 + q) * D) + F.lane;
#pragma unroll
            for (int j = 0; j < 4; ++j) v[q][j] = xr[64 * j]; }
#pragma unroll
        for (int q = 0; q < 2; ++q) { s[q] = 0.f;
#pragma unroll
            for (int j = 0; j < 4; ++j) s[q] += (v[q][j].x * v[q][j].x + v[q][j].y * v[q][j].y) + (v[q][j].z * v[q][j].z + v[q][j].w * v[q][j].w); }
#pragma unroll
        for (int o = 1; o < 64; o <<= 1) { s[0] += __shfl_xor(s[0], o); s[1] += __shfl_xor(s[1], o); }
        const int b = m0 >> 11;
#pragma unroll
        for (int j = 0; j < 4; ++j) { const int c = 4 * F.lane + 256 * j;
            const f32x4 g = *(const f32x4*)(gain + c), sc = *(const f32x4*)(mod + b * 6144 + scale_off + c), sh = *(const f32x4*)(mod + b * 6144 + shift_off + c);
            const f32x4 gs = g * (sc + 1.0f);
#pragma unroll
            for (int q = 0; q < 2; ++q) { const float rs = 1.0f / sqrtf(s[q] * (1.f / D) + RMS_EPS);
                const f32x4 y = (v[q][j] * rs) * gs + sh;
                ((GAS unsigned long long*)(XN + (size_t)(m0 + q) * D) + F.lane)[64 * j] = (unsigned long long)pk2(y.x, y.y) | ((unsigned long long)pk2(y.z, y.w) << 32); } }
    }
}

__device__ __forceinline__ void fox_prep(Frame& F) {
    const int gw = F.vcu * NWAVES + F.wave, NGW = F.G * NWAVES; const bf16* P = (const bf16*)(F.ws + WS_P); bf16* QN = (bf16*)(F.ws + WS_QN); bf16* KN = (bf16*)(F.ws + WS_KN);
    const float* qg = F.in[I_QG]; const float* kg = F.in[I_KG];
    f32x4 gq0 = *(const f32x4*)(qg + 8 * F.lane), gq1 = *(const f32x4*)(qg + 8 * F.lane + 4), gk0 = *(const f32x4*)(kg + 8 * F.lane), gk1 = *(const f32x4*)(kg + 8 * F.lane + 4);
    const float C2 = 0.125f * LOG2E; float* LF = (float*)(F.ws + WS_CUM); const float fbias = F.in[I_FBIAS][F.lane & 7];
    for (int m = gw; m < M; m += NGW) {
        if (F.lane < 8) { const float z = bf2f(P[(size_t)m * NIN + PC_F + F.lane]) + fbias;
            const float lf = z < -30.f ? z * LOG2E : -__builtin_amdgcn_logf(1.0f + __builtin_amdgcn_exp2f(-LOG2E * z));
            LF[((size_t)(m >> 11) * FOXH + F.lane) * T + (m & (T - 1))] = lf; }
        const v4u qw = *(const GAS v4u*)(P + (size_t)m * NIN + PC_Q + 8 * F.lane), kw = *(const GAS v4u*)(P + (size_t)m * NIN + PC_K + 8 * F.lane);
        float q[8], k[8]; const unsigned qq[4] = {qw.x, qw.y, qw.z, qw.w}, kk[4] = {kw.x, kw.y, kw.z, kw.w};
        float sq = 0.f, sk = 0.f;
#pragma unroll
        for (int i = 0; i < 8; ++i) { q[i] = bf2f((unsigned short)(qq[i >> 1] >> (16 * (i & 1)))); k[i] = bf2f((unsigned short)(kk[i >> 1] >> (16 * (i & 1)))); sq += q[i] * q[i]; sk += k[i] * k[i]; }
        sq = red8(sq); sk = red8(sk);
        const float rq = C2 / sqrtf(sq * (1.f / 64.f) + RMS_EPS), rk = 1.0f / sqrtf(sk * (1.f / 64.f) + RMS_EPS);
        v4u oq, ok;
        oq.x = pk2(q[0] * rq * gq0.x, q[1] * rq * gq0.y); oq.y = pk2(q[2] * rq * gq0.z, q[3] * rq * gq0.w); oq.z = pk2(q[4] * rq * gq1.x, q[5] * rq * gq1.y); oq.w = pk2(q[6] * rq * gq1.z, q[7] * rq * gq1.w);
        ok.x = pk2(k[0] * rk * gk0.x, k[1] * rk * gk0.y); ok.y = pk2(k[2] * rk * gk0.z, k[3] * rk * gk0.w); ok.z = pk2(k[4] * rk * gk1.x, k[5] * rk * gk1.y); ok.w = pk2(k[6] * rk * gk1.z, k[7] * rk * gk1.w);
        *(GAS v4u*)(QN + (size_t)m * 512 + 8 * F.lane) = oq; *(GAS v4u*)(KN + (size_t)m * 512 + 8 * F.lane) = ok;
    }
}

namespace rwprep {
constexpr int ACT_ST = 592;
__device__ __forceinline__ void run(Frame& F) {
    LAS unsigned char* L = F.lds + RING_OFF;
    const bf16* P = (const bf16*)(F.ws + WS_P); const float* mu = F.in[I_MU];
    bf16* LDo = (bf16*)F.out; bf16* AIo = LDo + (size_t)M * 512; bf16* GGo = AIo + (size_t)M * 512;
    const bf16* W2T = (const bf16*)(F.ws + WS_W2T); const bf16* A2T = (const bf16*)(F.ws + WS_A2T); const bf16* G2T = (const bf16*)(F.ws + WS_G2T);
    const int lane = F.lane, w = F.wave, hi = lane >> 5, r32 = lane & 31;
    for (int tile = F.vcu; tile < M / 32; tile += F.G) {
        const size_t row0 = (size_t)tile * 32;
        for (int g = F.tid; g < 32 * 36; g += NWAVES * 64) { const int t = g / 36, cg = g - 36 * t; const size_t row = row0 + t; const bool hp = (row & (T - 1)) != 0;
            const bf16* cp = P + row * NIN + PC_WDN + 8 * cg; const v4u c = *(const GAS v4u*)cp; v4u p = *(const GAS v4u*)(cp - (hp ? NIN : 0)); if (!hp) p = (v4u){0u, 0u, 0u, 0u};
            const f32x4 m0 = *(const f32x4*)(mu + 1536 + 8 * cg), m1 = *(const f32x4*)(mu + 1536 + 8 * cg + 4); const float mm[8] = {m0.x, m0.y, m0.z, m0.w, m1.x, m1.y, m1.z, m1.w};
            const unsigned cc[4] = {c.x, c.y, c.z, c.w}, pp[4] = {p.x, p.y, p.z, p.w}; float x[8];
#pragma unroll
            for (int i = 0; i < 8; ++i) { const float a = bf2f((unsigned short)(cc[i >> 1] >> (16 * (i & 1)))), b = bf2f((unsigned short)(pp[i >> 1] >> (16 * (i & 1)))); x[i] = a + (b - a) * mm[i]; }
            if (cg < 8) {
#pragma unroll
                for (int i = 0; i < 8; ++i) x[i] = tanhf_(x[i]);
            } else if (cg >= 16) {
#pragma unroll
                for (int i = 0; i < 8; ++i) x[i] = sigmoidf_(x[i]);
            }
            *(LAS v4u*)(L + t * ACT_ST + 16 * cg) = (v4u){cvtpk(x[0], x[1]), cvtpk(x[2], x[3]), cvtpk(x[4], x[5]), cvtpk(x[6], x[7])}; }
        __syncthreads();
        f32x16 aw[2] = {{}, {}}, aa[2] = {{}, {}}, ag[2] = {{}, {}};
        const LAS unsigned char* ap = L + r32 * ACT_ST + 16 * hi;
#pragma unroll
        for (int ks = 0; ks < 4; ++ks) { const bf16x8 fw = *(const LAS bf16x8*)(ap + 32 * ks), fa = *(const LAS bf16x8*)(ap + 128 + 32 * ks);
#pragma unroll
            for (int cb = 0; cb < 2; ++cb) { const size_t c = 64 * w + 32 * cb + r32;
                aw[cb] = __builtin_amdgcn_mfma_f32_32x32x16_bf16(*(const GAS bf16x8*)(W2T + c * 64 + 16 * ks + 8 * hi), fw, aw[cb], 0, 0, 0);
                aa[cb] = __builtin_amdgcn_mfma_f32_32x32x16_bf16(*(const GAS bf16x8*)(A2T + c * 64 + 16 * ks + 8 * hi), fa, aa[cb], 0, 0, 0); } }
#pragma unroll
        for (int ks = 0; ks < 10; ++ks) { const bf16x8 fg = *(const LAS bf16x8*)(ap + 256 + 32 * ks);
#pragma unroll
            for (int cb = 0; cb < 2; ++cb) { const size_t c = 64 * w + 32 * cb + r32;
                ag[cb] = __builtin_amdgcn_mfma_f32_32x32x16_bf16(*(const GAS bf16x8*)(G2T + c * 160 + 16 * ks + 8 * hi), fg, ag[cb], 0, 0, 0); } }
        const size_t orow = (row0 + r32) * 512;
#pragma unroll
        for (int cb = 0; cb < 2; ++cb)
#pragma unroll
            for (int g = 0; g < 4; ++g) { const int c = 64 * w + 32 * cb + 8 * g + 4 * hi;
                const f32x4 w0 = *(const f32x4*)(F.in[I_W0] + c), a0 = *(const f32x4*)(F.in[I_A0] + c);
                float ld[4], ai[4];
#pragma unroll
                for (int i = 0; i < 4; ++i) { ld[i] = -(0.6065306597126334f * LOG2E) * sigmoidf_(w0[i] + aw[cb][4 * g + i]); ai[i] = sigmoidf_(a0[i] + aa[cb][4 * g + i]); }
                *(GAS v2u*)(LDo + orow + c) = (v2u){cvtpk(ld[0], ld[1]), cvtpk(ld[2], ld[3])};
                *(GAS v2u*)(AIo + orow + c) = (v2u){cvtpk(ai[0], ai[1]), cvtpk(ai[2], ai[3])};
                *(GAS v2u*)(GGo + orow + c) = (v2u){cvtpk(ag[cb][4 * g], ag[cb][4 * g + 1]), cvtpk(ag[cb][4 * g + 2], ag[cb][4 * g + 3])}; }
        __syncthreads();
    }
}
}

namespace rwkv {
constexpr int TC = 32, NCH = T / TC;
constexpr int ST = 144, SCM = 72;
constexpr int I_A = 0, I_B = 32 * ST, I_K = 2 * 32 * ST, I_R = 3 * 32 * ST, I_BP = 4 * 32 * ST, I_KP = 5 * 32 * ST, I_V = 6 * 32 * ST, IMG_BYTES = 7 * 32 * ST;
constexpr int O_TM = 0;
constexpr int O_S0 = O_TM + 2 * 32 * SCM;
constexpr int O_YS = O_S0 + 64 * 136;
constexpr int O_NAB = O_YS + 8192;
constexpr int O_SEG = O_NAB + 32 * 144;
constexpr int O_LC = O_SEG + 2048;
constexpr int O_BS = O_LC + 512;
constexpr int O_INV = O_BS + 256;
constexpr int O_IMG = O_INV + 2048;
constexpr int L_BYTES = O_IMG + 2 * IMG_BYTES;
static_assert(L_BYTES <= RING_BYTES, "scan LDS");
__device__ __forceinline__ int crow(int r, int hi) { return (r & 3) + 8 * (r >> 2) + 4 * hi; }
__device__ __forceinline__ bf16x8 ld_tok(const LAS unsigned char* base, int row, int ks, int h) { return *(const LAS bf16x8*)(base + row * ST + 32 * ks + 16 * h); }
__device__ __forceinline__ bf16x8 ld_perm(const LAS unsigned char* base, int stride, int row, int s, int h) {
    const v2u lo = *(const LAS v2u*)(base + row * stride + (16 * s + 4 * h) * 2), hi2 = *(const LAS v2u*)(base + row * stride + (16 * s + 8 + 4 * h) * 2);
    return __builtin_bit_cast(bf16x8, (v4u){lo.x, lo.y, hi2.x, hi2.y});
}
typedef short v4i16_t __attribute__((ext_vector_type(4)));
__device__ __forceinline__ v2u tr4(const LAS unsigned char* img, int blk, int tok0, int lane) {
    const LAS unsigned char* p = img + (tok0 + ((lane & 15) >> 2)) * ST + (32 * blk + 16 * ((lane >> 4) & 1) + 4 * (lane & 3)) * 2;
    return __builtin_bit_cast(v2u, __builtin_amdgcn_ds_read_tr16_b64_v4i16((LAS v4i16_t*)p));
}
__device__ __forceinline__ bf16x8 ld_tr(const LAS unsigned char* img, int blk, int s, int lane) {
    const int h = lane >> 5; const v2u lo = tr4(img, blk, 16 * s + 4 * h, lane), hi2 = tr4(img, blk, 16 * s + 8 + 4 * h, lane);
    return __builtin_bit_cast(bf16x8, (v4u){lo.x, lo.y, hi2.x, hi2.y});
}
__device__ __forceinline__ bf16x8 acc_frag(const f32x16& x, int s) {
    return __builtin_bit_cast(bf16x8, (v4u){cvtpk(x[8 * s], x[8 * s + 1]), cvtpk(x[8 * s + 2], x[8 * s + 3]), cvtpk(x[8 * s + 4], x[8 * s + 5]), cvtpk(x[8 * s + 6], x[8 * s + 7])});
}
#define RW_MFMA(a, b, c) __builtin_amdgcn_mfma_f32_32x32x16_bf16(a, b, c, 0, 0, 0)
__device__ __forceinline__ f32x16 gram(const LAS unsigned char* X, const LAS unsigned char* Y, int r32, int h) {
    f32x16 acc = {};
#pragma unroll
    for (int ks = 0; ks < 4; ++ks) acc = RW_MFMA(ld_tok(X, r32, ks, h), ld_tok(Y, r32, ks, h), acc);
    return acc;
}
__device__ __forceinline__ void unpack4(float (&o)[4], v2u w) { o[0] = bf2f((unsigned short)w.x); o[1] = bf2f((unsigned short)(w.x >> 16)); o[2] = bf2f((unsigned short)w.y); o[3] = bf2f((unsigned short)(w.y >> 16)); }

__device__ __forceinline__ void invert(const LAS unsigned char* img, LAS unsigned char* nabs, LAS unsigned char* tmout, int lane) {
    const int hi = lane >> 5, r32 = lane & 31;
    { f32x16 nab = gram(img + I_B, img + I_A, r32, hi);
#pragma unroll
      for (int q = 0; q < 16; ++q) *(LAS float*)(nabs + crow(q, hi) * 144 + 4 * r32) = (crow(q, hi) < r32) ? nab[q] : 0.f; }
    asm volatile("s_waitcnt lgkmcnt(0)" ::: "memory");
    const LAS unsigned char* nrow0 = nabs; const LAS unsigned char* nrowh = nabs + 16 * hi; LAS unsigned char* tmo = tmout + 2 * r32;
    asm volatile("" : "+v"(nrow0), "+v"(nrowh), "+v"(tmo));
    float tmh[16];
#pragma unroll
    for (int i = 0; i < 16; ++i) tmh[i] = 0.f;
#pragma unroll
    for (int Q = 7; Q >= 0; --Q) {
        float part[4] = {0.f, 0.f, 0.f, 0.f}; f32x4 wq[4];
#pragma unroll
        for (int rr_ = 0; rr_ < 4; ++rr_) wq[rr_] = *(const LAS f32x4*)(nrow0 + (4 * Q + rr_) * 144 + 16 * Q);
#pragma unroll
        for (int pp = ((Q + 1) >> 1); pp < 4; pp += 2) {
            f32x4 nq[4][2];
#pragma unroll
            for (int rr_ = 0; rr_ < 4; ++rr_)
#pragma unroll
                for (int d = 0; d < 2; ++d) if (pp + d < 4) nq[rr_][d] = *(const LAS f32x4*)(nrowh + (4 * Q + rr_) * 144 + 32 * (pp + d));
            __builtin_amdgcn_sched_barrier(0);
#pragma unroll
            for (int d = 0; d < 2; ++d) if (pp + d < 4)
#pragma unroll
                for (int rr_ = 0; rr_ < 4; ++rr_) { const f32x4 n4 = nq[rr_][d]; const int p = pp + d;
                    part[rr_] = fmaf(n4.x, tmh[4 * p], part[rr_]); part[rr_] = fmaf(n4.y, tmh[4 * p + 1], part[rr_]); part[rr_] = fmaf(n4.z, tmh[4 * p + 2], part[rr_]); part[rr_] = fmaf(n4.w, tmh[4 * p + 3], part[rr_]); }
            __builtin_amdgcn_sched_barrier(0);
        }
        float tot[4];
#pragma unroll
        for (int rr_ = 0; rr_ < 4; ++rr_) { const auto sw = __builtin_amdgcn_permlane32_swap(__float_as_uint(part[rr_]), __float_as_uint(part[rr_]), false, false);
            tot[rr_] = __uint_as_float(sw[0]) + __uint_as_float(sw[1]) + ((r32 == 4 * Q + rr_) ? 1.f : 0.f); }
        tot[2] = fmaf(wq[2].w, tot[3], tot[2]);
        tot[1] = fmaf(wq[1].z, tot[2], fmaf(wq[1].w, tot[3], tot[1]));
        tot[0] = fmaf(wq[0].y, tot[1], fmaf(wq[0].z, tot[2], fmaf(wq[0].w, tot[3], tot[0])));
        const bool own = (hi == (Q & 1));
#pragma unroll
        for (int rr_ = 0; rr_ < 4; ++rr_) { const int idx = 4 * (Q >> 1) + rr_; tmh[idx] = own ? tot[rr_] : tmh[idx];
            *(LAS unsigned short*)(tmo + (4 * Q + rr_) * SCM) = (unsigned short)(cvtpk(tot[rr_], tot[rr_]) & 0xffffu); }
        asm volatile("" ::: "memory");
    }
}

__device__ __forceinline__ void unit(Frame& F, int b, int h, int probe) {
    LAS unsigned char* L = F.lds + RING_OFF;
    LAS float* Y_s = (LAS float*)(L + O_YS); LAS float* SEG = (LAS float*)(L + O_SEG);
    const bf16* P = (const bf16*)(F.ws + WS_P); bf16* MIX = (bf16*)(F.ws + WS_MIX);
    const bf16* LDi = (const bf16*)F.out; const bf16* AIi = LDi + (size_t)M * 512; const bf16* GGi = AIi + (size_t)M * 512;
    const float* mu = F.in[I_MU];
    const int lane = F.lane, w = F.wave, hi = lane >> 5, r32 = lane & 31;
    const size_t rowbase = (size_t)b * T;
    int te = F.tid >> 4, cq = F.tid & 15, c0 = h * 64 + 4 * cq;
    { const int q_ = F.tid >> 6, c_ = F.tid & 63; const float* src_ = q_ == 0 ? F.in[I_KK] : q_ == 1 ? F.in[I_KA] : q_ == 2 ? F.in[I_RK] : q_ == 3 ? F.in[I_LNG] : q_ == 4 ? F.in[I_LNB] : mu + 512 * (q_ - 5);
      ((LAS float*)(L + O_INV))[F.tid] = src_[h * 64 + c_]; }
#define inv4 ((const LAS f32x4*)(L + O_INV) + cq)
    for (int i = F.tid; i < 64 * 136 / 4; i += NWAVES * 64) ((LAS unsigned*)(L + O_S0))[i] = 0u;
    v2u ec[3], ep[3], eld, eai;
#define RW_LOAD_RAW(t0_) do { const int hp_ = ((t0_) + te) > 0; const size_t row_ = rowbase + (t0_) + te; const bf16* c_ = P + row_ * NIN + c0; const bf16* p_ = c_ - (hp_ ? NIN : 0); \
        ec[0] = *(const GAS v2u*)(c_ + PC_R); ec[1] = *(const GAS v2u*)(c_ + PC_RK); ec[2] = *(const GAS v2u*)(c_ + PC_RV); \
        ep[0] = *(const GAS v2u*)(p_ + PC_R); ep[1] = *(const GAS v2u*)(p_ + PC_RK); ep[2] = *(const GAS v2u*)(p_ + PC_RV); \
        if (!hp_) { ep[0] = (v2u){0u, 0u}; ep[1] = ep[0]; ep[2] = ep[0]; } \
        eld = *(const GAS v2u*)(LDi + row_ * 512 + c0); eai = *(const GAS v2u*)(AIi + row_ * 512 + c0); } while (0)
    float r[4], k2[4], v[4], av[4], bv[4], ld[4], lam[4];
#define RW_E1(pb_) do { \
        float rr_[4], pr_[4], kc_[4], kp_[4], vc_[4], vp_[4], ai_[4], kkv_[4]; unpack4(rr_, ec[0]); unpack4(pr_, ep[0]); unpack4(kc_, ec[1]); unpack4(kp_, ep[1]); unpack4(vc_, ec[2]); unpack4(vp_, ep[2]); unpack4(ld, eld); unpack4(ai_, eai); \
        const f32x4 kk4 = inv4[0], ka4 = inv4[16], rk4 = inv4[32], mur4 = inv4[80], muk4 = inv4[96], muv4 = inv4[112]; float kraw_[4]; \
        _Pragma("unroll") for (int i = 0; i < 4; ++i) { r[i] = rr_[i] + (pr_[i] - rr_[i]) * mur4[i]; kraw_[i] = kc_[i] + (kp_[i] - kc_[i]) * muk4[i]; v[i] = vc_[i] + (vp_[i] - vc_[i]) * muv4[i]; kkv_[i] = kraw_[i] * kk4[i]; } \
        const float ss_ = red16((kkv_[0] * kkv_[0] + kkv_[1] * kkv_[1]) + (kkv_[2] * kkv_[2] + kkv_[3] * kkv_[3])); \
        const float inv_ = __builtin_amdgcn_rsqf(fmaxf(ss_, L2_EPS * L2_EPS)); float bon_ = 0.f; \
        _Pragma("unroll") for (int i = 0; i < 4; ++i) { const float kn = kkv_[i] * inv_; k2[i] = kraw_[i] * (1.0f + (ai_[i] - 1.0f) * ka4[i]); av[i] = -kn; bv[i] = kn * ai_[i]; bon_ += r[i] * k2[i] * rk4[i]; } \
        bon_ = red16(bon_); if (cq == 0) ((LAS float*)(L + O_BS))[(pb_) * 32 + te] = bon_; \
          \
        _Pragma("unroll") for (int i = 0; i < 4; ++i) { float x_ = ld[i]; const float u1_ = __shfl_up(x_, 16); if (lane >= 16) x_ += u1_; const float u2_ = __shfl_up(x_, 32); if (lane >= 32) x_ += u2_; lam[i] = x_; } \
        if (lane >= 48) *(LAS f32x4*)(SEG + w * 64 + 4 * cq) = (f32x4){lam[0], lam[1], lam[2], lam[3]}; } while (0)
#define RW_E3(pb_) do { \
        f32x4 off_ = (f32x4){0.f, 0.f, 0.f, 0.f}, tot_ = off_; \
        _Pragma("unroll") for (int s_ = 0; s_ < 8; ++s_) { const f32x4 t_ = *(const LAS f32x4*)(SEG + s_ * 64 + 4 * cq); tot_ += t_; if (s_ < w) off_ += t_; } \
        LAS unsigned char* img_ = L + O_IMG + (pb_) * IMG_BYTES; float al_[4], be_[4], ka_[4], rh_[4], bp_[4], kp2_[4]; \
        _Pragma("unroll") for (int i = 0; i < 4; ++i) { const float lm_ = lam[i] + off_[i]; \
            const float g_ = __builtin_amdgcn_exp2f(lm_), gi_ = __builtin_amdgcn_exp2f(-lm_), gm1_ = __builtin_amdgcn_exp2f(lm_ - ld[i]), e_ = __builtin_amdgcn_exp2f(tot_[i] - lm_); \
            al_[i] = av[i] * gm1_; be_[i] = bv[i] * gi_; ka_[i] = k2[i] * gi_; rh_[i] = r[i] * g_; bp_[i] = bv[i] * e_; kp2_[i] = k2[i] * e_; } \
        *(LAS v2u*)(img_ + I_A + te * ST + 8 * cq) = (v2u){cvtpk(al_[0], al_[1]), cvtpk(al_[2], al_[3])}; \
        *(LAS v2u*)(img_ + I_B + te * ST + 8 * cq) = (v2u){cvtpk(be_[0], be_[1]), cvtpk(be_[2], be_[3])}; \
        *(LAS v2u*)(img_ + I_K + te * ST + 8 * cq) = (v2u){cvtpk(ka_[0], ka_[1]), cvtpk(ka_[2], ka_[3])}; \
        *(LAS v2u*)(img_ + I_R + te * ST + 8 * cq) = (v2u){cvtpk(rh_[0], rh_[1]), cvtpk(rh_[2], rh_[3])}; \
        *(LAS v2u*)(img_ + I_BP + te * ST + 8 * cq) = (v2u){cvtpk(bp_[0], bp_[1]), cvtpk(bp_[2], bp_[3])}; \
        *(LAS v2u*)(img_ + I_KP + te * ST + 8 * cq) = (v2u){cvtpk(kp2_[0], kp2_[1]), cvtpk(kp2_[2], kp2_[3])}; \
        *(LAS v2u*)(img_ + I_V + te * ST + 8 * cq) = (v2u){cvtpk(v[0], v[1]), cvtpk(v[2], v[3])}; \
        if (te == 0) *(LAS f32x4*)((LAS float*)(L + O_LC) + (pb_) * 64 + 4 * cq) = tot_; } while (0)
    RW_LOAD_RAW(0);
    __syncthreads();
    RW_E1(0);
    RW_LOAD_RAW(TC);
    __syncthreads();
    RW_E3(0);
    __syncthreads();
    if (w == 0) invert(L + O_IMG, L + O_NAB, L + O_TM, lane);
    __syncthreads();
    for (int c = 0; c < NCH; ++c) {
        const int pb = c & 1, nb = pb ^ 1; const bool more = (c + 1 < NCH);
        asm volatile("" : "+v"(te), "+v"(cq));  c0 = h * 64 + 4 * cq;
        const v2u gcur = *(const GAS v2u*)(GGi + (rowbase + c * TC + te) * 512 + c0);
        if (more && !(probe & 16)) { RW_E1(nb); if (c + 2 < NCH) RW_LOAD_RAW((c + 2) * TC); }
        __syncthreads();
        if (more && !(probe & 16)) RW_E3(nb);
        __syncthreads();
        const LAS unsigned char* img = L + O_IMG + pb * IMG_BYTES; const LAS unsigned char* tmc = L + O_TM + pb * 32 * SCM;
        f32x16 sres = {};
        if (w == 0) { if (more && !(probe & 4)) invert(L + O_IMG + nb * IMG_BYTES, L + O_NAB, L + O_TM + nb * 32 * SCM, lane); }
        else if ((w == 1 || w == 2) && !(probe & 8)) {
            const int vb = w - 1;
            f32x16 X = {};
            { f32x16 t1 = gram(img + I_B, img + I_R, r32, hi);
#pragma unroll
              for (int q = 0; q < 16; ++q) t1[q] = (crow(q, hi) <= r32) ? t1[q] : 0.f;
#pragma unroll
              for (int s_ = 0; s_ < 2; ++s_) X = RW_MFMA(ld_perm(tmc, SCM, r32, s_, hi), acc_frag(t1, s_), X); }
            f32x16 qy = gram(img + I_K, img + I_R, r32, hi);
            { f32x16 t2 = gram(img + I_A, img + I_K, r32, hi);
#pragma unroll
              for (int q = 0; q < 16; ++q) { const int cr_ = crow(q, hi); t2[q] = (r32 < cr_) ? t2[q] : 0.f; qy[q] = (cr_ <= r32) ? qy[q] : 0.f; }
#pragma unroll
              for (int s_ = 0; s_ < 2; ++s_) qy = RW_MFMA(acc_frag(t2, s_), acc_frag(X, s_), qy); }
            f32x16 y = {};
#pragma unroll
            for (int s_ = 0; s_ < 2; ++s_) y = RW_MFMA(ld_tr(img + I_V, vb, s_, lane), acc_frag(qy, s_), y);
#pragma unroll
            for (int kb = 0; kb < 2; ++kb) { f32x16 py;
#pragma unroll
                for (int g = 0; g < 4; ++g) { float c4[4]; unpack4(c4, *(const LAS v2u*)(img + I_R + r32 * ST + (32 * kb + 8 * g + 4 * hi) * 2)); py[4 * g] = c4[0]; py[4 * g + 1] = c4[1]; py[4 * g + 2] = c4[2]; py[4 * g + 3] = c4[3]; }
#pragma unroll
                for (int s_ = 0; s_ < 2; ++s_) py = RW_MFMA(ld_tr(img + I_A, kb, s_, lane), acc_frag(X, s_), py);
#pragma unroll
                for (int s_ = 0; s_ < 2; ++s_) y = RW_MFMA(ld_perm(L + O_S0, 136, 32 * vb + r32, 2 * kb + s_, hi), acc_frag(py, s_), y); }
#pragma unroll
            for (int g = 0; g < 4; ++g) *(LAS f32x4*)(Y_s + r32 * 64 + 32 * vb + 8 * g + 4 * hi) = (f32x4){y[4 * g], y[4 * g + 1], y[4 * g + 2], y[4 * g + 3]};
        } else if (w >= 4 && !(probe & 8)) {
            const int vb = (w >> 1) & 1, cb = w & 1;
            f32x16 Z = {};
#pragma unroll
            for (int s_ = 0; s_ < 2; ++s_) Z = RW_MFMA(ld_perm(tmc, SCM, r32, s_, hi), ld_tr(img + I_BP, cb, s_, lane), Z);
            { f32x16 hc;
#pragma unroll
              for (int g = 0; g < 4; ++g) { float c4[4]; unpack4(c4, tr4(img + I_KP, cb, 8 * g + 4 * hi, lane)); hc[4 * g] = c4[0]; hc[4 * g + 1] = c4[1]; hc[4 * g + 2] = c4[2]; hc[4 * g + 3] = c4[3]; }
              { f32x16 t2 = gram(img + I_A, img + I_K, r32, hi);
#pragma unroll
                for (int q = 0; q < 16; ++q) t2[q] = (r32 < crow(q, hi)) ? t2[q] : 0.f;
#pragma unroll
                for (int s_ = 0; s_ < 2; ++s_) hc = RW_MFMA(acc_frag(t2, s_), acc_frag(Z, s_), hc); }
#pragma unroll
              for (int s_ = 0; s_ < 2; ++s_) sres = RW_MFMA(ld_tr(img + I_V, vb, s_, lane), acc_frag(hc, s_), sres); }
            const float gC = __builtin_amdgcn_exp2f(((const LAS float*)(L + O_LC))[pb * 64 + 32 * cb + r32]);
#pragma unroll
            for (int kb = 0; kb < 2; ++kb) { f32x16 gc;
#pragma unroll
                for (int q = 0; q < 16; ++q) gc[q] = (kb == cb && crow(q, hi) == r32) ? gC : 0.f;
#pragma unroll
                for (int s_ = 0; s_ < 2; ++s_) gc = RW_MFMA(ld_tr(img + I_A, kb, s_, lane), acc_frag(Z, s_), gc);
#pragma unroll
                for (int s_ = 0; s_ < 2; ++s_) sres = RW_MFMA(ld_perm(L + O_S0, 136, 32 * vb + r32, 2 * kb + s_, hi), acc_frag(gc, s_), sres); }
        }
        __syncthreads();
        if (w >= 4) { const int vb = (w >> 1) & 1, cb = w & 1;
#pragma unroll
            for (int q = 0; q < 16; q += 2) { const unsigned pkd = cvtpk(sres[q], sres[q + 1]);
                *(LAS unsigned short*)(L + O_S0 + (32 * vb + crow(q, hi)) * 136 + (32 * cb + r32) * 2) = (unsigned short)(pkd & 0xffffu);
                *(LAS unsigned short*)(L + O_S0 + (32 * vb + crow(q + 1, hi)) * 136 + (32 * cb + r32) * 2) = (unsigned short)(pkd >> 16); }
        }
        if (!(probe & 8)) {
            const f32x4 y = *(const LAS f32x4*)(Y_s + te * 64 + 4 * cq);
            const float mean = red16((y.x + y.y) + (y.z + y.w)) * (1.f / 64.f);
            const f32x4 dy = y - mean;
            const float var = red16((dy.x * dy.x + dy.y * dy.y) + (dy.z * dy.z + dy.w * dy.w)) * (1.f / 64.f);
            const float rstd = __builtin_amdgcn_rsqf(var + GN_EPS);
            const float bon = ((const LAS float*)(L + O_BS))[pb * 32 + te];
            float vv_[4], gg_[4]; unpack4(vv_, *(const LAS v2u*)(img + I_V + te * ST + 8 * cq)); unpack4(gg_, gcur);
            const f32x4 lg4 = inv4[48], lb4 = inv4[64];
            const f32x4 o = ((dy * rstd) * lg4 + lb4 + (f32x4){vv_[0], vv_[1], vv_[2], vv_[3]} * bon) * (f32x4){gg_[0], gg_[1], gg_[2], gg_[3]};
            *(GAS v2u*)(MIX + (rowbase + c * TC + te) * 1024 + 512 + c0) = (v2u){cvtpk(o.x, o.y), cvtpk(o.z, o.w)};
        }
    }
#undef inv4
#undef RW_LOAD_RAW
#undef RW_E1
#undef RW_E3
#undef RW_MFMA
}
}

#ifndef PROBE_REP
#define PROBE_REP 0
#endif
#ifndef PROBE_SKIP
#define PROBE_SKIP 0
#endif
struct Args { const float* in[25]; float* out; unsigned char* ws; int ph_lo, ph_hi, li, pad; };
__global__ void __launch_bounds__(NWAVES * 64, 2) skel_fwd(Args args) {
    extern __shared__ __attribute__((aligned(16))) unsigned char lds[];
    Frame F;
    F.lds = (LAS unsigned char*)lds;
    F.MISC = (volatile LAS unsigned*)(F.lds + MISC_OFF);
    F.tid = threadIdx.x; F.lane = F.tid & 63; F.wave = __builtin_amdgcn_readfirstlane(F.tid >> 6);
    F.G = gridDim.x; { const int bx = blockIdx.x; F.vcu = (F.G % 8 == 0) ? (bx % 8) * (F.G / 8) + bx / 8 : bx; }
#define GRID_BAR(seam) do { if (N_LAUNCHES == PER_PHASE) { if (F.tid == 0) __hip_atomic_store(F.ctl + CW_TMO, 0xBADBA0u | (unsigned)(seam), RLX_AGENT); } \
    else { xcd_barrier(bar); } } while (0)
    unsigned char* ws = args.ws; F.ws = ws;
    F.ctl = (gu32*)(ws + WS_CTL);
#pragma unroll
    for (int i = 0; i < 25; ++i) F.in[i] = args.in[i];
    F.out = args.out;
    for (int u = F.tid; u < (LDS_BYTES - LDSCTL_OFF) / 4; u += NWAVES * 64) ((LAS unsigned*)(F.lds + LDSCTL_OFF))[u] = 0u;
    __syncthreads();
    XcdBarrier bar; bar.bar = (unsigned*)(F.ctl + CW_BAR); bar.x = 0; bar.st = nullptr;
    if (N_LAUNCHES != PER_PHASE) bar = xcd_barrier_post((unsigned*)(F.ctl + CW_BAR), F.MISC + 8);

    const int lo = args.ph_lo, hi = args.ph_hi;
#define IN(k) (lo <= (k) && (k) < hi)
#define BOTH(k) (IN(k) && IN((k) + 1))
    const float* modp = (const float*)(ws + WS_MOD);

    if (IN(0)) { p0_prologue(F); if (BOTH(0)) GRID_BAR(0); }
    if (IN(1)) { xn_pass(F, F.in[I_X], F.in[I_N1G], 0, 1024); if (BOTH(1)) GRID_BAR(1); }
    if (IN(2)) {
        pg8::Gemm g{(const bf16*)(ws + WS_XN), (const bf16*)(ws + WS_WIN), M, NIN, D}; pg8::StaticOrder S; S.init(M, NIN, F.G, (int)blockIdx.x);
        pg8::EpiBf16<0> E{(bf16*)(ws + WS_P), NIN, nullptr, 0, 0, 1.f};
        pg8::gemm_phase<pg8::EpiBf16<0>, pg8::StaticOrder, PG8_ALIGN, PG8_SP2>(F.lds + RING_OFF, g, S, E);
        if (BOTH(2)) GRID_BAR(2);
    }
    if (IN(3)) { fox_prep(F); rwprep::run(F); if (BOTH(3)) GRID_BAR(3); }
    if (IN(4)) {
        const int half = F.G >> 1, me = F.vcu >> 1;
        if ((F.vcu & 1) == 0 && F.vcu < 2 * half) { if (!(args.pad & 1))
            for (int bh = me; bh < BATCH * RWKVH; bh += half) rwkv::unit(F, bh >> 3, bh & 7, args.pad);
        } else if (F.vcu < 2 * half && !(args.pad & 2)) {
            static_assert(attn_body::ATTN_LDS_BYTES <= RING_BYTES, "attention LDS");
            const attn_body::AttnTensors AT{(const attn_body::bf16*)(ws + WS_QN), (const attn_body::bf16*)(ws + WS_KN), (const attn_body::bf16*)(ws + WS_P) + PC_V, (attn_body::bf16*)(ws + WS_MIX),
                                            (const float*)(ws + WS_CUM), (const float*)(ws + WS_LQ)};
            const attn_body::StaticOrder S(me, half);
            attn_body::attn_phase<attn_body::StaticOrder>((char*)lds + RING_OFF, AT, S);
        }
        if (BOTH(4)) GRID_BAR(4);
    }
    if (IN(5)) {
        pg8::Gemm g{(const bf16*)(ws + WS_MIX), (const bf16*)(ws + WS_WOUT), M, D, D}; pg8::StaticOrder S; S.init(M, D, F.G, (int)blockIdx.x);
        pg8::EpiResGate E{F.in[I_X], F.out, modp + 2048, D, 6144};
        pg8::gemm_phase<pg8::EpiResGate, pg8::StaticOrder, PG8_ALIGN, PG8_SP2>(F.lds + RING_OFF, g, S, E);
        if (BOTH(5)) GRID_BAR(5);
    }
    if (IN(6)) { xn_pass(F, F.out, F.in[I_N2G], 3072, 4096); if (BOTH(6)) GRID_BAR(6); }
    if (IN(7)) {
        pg8::Gemm g{(const bf16*)(ws + WS_XN), (const bf16*)(ws + WS_WGU), M, NGU, D}; pg8::StaticOrder S; S.init(M, NGU, F.G, (int)blockIdx.x);
        pg8::EpiSwiGLU E{(bf16*)(ws + WS_HH), FF};
        pg8::gemm_phase<pg8::EpiSwiGLU, pg8::StaticOrder, PG8_ALIGN, PG8_SP2>(F.lds + RING_OFF, g, S, E);
        if (BOTH(7)) GRID_BAR(7);
    }
    if (IN(8)) {
        pg8::Gemm g{(const bf16*)(ws + WS_HH), (const bf16*)(ws + WS_WDN), M, D, FF}; pg8::StaticOrder S; S.init(M, D, F.G, (int)blockIdx.x);
        pg8::EpiResGate E{F.out, F.out, modp + 5120, D, 6144};
        pg8::gemm_phase<pg8::EpiResGate, pg8::StaticOrder, PG8_ALIGN, PG8_SP2>(F.lds + RING_OFF, g, S, E);
    }
#undef IN
#undef BOTH
}

extern "C" void kernel_launch(void* const* d_in, const int* in_sizes, int n_in, void* d_out, int out_size, void* d_ws, size_t ws_size, hipStream_t stream) {
    static int grid = 0;
    if (grid == 0) {
        if (n_in != 25 || in_sizes[0] != M * D || out_size != M * D || ws_size < WS_END) { fprintf(stderr, "kernel_launch: unexpected shapes (n_in %d, in0 %d, out %d, ws %zu); nothing launched\n", n_in, n_in > 0 ? in_sizes[0] : -1, out_size, ws_size); grid = -1; return; }
        int dev = 0, cus = 0, per_cu = 0;
        if (hipGetDevice(&dev) != hipSuccess || hipDeviceGetAttribute(&cus, hipDeviceAttributeMultiprocessorCount, dev) != hipSuccess) { fprintf(stderr, "kernel_launch: device query failed\n"); grid = -1; return; }
        if (hipFuncSetAttribute((const void*)skel_fwd, hipFuncAttributeMaxDynamicSharedMemorySize, LDS_BYTES) != hipSuccess) { fprintf(stderr, "kernel_launch: hipFuncSetAttribute failed\n"); grid = -1; return; }
        if (hipOccupancyMaxActiveBlocksPerMultiprocessor(&per_cu, (const void*)skel_fwd, NWAVES * 64, LDS_BYTES) != hipSuccess || per_cu < 1)
            fprintf(stderr, "kernel_launch: note: occupancy query reports %d workgroups per CU\n", per_cu);
        (void)hipGetLastError();
        grid = cus;
    }
    if (grid < 0) return;
    if (hipMemsetAsync((char*)d_ws + WS_CTL, 0, CTL_ZERO_BYTES, stream) != hipSuccess) { fprintf(stderr, "kernel_launch: hipMemsetAsync failed\n"); return; }
    Args a{};
    for (int i = 0; i < 25; ++i) a.in[i] = (const float*)d_in[i];
    a.out = (float*)d_out; a.ws = (unsigned char*)d_ws;
    for (int li = 0; li < N_LAUNCHES; ++li) {
        a.ph_lo = (N_LAUNCHES == PER_PHASE) ? li : 0; a.ph_hi = (N_LAUNCHES == PER_PHASE) ? li + 1 : PER_PHASE; a.li = li;
        hipLaunchKernelGGL(skel_fwd, dim3(grid), dim3(NWAVES * 64), LDS_BYTES, stream, a);
        if (N_LAUNCHES == PER_PHASE && ((PROBE_REP >> li) & 1)) { a.pad = PROBE_SKIP; hipLaunchKernelGGL(skel_fwd, dim3(grid), dim3(NWAVES * 64), LDS_BYTES, stream, a); a.pad = 0; }
        const hipError_t le = hipPeekAtLastError();
        if (le != hipSuccess) { fprintf(stderr, "kernel_launch: launch %d failed: %s\n", li, hipGetErrorName(le)); break; }
    }
}
```

```cpp
#define MK_N_LAUNCHES 1
#define PROBE_REP 0
#define PROBE_SKIP 0
#include <hip/hip_runtime.h>
#include <cstdio>
#include <cstdint>
namespace pg8 {
#define PG8_LAS __attribute__((address_space(3)))
typedef unsigned short bf16_t;
typedef short bf16x8 __attribute__((ext_vector_type(8)));
typedef float f32x4 __attribute__((ext_vector_type(4)));
typedef unsigned u32x4 __attribute__((ext_vector_type(4)));
constexpr int BM = 256, BK = 64, HALF = 128, HTB = HALF * BK * 2  , STAGE_BYTES = 8 * HTB, NXCD = 8, WGM = 8;

__host__ __device__ __forceinline__ int lds_byte(int r, int c) { const int st = (r >> 4) * 2 + (c >> 5), rr = r & 15, cc = c & 31, ob = rr * 64 + cc * 2; return st * 1024 + (ob ^ (((ob >> 9) & 1) << 5)); }
__host__ __device__ __forceinline__ void stage_rc(int b, int& R, int& C) { const int st = b / 1024, sb = b % 1024, swz = sb ^ (((sb >> 9) & 1) << 5); R = (st >> 1) * 16 + swz / 64; C = (st & 1) * 32 + (swz % 64) / 2; }
__host__ __device__ __forceinline__ int perm32(int rho) { const int n = rho >> 4, i = rho & 15; return 8 * (i >> 2) + 4 * n + (i & 3); }

struct Unit { int pm, pn; };
struct Gemm { const bf16_t* A; const bf16_t* Bt; int M, N, K; };

struct StaticOrder {
    int nM, nN, nwg, G, c;
    __host__ __device__ void init(int M, int N, int G_, int c_) { nM = M / BM; nN = N / BM; nwg = nM * nN; G = G_; c = c_; }
    __host__ __device__ bool next(int i, Unit& u) const {
        const long L = (long)i * G + c; if (L >= nwg) return false;
        int wgid = (int)L; { const int q = nwg / NXCD, r = nwg % NXCD, xcd = wgid % NXCD, off = wgid / NXCD; wgid = (xcd < r ? xcd * (q + 1) : r * (q + 1) + (xcd - r) * q) + off; }
        const int nig = WGM * nN, gid = wgid / nig, fm = gid * WGM, gsz = (nM - fm) < WGM ? (nM - fm) : WGM;
        u.pm = fm + ((wgid % nig) % gsz); u.pn = (wgid % nig) / gsz; return true;
    }
    __device__ __forceinline__ void a_ready(const Unit&) const {}
    __device__ __forceinline__ void done(const Unit&) const {}
};

__device__ __forceinline__ unsigned cvt_pk_bf16(float lo, float hi) { unsigned r; asm volatile("v_cvt_pk_bf16_f32 %0, %1, %2" : "=v"(r) : "v"(lo), "v"(hi)); return r; }
typedef float f32x2 __attribute__((ext_vector_type(2)));
__device__ __forceinline__ f32x2 gelu_pk(f32x2 v) {
    const f32x2 av = __builtin_elementwise_abs(v), d = av * 0.2316418882f + 1.0f;
    f32x2 t; t.x = __builtin_amdgcn_rcpf(d.x); t.y = __builtin_amdgcn_rcpf(d.y);
    f32x2 q = t * 0.5307027145f + (-0.7265760135f); q = q * t + 0.7107068705f; q = q * t + (-0.142248368f); q = q * t + 0.127414796f; q = q * t;
    const f32x2 s = (v * v) * (-0.72134752044f);
    f32x2 e; e.x = __builtin_amdgcn_exp2f(s.x); e.y = __builtin_amdgcn_exp2f(s.y);
    const f32x2 m = v * (q * e), r = v - m;
    f32x2 o; o.x = v.x < 0.f ? m.x : r.x; o.y = v.y < 0.f ? m.y : r.y; return o;
}

template <int ACT  > struct EpiBf16 {
    static constexpr bool PERM = true, AFTER_DRAIN = false; static_assert(ACT == 0 || ACT == 1, "EpiBf16: ACT is 0 (none) or 1 (gelu_pk)");
    bf16_t* O; int ldc; const float* bias; int split_cols; size_t split_stride; float scale0;
    __device__ __forceinline__ void operator()(const f32x4 (&acc)[2][2][4][2], const Unit& u, int wr, int wc, int fr, int fq) const {
        const int row0 = u.pm * BM + wr * 64 + fr; int colt = u.pn * BM; bf16_t* base = O;
        float sc = 1.f; if (split_cols) { const int t = colt / split_cols; base += (size_t)t * split_stride; colt -= t * split_cols; if (t == 0) sc = scale0; }
        const int col0 = colt + wc * 32 + 8 * fq, bcol0 = u.pn * BM + wc * 32 + 8 * fq;
        f32x4 bv[2][2];
#pragma unroll
        for (int bj = 0; bj < 2; ++bj)
#pragma unroll
            for (int n = 0; n < 2; ++n) bv[bj][n] = bias ? *(const f32x4*)(bias + bcol0 + bj * HALF + 4 * n) : (f32x4){0.f, 0.f, 0.f, 0.f};
#pragma unroll
        for (int ai = 0; ai < 2; ++ai)
#pragma unroll
            for (int m = 0; m < 4; ++m) { bf16_t* rowp = base + (size_t)(row0 + ai * HALF + m * 16) * ldc + col0;
#pragma unroll
                for (int bj = 0; bj < 2; ++bj) { f32x4 v0 = acc[ai][bj][m][0] + bv[bj][0], v1 = acc[ai][bj][m][1] + bv[bj][1];
                    if (ACT == 1) { f32x2 a = gelu_pk((f32x2){v0[0], v0[1]}), b = gelu_pk((f32x2){v0[2], v0[3]}), c = gelu_pk((f32x2){v1[0], v1[1]}), d = gelu_pk((f32x2){v1[2], v1[3]});
                        v0 = (f32x4){a.x, a.y, b.x, b.y}; v1 = (f32x4){c.x, c.y, d.x, d.y}; }
                    v0 = v0 * sc; v1 = v1 * sc; u32x4 w; w.x = cvt_pk_bf16(v0[0], v0[1]); w.y = cvt_pk_bf16(v0[2], v0[3]); w.z = cvt_pk_bf16(v1[0], v1[1]); w.w = cvt_pk_bf16(v1[2], v1[3]);
                    *(u32x4*)(rowp + bj * HALF) = w; } }
    }
};
struct EpiResGate {
    static constexpr bool PERM = false, AFTER_DRAIN = false;
    const float* base; float* out; const float* gate; int ldc; int gate_ld;
    __device__ __forceinline__ void operator()(const f32x4 (&acc)[2][2][4][2], const Unit& u, int wr, int wc, int fr, int fq) const {
        const int b = (u.pm * BM) >> 11; const float* g = gate + (size_t)b * gate_ld;
        const int col0 = u.pn * BM + wc * 32 + 4 * fq;
        f32x4 gv[2][2];
#pragma unroll
        for (int bj = 0; bj < 2; ++bj)
#pragma unroll
            for (int n = 0; n < 2; ++n) gv[bj][n] = *(const f32x4*)(g + col0 + bj * HALF + n * 16);
#pragma unroll
        for (int ai = 0; ai < 2; ++ai)
#pragma unroll
            for (int m = 0; m < 4; ++m) { const size_t off = (size_t)(u.pm * BM + ai * HALF + wr * 64 + m * 16 + fr) * ldc + col0;
                f32x4 bs[2][2];
#pragma unroll
                for (int bj = 0; bj < 2; ++bj)
#pragma unroll
                    for (int n = 0; n < 2; ++n) bs[bj][n] = *(const f32x4*)(base + off + bj * HALF + n * 16);
#pragma unroll
                for (int bj = 0; bj < 2; ++bj)
#pragma unroll
                    for (int n = 0; n < 2; ++n) *(f32x4*)(out + off + bj * HALF + n * 16) = bs[bj][n] + gv[bj][n] * acc[ai][bj][m][n];
                asm volatile("" ::: "memory"); }
    }
};
struct EpiSwiGLU {
    static constexpr bool PERM = true, AFTER_DRAIN = false;
    bf16_t* O; int ldc;
    __device__ __forceinline__ void operator()(const f32x4 (&acc)[2][2][4][2], const Unit& u, int wr, int wc, int fr, int fq) const {
        const int row0 = u.pm * BM + wr * 64 + fr, col0 = u.pn * HALF + wc * 32 + 8 * fq;
#pragma unroll
        for (int ai = 0; ai < 2; ++ai)
#pragma unroll
            for (int m = 0; m < 4; ++m) { bf16_t* rowp = O + (size_t)(row0 + ai * HALF + m * 16) * ldc + col0;
                float hv[8];
#pragma unroll
                for (int n = 0; n < 2; ++n)
#pragma unroll
                    for (int i = 0; i < 4; ++i) { const float g = acc[ai][0][m][n][i], up = acc[ai][1][m][n][i];
                        const float sg = g * __builtin_amdgcn_rcpf(1.0f + __builtin_amdgcn_exp2f(-1.4426950408889634f * g)); hv[4 * n + i] = sg * up; }
                u32x4 w; w.x = cvt_pk_bf16(hv[0], hv[1]); w.y = cvt_pk_bf16(hv[2], hv[3]); w.z = cvt_pk_bf16(hv[4], hv[5]); w.w = cvt_pk_bf16(hv[6], hv[7]);
                *(u32x4*)rowp = w; }
    }
};

template <class Epi, class Sched, bool ALIGN_EPI = false, bool SP2 = false>
__device__ __forceinline__ void gemm_phase(PG8_LAS unsigned char* lds, const Gemm g, const Sched& S, const Epi& E) {
    const int tid = threadIdx.x, wid = __builtin_amdgcn_readfirstlane(tid >> 6), lane = tid & 63, wr = wid >> 2, wc = wid & 3, fr = lane & 15, fq = lane >> 4;
    const int K = g.K, nt = K / BK;
    unsigned voffA[2], voffB[2];
#pragma unroll
    for (int i = 0; i < 2; ++i) { int R, C; stage_rc(tid * 16 + i * 8192, R, C); const int Rb = Epi::PERM ? ((R & ~31) + perm32(R & 31)) : R;
        voffA[i] = (unsigned)(R * K + C) * 2u; voffB[i] = (unsigned)(Rb * K + C) * 2u; }
    const size_t kstep = (size_t)(BK * 2);
    const size_t hstep = (size_t)HALF * K * 2;
    const size_t tstep = 2 * hstep;
    const unsigned ldsw = (unsigned)wid * 1024u;
    const int aoff = lds_byte(wr * 64 + fr, fq * 8), boff = lds_byte(wc * 32 + fr, fq * 8);
#define PG8_SA(b, h) (((b) * 2 + (h)) * HTB)
#define PG8_SB(b, h) ((4 + (b) * 2 + (h)) * HTB)
#define PG8_STAGE(bufoff, gbase, voff) do { _Pragma("unroll") for (int _i = 0; _i < 2; ++_i) \
        __builtin_amdgcn_global_load_lds((const unsigned*)((const char*)(gbase) + (voff)[_i]), (PG8_LAS unsigned*)(lds + (bufoff) + ldsw + _i * 8192), 16, 0, 0); } while (0)
#define PG8_LDA(dst, b, h) do { _Pragma("unroll") for (int m = 0; m < 4; ++m) _Pragma("unroll") for (int k = 0; k < 2; ++k) dst[m][k] = *(const PG8_LAS bf16x8*)(lds + PG8_SA(b, h) + aoff + m * 2048 + k * 1024); } while (0)
#define PG8_LDB(dst, b, h) do { _Pragma("unroll") for (int n = 0; n < 2; ++n) _Pragma("unroll") for (int k = 0; k < 2; ++k) dst[n][k] = *(const PG8_LAS bf16x8*)(lds + PG8_SB(b, h) + boff + n * 2048 + k * 1024); } while (0)
#define PG8_MMA(ai, bj, At, Bt) do { __builtin_amdgcn_s_setprio(1); _Pragma("unroll") for (int m = 0; m < 4; ++m) _Pragma("unroll") for (int n = 0; n < 2; ++n) _Pragma("unroll") for (int k = 0; k < 2; ++k) \
        acc[ai][bj][m][n] = __builtin_amdgcn_mfma_f32_16x16x32_bf16(Bt[n][k], At[m][k], acc[ai][bj][m][n], 0, 0, 0); __builtin_amdgcn_s_setprio(0); } while (0)
#define PG8_WAIT_V(n) asm volatile("s_waitcnt vmcnt(" #n ")" ::: "memory")
#define PG8_WAIT_L(n) asm volatile("s_waitcnt lgkmcnt(" #n ")" ::: "memory")
#define PG8_BAR __builtin_amdgcn_s_barrier()
#define PG8_SCHED __builtin_amdgcn_sched_barrier(0)
    Unit cur, nxt; int ui = 0;
    if (!S.next(0, cur)) return;
    f32x4 acc[2][2][4][2];
#pragma unroll
    for (int a = 0; a < 2; ++a)
#pragma unroll
        for (int b = 0; b < 2; ++b)
#pragma unroll
            for (int m = 0; m < 4; ++m)
#pragma unroll
                for (int n = 0; n < 2; ++n) acc[a][b][m][n] = (f32x4){0.f, 0.f, 0.f, 0.f};
    bf16x8 At[4][2], B0[2][2], B1[2][2];
    const char* cA = (const char*)g.A + (size_t)cur.pm * tstep; const char* cB = (const char*)g.Bt + (size_t)cur.pn * tstep;
    S.a_ready(cur);
    if constexpr (SP2) {
        PG8_STAGE(PG8_SB(0, 0), cB, voffB); PG8_STAGE(PG8_SB(0, 1), cB + hstep, voffB); PG8_STAGE(PG8_SA(0, 0), cA, voffA); PG8_STAGE(PG8_SA(0, 1), cA + hstep, voffA);
        if (wr == 1) PG8_BAR;
        PG8_WAIT_V(2); PG8_BAR;
        PG8_STAGE(PG8_SB(1, 0), cB + kstep, voffB); PG8_STAGE(PG8_SA(1, 0), cA + kstep, voffA); PG8_STAGE(PG8_SB(1, 1), cB + hstep + kstep, voffB);
        PG8_WAIT_V(6); PG8_BAR;
    } else {
        PG8_STAGE(PG8_SB(0, 0), cB, voffB); PG8_STAGE(PG8_SA(0, 0), cA, voffA); PG8_STAGE(PG8_SB(0, 1), cB + hstep, voffB); PG8_STAGE(PG8_SA(0, 1), cA + hstep, voffA);
        if (wr == 1) PG8_BAR;
        PG8_WAIT_V(4); PG8_BAR;
        PG8_STAGE(PG8_SB(1, 0), cB + kstep, voffB); PG8_STAGE(PG8_SA(1, 0), cA + kstep, voffA); PG8_STAGE(PG8_SB(1, 1), cB + hstep + kstep, voffB);
        PG8_WAIT_V(6); PG8_BAR;
    }
    for (;;) {
        const bool has_next = S.next(ui + 1, nxt);
        const char* nA = has_next ? (const char*)g.A + (size_t)nxt.pm * tstep : cA; const char* nB = has_next ? (const char*)g.Bt + (size_t)nxt.pn * tstep : cB;
        for (int t = 0; t < nt; t += 2) {
            const bool last = (t == nt - 2);
            const char* a1 = cA + (size_t)(t + 1) * kstep;
            const char* a2 = last ? nA : cA + (size_t)(t + 2) * kstep; const char* b2 = last ? nB : cB + (size_t)(t + 2) * kstep;
            const char* a3 = a2 + kstep; const char* b3 = b2 + kstep;
            if (last && has_next) S.a_ready(nxt);
            if constexpr (SP2) {
            PG8_LDB(B0, 0, 0); PG8_LDB(B1, 0, 1); PG8_SCHED; PG8_LDA(At, 0, 0); PG8_STAGE(PG8_SA(1, 1), a1 + hstep, voffA);
            PG8_WAIT_V(8); PG8_WAIT_L(0); PG8_BAR; PG8_MMA(0, 0, At, B0); PG8_MMA(0, 1, At, B1); PG8_BAR; PG8_SCHED;
            PG8_LDA(At, 0, 1); PG8_STAGE(PG8_SB(0, 0), b2, voffB); PG8_STAGE(PG8_SB(0, 1), b2 + hstep, voffB); PG8_STAGE(PG8_SA(0, 0), a2, voffA);
            PG8_WAIT_V(8); PG8_WAIT_L(0); PG8_BAR; PG8_MMA(1, 0, At, B0); PG8_MMA(1, 1, At, B1); PG8_BAR; PG8_SCHED;
            PG8_LDB(B0, 1, 0); PG8_LDB(B1, 1, 1); PG8_SCHED; PG8_LDA(At, 1, 0); PG8_STAGE(PG8_SA(0, 1), a2 + hstep, voffA);
            PG8_WAIT_V(8); PG8_WAIT_L(0); PG8_BAR; PG8_MMA(0, 0, At, B0); PG8_MMA(0, 1, At, B1); PG8_BAR; PG8_SCHED;
            PG8_LDA(At, 1, 1); PG8_STAGE(PG8_SB(1, 0), b3, voffB); PG8_STAGE(PG8_SB(1, 1), b3 + hstep, voffB); PG8_STAGE(PG8_SA(1, 0), a3, voffA);
            PG8_WAIT_V(8); PG8_WAIT_L(0); PG8_BAR; PG8_MMA(1, 0, At, B0); PG8_MMA(1, 1, At, B1); PG8_BAR; PG8_SCHED;
            } else {
            PG8_LDB(B0, 0, 0); PG8_SCHED; PG8_LDA(At, 0, 0); PG8_STAGE(PG8_SA(1, 1), a1 + hstep, voffA);
            PG8_WAIT_L(8); PG8_BAR; PG8_WAIT_L(0); PG8_MMA(0, 0, At, B0); PG8_BAR; PG8_SCHED;
            PG8_LDB(B1, 0, 1); PG8_STAGE(PG8_SB(0, 0), b2, voffB);
            PG8_BAR; PG8_WAIT_L(0); PG8_MMA(0, 1, At, B1); PG8_BAR;
            PG8_LDA(At, 0, 1); PG8_STAGE(PG8_SA(0, 0), a2, voffA);
            PG8_BAR; PG8_WAIT_L(0); PG8_MMA(1, 0, At, B0); PG8_BAR; PG8_SCHED;
            PG8_STAGE(PG8_SB(0, 1), b2 + hstep, voffB);
            PG8_WAIT_V(6); PG8_BAR; PG8_MMA(1, 1, At, B1); PG8_BAR;
            PG8_LDB(B0, 1, 0); PG8_SCHED; PG8_LDA(At, 1, 0); PG8_STAGE(PG8_SA(0, 1), a2 + hstep, voffA);
            PG8_WAIT_L(8); PG8_BAR; PG8_WAIT_L(0); PG8_MMA(0, 0, At, B0); PG8_BAR; PG8_SCHED;
            PG8_LDB(B1, 1, 1); PG8_STAGE(PG8_SB(1, 0), b3, voffB);
            PG8_BAR; PG8_WAIT_L(0); PG8_MMA(0, 1, At, B1); PG8_BAR;
            PG8_LDA(At, 1, 1); PG8_STAGE(PG8_SA(1, 0), a3, voffA);
            PG8_BAR; PG8_WAIT_L(0); PG8_MMA(1, 0, At, B0); PG8_BAR; PG8_SCHED;
            PG8_STAGE(PG8_SB(1, 1), b3 + hstep, voffB);
            PG8_WAIT_V(6); PG8_BAR; PG8_MMA(1, 1, At, B1); PG8_BAR;
            }
        }
        if constexpr (ALIGN_EPI) { if (wr == 0) PG8_BAR; }
        if constexpr (!Epi::AFTER_DRAIN) { E(acc, cur, wr, wc, fr, fq); S.done(cur); }
        if (!has_next) break;
#pragma unroll
        for (int a = 0; a < 2; ++a)
#pragma unroll
            for (int b = 0; b < 2; ++b)
#pragma unroll
                for (int m = 0; m < 4; ++m)
#pragma unroll
                    for (int n = 0; n < 2; ++n) acc[a][b][m][n] = (f32x4){0.f, 0.f, 0.f, 0.f};
        cur = nxt; cA = nA; cB = nB; ++ui;
        if constexpr (ALIGN_EPI) { if (wr == 1) PG8_BAR; }
    }
    PG8_WAIT_V(0);
    if constexpr (!ALIGN_EPI) { if (wr == 0) PG8_BAR; }
    PG8_BAR;
    if constexpr (Epi::AFTER_DRAIN) { E.fused(acc, cur, wr, wc, fr, fq, lds, wid, lane); S.done(cur); }
#undef PG8_SA
#undef PG8_SB
#undef PG8_STAGE
#undef PG8_LDA
#undef PG8_LDB
#undef PG8_MMA
#undef PG8_WAIT_V
#undef PG8_WAIT_L
#undef PG8_BAR
#undef PG8_SCHED
}
}

#ifndef PG8_SP2
#define PG8_SP2 true
#endif
#ifndef PG8_ALIGN
#define PG8_ALIGN true
#endif
#include <hip/hip_bf16.h>
#include <cmath>
namespace attn_body {
using bf16=__hip_bfloat16;
using bf16x8=__attribute__((ext_vector_type(8)))short;
using s16x4=__attribute__((ext_vector_type(4)))short;
using f32x16=__attribute__((ext_vector_type(16)))float;
using u32x4=__attribute__((ext_vector_type(4)))unsigned;
using f32x4_t=__attribute__((ext_vector_type(4)))float;
constexpr int BATCH=16,NHEAD=8,SEQ=2048,D=64;
constexpr int QP=512,KP=512,VP=3584,OP=1024;
constexpr int NW=8,QBLK=32,QB=QBLK*NW,KVBLK=64,NQB=SEQ/QB;
constexpr int ATTN_UNIT_ROWS=QB;
__device__ __forceinline__ int crow(int r,int hi){return (r&3)+8*(r>>2)+4*hi;}
#define SBAR() __builtin_amdgcn_sched_barrier(0)
__device__ __forceinline__ void cmask(f32x16&p0,f32x16&p1,int jb,int qrel,int hi){
  const float NEG=-INFINITY; int kb=64*jb+4*hi;
  #pragma unroll
  for(int r=0;r<16;++r){int kv=kb+(r&3)+8*(r>>2); if(kv>qrel)p0[r]=NEG; if(kv+32>qrel)p1[r]=NEG;}
}

constexpr int NSLOT=3, SLOTB=8192;
constexpr int LDS_K=0, LDS_V=NSLOT*SLOTB, LDS_WS=2*NSLOT*SLOTB, LDS_OST=LDS_WS+NW*64*4, LDS_KB=LDS_OST+NW*4096, LDS_CUM=LDS_KB+SEQ*4, LDS_WSUM=LDS_CUM+SEQ*4, LDS_Q=LDS_WSUM+64, LDS_BYTES=LDS_Q+NW*4096;
constexpr float C2=0.125f*1.4426950408889634f;
__device__ __forceinline__ void glds16(const void*gsrc,unsigned lds_dst){unsigned keep;
  asm volatile("s_mov_b32 %0, m0\n\ts_mov_b32 m0, %2\n\ts_nop 0\n\tglobal_load_lds_dwordx4 %1, off\n\ts_mov_b32 m0, %0":"=&s"(keep):"v"(gsrc),"s"(lds_dst):"memory");}
__device__ __forceinline__ float max3f(float a,float b,float c){float r;asm("v_max3_f32 %0, %1, %2, %3":"=v"(r):"v"(a),"v"(b),"v"(c));return r;}
__device__ __forceinline__ float max2f(float a,float b){float r;asm("v_max_f32_e32 %0, %1, %2":"=v"(r):"v"(a),"v"(b));return r;}
__device__ __forceinline__ float fadd_s(float a,float b){float r;asm("v_add_f32_e32 %0, %1, %2":"=v"(r):"v"(a),"v"(b));return r;}
__device__ __forceinline__ float fsub_s(float a,float b){float r;asm("v_sub_f32_e32 %0, %1, %2":"=v"(r):"v"(a),"v"(b));return r;}
typedef float f32x2_t __attribute__((ext_vector_type(2))); typedef __bf16 bf16x2_t __attribute__((ext_vector_type(2)));
__device__ __forceinline__ unsigned cvtpk_s(float lo,float hi){f32x2_t v={lo,hi};bf16x2_t b=__builtin_convertvector(v,bf16x2_t);return __builtin_bit_cast(unsigned,b);}
#define WAIT_BAR(N) asm volatile("s_waitcnt vmcnt(" #N ") lgkmcnt(0)\n\ts_barrier":::"memory")

__device__ __forceinline__ void qkt(f32x16&p0,f32x16&p1,const char*Kslot,const bf16x8*qr,const f32x16&negm,int r32,int hi,bf16x8 kb0,bf16x8 kb1,bf16x8 qone){
  p0=__builtin_amdgcn_mfma_f32_32x32x16_bf16(kb0,qone,negm,0,0,0);p1=__builtin_amdgcn_mfma_f32_32x32x16_bf16(kb1,qone,negm,0,0,0);
  const char*kb=Kslot+hi*1024+r32*16;
  #pragma unroll
  for(int d0=0;d0<4;++d0){
    const bf16x8 b0=*reinterpret_cast<const bf16x8*>(kb+d0*2048);
    const bf16x8 b1=*reinterpret_cast<const bf16x8*>(kb+d0*2048+512);
    p0=__builtin_amdgcn_mfma_f32_32x32x16_bf16(b0,qr[d0],p0,0,0,0);p1=__builtin_amdgcn_mfma_f32_32x32x16_bf16(b1,qr[d0],p1,0,0,0);}
}
typedef __attribute__((address_space(3))) const char* lds_cptr;
typedef short v4i16_t __attribute__((ext_vector_type(4)));
__device__ __forceinline__ void kload8(bf16x8*kf,lds_cptr kp){
  kf[0]=*(const __attribute__((address_space(3))) bf16x8*)(kp);      kf[1]=*(const __attribute__((address_space(3))) bf16x8*)(kp+512);
  kf[2]=*(const __attribute__((address_space(3))) bf16x8*)(kp+2048); kf[3]=*(const __attribute__((address_space(3))) bf16x8*)(kp+2560);
  kf[4]=*(const __attribute__((address_space(3))) bf16x8*)(kp+4096); kf[5]=*(const __attribute__((address_space(3))) bf16x8*)(kp+4608);
  kf[6]=*(const __attribute__((address_space(3))) bf16x8*)(kp+6144); kf[7]=*(const __attribute__((address_space(3))) bf16x8*)(kp+6656);
}
__device__ __forceinline__ void kload2(bf16x8*kf,lds_cptr kp,int j){ kf[2*j]=*(const __attribute__((address_space(3))) bf16x8*)(kp+j*2048); kf[2*j+1]=*(const __attribute__((address_space(3))) bf16x8*)(kp+j*2048+512); }
__device__ __forceinline__ s16x4 vtr(lds_cptr p){ return __builtin_bit_cast(s16x4,__builtin_amdgcn_ds_read_tr16_b64_v4i16((__attribute__((address_space(3))) v4i16_t*)p)); }
__device__ __forceinline__ float rowmax(const f32x16&p0,const f32x16&p1){
  float a=max3f(p0[0],p0[1],p1[0]),b=max3f(p0[2],p0[3],p1[1]);a=max3f(a,p1[2],p1[3]);
  #pragma unroll
  for(int r=4;r<16;r+=4){a=max3f(a,p0[r],p0[r+1]);b=max3f(b,p0[r+2],p0[r+3]);a=max3f(a,p1[r],p1[r+1]);b=max3f(b,p1[r+2],p1[r+3]);}
  const float m=max2f(a,b);
  auto rr=__builtin_amdgcn_permlane32_swap(__float_as_uint(m),__float_as_uint(m),false,false);
  return max2f(__uint_as_float(rr[0]),__uint_as_float(rr[1]));
}
__device__ __forceinline__ void pv(f32x16*o,int vb,bf16x8 pa0,bf16x8 pa1,bf16x8 pa2,bf16x8 pa3){
  #pragma unroll
  for(int d0=0;d0<2;++d0){s16x4 lo[4],hi[4];
    #pragma unroll
    for(int ks=0;ks<4;++ks){
      asm volatile("ds_read_b64_tr_b16 %0,%1 offset:%c2":"=&v"(lo[ks]):"v"(vb),"i"(d0*4096+ks*1024):"memory");
      asm volatile("ds_read_b64_tr_b16 %0,%1 offset:%c2":"=&v"(hi[ks]):"v"(vb),"i"(d0*4096+ks*1024+512):"memory");}
    asm volatile("s_waitcnt lgkmcnt(0)":::"memory");SBAR();
    #define PK(k) (bf16x8){lo[k][0],lo[k][1],lo[k][2],lo[k][3],hi[k][0],hi[k][1],hi[k][2],hi[k][3]}
    o[d0]=__builtin_amdgcn_mfma_f32_32x32x16_bf16(pa0,PK(0),o[d0],0,0,0);
    o[d0]=__builtin_amdgcn_mfma_f32_32x32x16_bf16(pa1,PK(1),o[d0],0,0,0);
    o[d0]=__builtin_amdgcn_mfma_f32_32x32x16_bf16(pa2,PK(2),o[d0],0,0,0);
    o[d0]=__builtin_amdgcn_mfma_f32_32x32x16_bf16(pa3,PK(3),o[d0],0,0,0);
    #undef PK
  }
}

#ifndef ATTN_STORE16
#define ATTN_STORE16(p,v) (*(u32x4*)(p)=(v))
#endif
template<int THRL> __device__ __forceinline__ void attn_unit(int b,int h,int qb,const bf16*Q,const bf16*__restrict__ K,const bf16*__restrict__ V,bf16*O,const float*Cum,const float*Lq,bool newbh,char*shm){
  const int tid=threadIdx.x,lane=tid&63,r32=lane&31,hi=lane>>5; const int wid=__builtin_amdgcn_readfirstlane(tid>>6);
  const long rowbase=(long)b*SEQ; const int q0=qb*QB;
  const bf16*Qw=Q+(rowbase+q0+wid*QBLK)*QP+h*D;
  const bf16*Kh=K+rowbase*KP+h*D,*Vh=V+rowbase*VP+h*D;
  const unsigned lds0=(unsigned)(uintptr_t)shm;
  float*wsf=(float*)(shm+LDS_WS)+wid*64;
  const unsigned kdst=lds0+LDS_K+wid*1024, vdst=lds0+LDS_V+wid*1024;
  #define DMA_K(t,slot) glds16(ksrc+(long)(t)*KVBLK*KP,(unsigned)__builtin_amdgcn_readfirstlane(kdst+(slot)))
  #define DMA_V(t,slot) glds16(vsrc+(long)(t)*KVBLK*VP,(unsigned)__builtin_amdgcn_readfirstlane(vdst+(slot)))
  const int vb0=(int)(lds0+LDS_V)+((lane>>4)&1)*32+(lane&3)*8+(4*hi+((lane&15)>>2))*64;
  const char*Kbase=shm+LDS_K; bf16x8 kf[8];
  const lds_cptr shm3=(lds_cptr)shm; const lds_cptr kp0=shm3+LDS_K+hi*1024+r32*16; const lds_cptr vp0=shm3+LDS_V+((lane>>4)&1)*32+(lane&3)*8+(4*hi+((lane&15)>>2))*64;
  const int NTF=(q0+QB)/KVBLK;
  __attribute__((address_space(3))) float*cumL=(__attribute__((address_space(3))) float*)(shm3+LDS_CUM);
  if(newbh){ __attribute__((address_space(3))) float*wsum=(__attribute__((address_space(3))) float*)(shm3+LDS_WSUM);
    int tid_c=tid; asm volatile("":"+v"(tid_c));
    const float*lf=Cum+((long)b*NHEAD+h)*SEQ; f32x4_t x=*(const f32x4_t*)(lf+4*tid_c); x.y+=x.x; x.z+=x.y; x.w+=x.z;
    const float tot=x.w; float incl=tot;
    #pragma unroll
    for(int o=1;o<64;o<<=1){ const float t_=__shfl_up(incl,o); if(lane>=o)incl+=t_; }
    if(lane==63)wsum[wid]=incl;
    WAIT_BAR(0);
    float woff=0.f;
    #pragma unroll
    for(int w_=0;w_<NW;++w_){ const float t_=wsum[w_]; if(w_<wid)woff+=t_; }
    const float off=woff+incl-tot; x.x+=off; x.y+=off; x.z+=off; x.w+=off;
    *(__attribute__((address_space(3))) f32x4_t*)(cumL+4*tid_c)=x;
    WAIT_BAR(0); }
  const __attribute__((address_space(3))) float*cum=cumL; const float c0=cum[q0];
  { __attribute__((address_space(3))) unsigned*kbw=(__attribute__((address_space(3))) unsigned*)(shm3+LDS_KB);
    for(int s=tid;s<q0+QB;s+=NW*64){ const float v=c0-cum[s]; const unsigned vb=__float_as_uint(v); const unsigned hb=(vb+0x7fffu+((vb>>16)&1u))&0xffff0000u; const float lo=v-__uint_as_float(hb);
      const unsigned lb=__float_as_uint(lo); const unsigned lr=(lb+0x7fffu+((lb>>16)&1u))>>16; kbw[s]=(hb>>16)|(lr<<16); } }
  const float qbias=cum[q0+wid*QBLK+r32]-c0;
  int T0; { const float thr=2.f*Lq[8+h]+36.f; const int j_=lane; const bool pr_=(j_<NTF-4)&&(cum[(j_<NTF?j_:0)*KVBLK+63]-c0>thr);
    T0=(int)__builtin_amdgcn_readfirstlane(__builtin_popcountll(__ballot(pr_)))&~1; }
  const int NT=NTF-T0;
  const float lq=Lq[h];
  const unsigned onew=hi?0u:0x3f803f80u;
  const bf16x8 qone=__builtin_bit_cast(bf16x8,(u32x4){onew,0u,0u,0u});
  const __attribute__((address_space(3))) unsigned*kbp=(const __attribute__((address_space(3))) unsigned*)(shm3+LDS_KB)+r32+T0*KVBLK;
  const bf16*ksrc=Kh+(long)(T0*KVBLK+lane)*KP+wid*8;
  const bf16*vsrc=Vh+(long)(T0*KVBLK+16*(wid&3)+(lane>>2))*VP+(wid>>2)*32+(lane&3)*8;
  #define KBF(t,half) __builtin_bit_cast(bf16x8,(u32x4){kbp[(t)*KVBLK+(half)*32],0u,0u,0u})
  DMA_K(0,0);DMA_V(0,0);DMA_K(1,SLOTB);
  bf16x8 qr[4];
  #pragma unroll
  for(int d0=0;d0<4;++d0)qr[d0]=*reinterpret_cast<const bf16x8*>(&Qw[(long)r32*QP+d0*16+hi*8]);
  const __attribute__((address_space(3))) char*qsl=(const __attribute__((address_space(3))) char*)(shm3+LDS_Q)+wid*4096+lane*64;
  #pragma unroll
  for(int d0=0;d0<4;++d0)*(__attribute__((address_space(3))) bf16x8*)(qsl+16*d0)=qr[d0];
  #define QL(d) (*(const __attribute__((address_space(3))) bf16x8*)(qsl+16*(d)))
  float mhat=0.f,l_reg=0.f;f32x16 o[2];o[0]=f32x16{};o[1]=f32x16{};f32x16 negm;
  #pragma unroll
  for(int r=0;r<16;++r)negm[r]=qbias;
  asm volatile("":"+v"(negm));
  const int qrel=wid*QBLK+r32;
  #define CMASK(P0,P1,t) do{int jb_=(t)-(NT-4); if(jb_>=0)cmask(P0,P1,jb_,qrel,hi);}while(0)
  bool resc=false;
  #define START(P0,P1) do{ const float rm=rowmax(P0,P1); resc=false; \
    { const float dl=__builtin_fmaxf(rm,lq); mhat=fadd_s(mhat,dl); \
      _Pragma("unroll") for(int r=0;r<16;++r){P0[r]=fsub_s(P0[r],dl);P1[r]=fsub_s(P1[r],dl);} \
      _Pragma("unroll") for(int r=0;r<16;++r)negm[r]=qbias-mhat; asm volatile("":"+v"(negm)); } \
    _Pragma("unroll") for(int r=0;r<16;++r)P0[r]=__builtin_amdgcn_exp2f(P0[r]); }while(0)
  #define RESC() do{ if(resc){ asm volatile("s_waitcnt lgkmcnt(0)":::"memory"); \
      _Pragma("unroll") for(int d_=0;d_<2;++d_) _Pragma("unroll") for(int r=0;r<16;++r)o[d_][r]*=wsf[crow(r,hi)]; } }while(0)
  f32x16 pA0,pA1,pB0,pB1;
  int sl_prev=0,sl_cur=0,sl_next=SLOTB;
  #define ROT() do{sl_prev=sl_cur;sl_cur=sl_next;sl_next=(sl_next==(NSLOT-1)*SLOTB)?0:sl_next+SLOTB;}while(0)
  DMA_K(2,2*SLOTB);
  WAIT_BAR(3);
  qkt(pA0,pA1,Kbase,qr,negm,r32,hi,KBF(0,0),KBF(0,1),qone);asm volatile("s_nop 15\n\ts_nop 7":"+v"(pA0),"+v"(pA1));CMASK(pA0,pA1,0);
  START(pA0,pA1);
  _Pragma("unroll") for(int r=0;r<16;++r)pA1[r]=__builtin_amdgcn_exp2f(pA1[r]);
  WAIT_BAR(0);
  DMA_K(3,0);DMA_V(1,SLOTB);
  ROT();
  kload8(kf,kp0+sl_cur);
  WAIT_BAR(2);
  s16x4 vlo[8],vhi[8]; u32x4 pw0,pw1,pw2,pw3;
  #define PKW(P,B) cvtpk_s(P[B],P[B+1])
  #define PAF(k) __builtin_bit_cast(bf16x8,pw##k)
  #define VFR(i) (bf16x8){vlo[i][0],vlo[i][1],vlo[i][2],vlo[i][3],vhi[i][0],vhi[i][1],vhi[i][2],vhi[i][3]}
  #define PIN(x) asm volatile("":"+v"(x))
  #define MX3(a,b,c) __builtin_fmaxf(__builtin_fmaxf((a),(b)),(c))
  #define GAPA(MF,A0,A1,A2,A3,W0,W1,PW) do{ MF; sacc+=A0; sacc+=A1; sacc+=A2; sacc+=A3; PIN(sacc); W0; W1; PIN(PW); SBAR(); }while(0)
  #define EX(v) __builtin_amdgcn_exp2f(v)
  #define GAPB(MF,X,B) do{ MF; X[B]=EX(X[B]); X[B+1]=EX(X[B+1]); X[B+2]=EX(X[B+2]); X[B+3]=EX(X[B+3]); PIN(X); SBAR(); }while(0)
  #define VRD(i) do{ vlo[i]=vtr(vp_+(((i)>>2)*4096+((i)&3)*1024)); vhi[i]=vtr(vp_+(((i)>>2)*4096+((i)&3)*1024+512)); }while(0)
  #define KRD(G,j) do{ if(G){ kload2(kf,kp0+sl_next,j); SBAR(); } }while(0)
  #define STEP(C0,C1,P0,P1,t,GK,GV,GL) do{ SBAR(); \
    const lds_cptr vp_=vp0+sl_prev; \
    { const bf16x8 kb0_=KBF(t,0),kb1_=KBF(t,1); C0=__builtin_amdgcn_mfma_f32_32x32x16_bf16(kb0_,qone,negm,0,0,0); C1=__builtin_amdgcn_mfma_f32_32x32x16_bf16(kb1_,qone,negm,0,0,0); SBAR(); } \
    VRD(0); SBAR(); float sacc=(P0[0]+P0[1]); \
    GAPA(C0=__builtin_amdgcn_mfma_f32_32x32x16_bf16(kf[0],QL(0),C0,0,0,0), P0[2],P0[3],P0[4],P0[5],     pw0[0]=PKW(P0,0), pw0[1]=PKW(P0,2), pw0); \
    VRD(4); SBAR(); GAPA(C1=__builtin_amdgcn_mfma_f32_32x32x16_bf16(kf[1],QL(0),C1,0,0,0), P0[6],P0[7],P0[8],P0[9],     pw0[2]=PKW(P0,4), pw0[3]=PKW(P0,6), pw0); \
    VRD(1); SBAR(); GAPA(C0=__builtin_amdgcn_mfma_f32_32x32x16_bf16(kf[2],QL(1),C0,0,0,0),   P0[10],P0[11],P0[12],P0[13], pw1[0]=PKW(P0,8), pw1[1]=PKW(P0,10), pw1); \
    VRD(5); SBAR(); GAPA(C1=__builtin_amdgcn_mfma_f32_32x32x16_bf16(kf[3],QL(1),C1,0,0,0),   P0[14],P0[15],P1[0],P1[1],   pw1[2]=PKW(P0,12),pw1[3]=PKW(P0,14), pw1); \
    VRD(2); SBAR(); GAPA(C0=__builtin_amdgcn_mfma_f32_32x32x16_bf16(kf[4],QL(2),C0,0,0,0),   P1[2],P1[3],P1[4],P1[5],     pw2[0]=PKW(P1,0), pw2[1]=PKW(P1,2), pw2); \
    VRD(6); SBAR(); GAPA(C1=__builtin_amdgcn_mfma_f32_32x32x16_bf16(kf[5],QL(2),C1,0,0,0),   P1[6],P1[7],P1[8],P1[9],     pw2[2]=PKW(P1,4), pw2[3]=PKW(P1,6), pw2); \
    VRD(3); SBAR(); GAPA(C0=__builtin_amdgcn_mfma_f32_32x32x16_bf16(kf[6],QL(3),C0,0,0,0),   P1[10],P1[11],P1[12],P1[13], pw3[0]=PKW(P1,8), pw3[1]=PKW(P1,10), pw3); \
    VRD(7); SBAR(); GAPA(C1=__builtin_amdgcn_mfma_f32_32x32x16_bf16(kf[7],QL(3),C1,0,0,0),   P1[14],P1[15],0.f,0.f,       pw3[2]=PKW(P1,12),pw3[3]=PKW(P1,14), pw3); \
    l_reg+=sacc; \
    if(GK){DMA_K((t)+3,sl_cur);} if(GV){DMA_V((t)+1,sl_next);} \
    CMASK(C0,C1,t); \
    { float a=MX3(C0[0],C0[1],C1[0]),b=MX3(C0[2],C0[3],C1[1]); a=MX3(a,C1[2],C1[3]); \
      _Pragma("unroll") for(int r=4;r<16;r+=4){a=MX3(a,C0[r],C0[r+1]);b=MX3(b,C0[r+2],C0[r+3]);a=MX3(a,C1[r],C1[r+1]);b=MX3(b,C1[r+2],C1[r+3]);} \
      float rm=__builtin_fmaxf(a,b); { auto rr=__builtin_amdgcn_permlane32_swap(__float_as_uint(rm),__float_as_uint(rm),false,false); rm=__builtin_fmaxf(__uint_as_float(rr[0]),__uint_as_float(rr[1])); } \
      resc=false; \
      if(__builtin_expect(__any(rm>(float)THRL),0)){ const float dl=__builtin_fmaxf(rm,0.f); mhat+=dl; \
        _Pragma("unroll") for(int r=0;r<16;++r){C0[r]-=dl;C1[r]-=dl;} \
        _Pragma("unroll") for(int r=0;r<16;++r)negm[r]=qbias-mhat; asm volatile("":"+v"(negm)); \
        const float f=__builtin_amdgcn_exp2f(-dl); l_reg*=f; if(hi==0)wsf[r32]=f; resc=true; } } \
    SBAR(); \
    GAPB(o[0]=__builtin_amdgcn_mfma_f32_32x32x16_bf16(PAF(0),VFR(0),o[0],0,0,0), C0,0); \
    GAPB(o[1]=__builtin_amdgcn_mfma_f32_32x32x16_bf16(PAF(0),VFR(4),o[1],0,0,0), C0,4); \
    KRD(GL,0); GAPB(o[0]=__builtin_amdgcn_mfma_f32_32x32x16_bf16(PAF(1),VFR(1),o[0],0,0,0), C0,8); \
    KRD(GL,1); GAPB(o[1]=__builtin_amdgcn_mfma_f32_32x32x16_bf16(PAF(1),VFR(5),o[1],0,0,0), C0,12); \
    KRD(GL,2); GAPB(o[0]=__builtin_amdgcn_mfma_f32_32x32x16_bf16(PAF(2),VFR(2),o[0],0,0,0), C1,0); \
    KRD(GL,3); GAPB(o[1]=__builtin_amdgcn_mfma_f32_32x32x16_bf16(PAF(2),VFR(6),o[1],0,0,0), C1,4); \
    GAPB(o[0]=__builtin_amdgcn_mfma_f32_32x32x16_bf16(PAF(3),VFR(3),o[0],0,0,0), C1,8); \
    GAPB(o[1]=__builtin_amdgcn_mfma_f32_32x32x16_bf16(PAF(3),VFR(7),o[1],0,0,0), C1,12); \
    }while(0)
  int t=1;
  #undef CMASK
  #define CMASK(P0,P1,t) do{}while(0)
  for(;t+5<NT;t+=2){
    STEP(pB0,pB1,pA0,pA1,t,true,true,true);     WAIT_BAR(2); RESC(); ROT();
    STEP(pA0,pA1,pB0,pB1,t+1,true,true,true);   WAIT_BAR(2); RESC(); ROT();
  }
  #undef CMASK
  #define CMASK(P0,P1,t) do{int jb_=(t)-(NT-4); if(jb_>=0)cmask(P0,P1,jb_,qrel,hi);}while(0)
  #define ENDW(tt) do{ if((tt)+3<NT){WAIT_BAR(2);} else if((tt)+2<NT){WAIT_BAR(1);} else {WAIT_BAR(0);} }while(0)
  for(;t+1<NT;t+=2){
    STEP(pB0,pB1,pA0,pA1,t,(t+3<NT),(t+1<NT),(t+1<NT));       ENDW(t);   RESC(); ROT();
    STEP(pA0,pA1,pB0,pB1,t+1,(t+4<NT),(t+2<NT),(t+2<NT));     ENDW(t+1); RESC(); ROT();
  }
  STEP(pB0,pB1,pA0,pA1,NT-1,false,false,false); RESC();
  { float sacc=pB0[0]+pB0[1]; _Pragma("unroll") for(int r=2;r<16;++r)sacc+=pB0[r]; _Pragma("unroll") for(int r=0;r<16;++r)sacc+=pB1[r]; l_reg+=sacc;
    pw0=(u32x4){PKW(pB0,0),PKW(pB0,2),PKW(pB0,4),PKW(pB0,6)};pw1=(u32x4){PKW(pB0,8),PKW(pB0,10),PKW(pB0,12),PKW(pB0,14)};pw2=(u32x4){PKW(pB1,0),PKW(pB1,2),PKW(pB1,4),PKW(pB1,6)};pw3=(u32x4){PKW(pB1,8),PKW(pB1,10),PKW(pB1,12),PKW(pB1,14)};
    SBAR(); pv(o,vb0+sl_cur,PAF(0),PAF(1),PAF(2),PAF(3)); }
  #undef PKW
  #undef PAF
  #undef VFR
  #undef PIN
  #undef MX3
  #undef GAPA
  #undef GAPB
  #undef EX
  #undef VRD
  #undef KRD
  #undef STEP
  #undef ENDW
  {auto rr=__builtin_amdgcn_permlane32_swap(__float_as_uint(l_reg),__float_as_uint(l_reg),false,false);l_reg=__uint_as_float(rr[0])+__uint_as_float(rr[1]);}
  if(hi==0)wsf[32+r32]=l_reg;asm volatile("s_waitcnt lgkmcnt(0)":::"memory");
  float rli[16];
  #pragma unroll
  for(int r=0;r<16;++r)rli[r]=__builtin_amdgcn_rcpf(wsf[32+crow(r,hi)]);
  bf16*Ow=O+(rowbase+q0+wid*QBLK)*OP+h*D;
  { bf16*stg=(bf16*)(shm+LDS_OST)+wid*2048;
    #pragma unroll
    for(int r=0;r<16;++r){const int orow=crow(r,hi);
      #pragma unroll
      for(int d0=0;d0<2;++d0)stg[orow*64+d0*32+r32]=__float2bfloat16(o[d0][r]*rli[r]);}
    asm volatile("s_waitcnt lgkmcnt(0)":::"memory");
    int lane_e=lane; asm volatile("":"+v"(lane_e));
    #pragma unroll
    for(int i=0;i<4;++i){const int row=i*8+(lane_e>>3),ch=lane_e&7; const u32x4 v=*(const u32x4*)(stg+row*64+ch*8); ATTN_STORE16(Ow+(long)row*OP+ch*8,v);} }
  asm volatile("s_waitcnt lgkmcnt(0)\n\ts_barrier":::"memory");
  #undef KBF
  #undef QL
  #undef DMA_K
  #undef DMA_V
  #undef CMASK
  #undef START
  #undef RESC
  #undef ROT
}
constexpr int ATTN_LDS_BYTES=LDS_BYTES;
struct AttnTensors { const bf16* Q; const bf16* K; const bf16* V; bf16* O; const float* Cum; const float* Lq; };
struct AttnUnit { int bh; int qb; };
struct StaticOrder {
  int a,na;
  __device__ __forceinline__ StaticOrder(int a_,int na_):a(a_),na(na_){}
  __device__ __forceinline__ bool next(int i,AttnUnit&u)const{ const int bh=a+(i/NQB)*na; if(a<0||bh>=BATCH*NHEAD)return false; u.bh=bh; u.qb=NQB-1-(i%NQB); return true; }
  __device__ __forceinline__ void a_ready(const AttnUnit&)const{}
  __device__ __forceinline__ void done(const AttnUnit&)const{}
};
template<class Sched,int THRL=16> __device__ __forceinline__ void attn_phase(char*lds,const AttnTensors&T,const Sched&S){
  AttnUnit u; int last_=-1;
  for(int i=0;S.next(i,u);++i){ S.a_ready(u); attn_unit<THRL>(u.bh/NHEAD,u.bh%NHEAD,u.qb,T.Q,T.K,T.V,T.O,T.Cum,T.Lq,u.bh!=last_,lds); last_=u.bh; S.done(u); }
}
#undef SBAR
#undef WAIT_BAR
}
constexpr int NWAVES = 8;
#ifndef MK_N_LAUNCHES
#define MK_N_LAUNCHES 1
#endif
constexpr int PER_PHASE = 9;
constexpr int N_LAUNCHES = MK_N_LAUNCHES;
static_assert(N_LAUNCHES == 1 || N_LAUNCHES == PER_PHASE, "MK_N_LAUNCHES is 1 or 9");

constexpr int BATCH = 16, T = 2048, D = 1024, HD = 64, FOXH = 8, RWKVH = 8, FF = 2816;
constexpr int M = BATCH * T;
constexpr int IN_COLS = 3368;
constexpr int NIN = 3584;
constexpr int PC_Q = 0, PC_K = 512, PC_V = 1024, PC_R = 1536, PC_RK = 2048, PC_RV = 2560, PC_WDN = 3072, PC_ADN = 3136, PC_GDN = 3200, PC_F = 3360;
constexpr int NGU = 2 * FF;
constexpr float RMS_EPS = 1e-6f, GN_EPS = 64e-5f, L2_EPS = 1e-12f;
constexpr float LOG2E = 1.4426950408889634f;

constexpr size_t MiB = 1u << 20, KiB = 1u << 10;
constexpr size_t WS_CTL = 0, CTL_ZERO_BYTES = 64 * KiB;
constexpr size_t WS_WIN = 1 * MiB, WS_WOUT = 8 * MiB, WS_WGU = 10 * MiB, WS_WDN = 21 * MiB;
constexpr size_t WS_W2T = 27 * MiB, WS_A2T = WS_W2T + 64 * KiB, WS_G2T = WS_A2T + 64 * KiB;
constexpr size_t WS_MOD = 27 * MiB + 512 * KiB;
constexpr size_t WS_LQ = 27 * MiB + 960 * KiB;
constexpr size_t WS_CUM = 28 * MiB;
constexpr size_t WS_XN = 32 * MiB;
constexpr size_t WS_QN = 96 * MiB, WS_KN = 128 * MiB;
constexpr size_t WS_MIX = 160 * MiB;
constexpr size_t WS_P = 224 * MiB;
constexpr size_t WS_HH = WS_P;
constexpr size_t WS_SCR = 448 * MiB;
constexpr size_t WS_END = 452 * MiB;
static_assert(WS_WIN + (size_t)NIN * D * 2 <= WS_WOUT && WS_WGU + (size_t)NGU * D * 2 <= WS_WDN && WS_WDN + (size_t)D * FF * 2 <= WS_W2T && WS_G2T + 512 * 160 * 2 <= WS_MOD && WS_MOD + 16 * 6144 * 4 <= WS_LQ, "ws map");
static_assert(WS_P + (size_t)M * NIN * 2 <= WS_END && WS_HH + (size_t)M * FF * 2 <= WS_END, "ws map");
constexpr int CW_TMO = 0, CW_CODE = 1, CW_LATE = 2048;
constexpr int CW_BAR = 4096;

constexpr int RING_OFF = 0, RING_BYTES = 162816;
constexpr int LDSCTL_OFF = RING_BYTES, MISC_OFF = LDSCTL_OFF + 320;
constexpr int LDS_BYTES = 163840;
static_assert(MISC_OFF + 128 <= LDS_BYTES, "LDS map");
#define GAS __attribute__((address_space(1)))
#define LAS __attribute__((address_space(3)))
typedef unsigned short bf16;
typedef unsigned v4u __attribute__((ext_vector_type(4)));
typedef float f32x4 __attribute__((ext_vector_type(4)));
typedef short bf16x8 __attribute__((ext_vector_type(8)));
typedef GAS unsigned gu32;
typedef GAS unsigned long long gu64;
#define RLX_AGENT __ATOMIC_RELAXED, __HIP_MEMORY_SCOPE_AGENT
#define LDS_WAIT() asm volatile("s_waitcnt lgkmcnt(0)" ::: "memory")
#define VM_WAIT() asm volatile("s_waitcnt vmcnt(0)" ::: "memory")
__device__ __forceinline__ unsigned long long rt() { return __builtin_amdgcn_s_memrealtime(); }
__device__ __forceinline__ unsigned f2bf(float f) { unsigned u = __builtin_bit_cast(unsigned, f); return (u + 0x7fffu + ((u >> 16) & 1u)) >> 16; }
__device__ __forceinline__ unsigned pk2(float lo, float hi) { return f2bf(lo) | (f2bf(hi) << 16); }

#define XB_TMO      128
#define XB_XCNT(j)  (256  + 64 * (j))
#define XB_XSUB(j)  (1280 + 64 * (j))
#define XB_XGEN(j)  (2304 + 64 * (j))
#define XB_TOP      3328
#define XB_TOPGEN   3392
#define XCD_BAR_WORDS 3456
#define XB_SPIN_CAP (1u << 18)

__device__ __forceinline__ unsigned xb_ld(unsigned* p)              { return __hip_atomic_load(p, __ATOMIC_RELAXED, __HIP_MEMORY_SCOPE_AGENT); }
__device__ __forceinline__ unsigned xb_add(unsigned* p, unsigned v) { return __hip_atomic_fetch_add(p, v, __ATOMIC_RELAXED, __HIP_MEMORY_SCOPE_AGENT); }
__device__ __forceinline__ unsigned xb_xcc_id() { return (unsigned)__builtin_amdgcn_s_getreg((3 << 11) | 20) & 0xFu; }
#define XB_SPIN(cond, bar) do { unsigned _sp = 0; while (cond) { __builtin_amdgcn_s_sleep(1); \
    if ((++_sp & 255u) == 0u) { if (xb_ld(&(bar)[XB_TMO])) break; if (_sp > XB_SPIN_CAP) { atomicAdd(&(bar)[XB_TMO], 1u); break; } } } } while (0)

struct XcdBarrier {
    unsigned* bar; unsigned x;
    volatile LAS unsigned* st;
};

__device__ __forceinline__ XcdBarrier xcd_barrier_post(unsigned* bar, volatile LAS unsigned* st) {
    XcdBarrier b; b.bar = bar; b.x = xb_xcc_id(); b.st = st;
    if (threadIdx.x == 0) (void)xb_add(&bar[XB_XCNT(b.x)], 1u);
    return b;
}
__device__ __forceinline__ void xcd_barrier_complete(unsigned* bar, unsigned x, unsigned& nloc, unsigned& nx) {
    const unsigned G = gridDim.x * gridDim.y * gridDim.z;
    unsigned sum, cnt, mine, sp = 0u;
    for (;;) {
        sum = 0u; cnt = 0u; mine = 0u;
#pragma unroll
        for (unsigned j = 0; j < 16; ++j) { const unsigned c = xb_ld(&bar[XB_XCNT(j)]); sum += c; cnt += (c > 0u) ? 1u : 0u; mine = (j == x) ? c : mine; }
        if (sum == G) break;
        __builtin_amdgcn_s_sleep(1);
        if ((++sp & 255u) == 0u) { if (xb_ld(&bar[XB_TMO])) break; if (sp > XB_SPIN_CAP) { atomicAdd(&bar[XB_TMO], 1u); break; } }
    }
    nloc = mine > 0u ? mine : 1u; nx = cnt > 0u ? cnt : 1u;
}

__device__ __forceinline__ void xcd_barrier(const XcdBarrier& b) {
    asm volatile("s_waitcnt vmcnt(0)" ::: "memory");
    __syncthreads();
    if (threadIdx.x == 0) {
        unsigned* bar = b.bar;
        __builtin_amdgcn_s_waitcnt(0);
        unsigned nloc = b.st[0], nx = b.st[1];
        if (nloc == 0u) { xcd_barrier_complete(bar, b.x, nloc, nx); b.st[0] = nloc; b.st[1] = nx; }
        const unsigned old = xb_add(&bar[XB_XSUB(b.x)], 1u);
        const unsigned gen = old / nloc;
        if (old + 1u == (gen + 1u) * nloc) {
            __builtin_amdgcn_fence(__ATOMIC_RELEASE, "agent");
            asm volatile("s_waitcnt vmcnt(0)" ::: "memory");
            const unsigned og = xb_add(&bar[XB_TOP], 1u);
            const unsigned tg = og / nx;
            if (og + 1u == (tg + 1u) * nx) xb_add(&bar[XB_TOPGEN], 1u);
            else XB_SPIN(xb_ld(&bar[XB_TOPGEN]) == tg, bar);
            __builtin_amdgcn_fence(__ATOMIC_ACQUIRE, "agent");
            xb_add(&bar[XB_XGEN(b.x)], 1u);
            asm volatile("s_waitcnt vmcnt(0)" ::: "memory");
        } else {
            XB_SPIN(xb_ld(&bar[XB_XGEN(b.x)]) == gen, bar);
            __builtin_amdgcn_fence(__ATOMIC_ACQUIRE, "agent");
            asm volatile("s_waitcnt vmcnt(0)" ::: "memory");
        }
    }
    __syncthreads();
}
typedef float f32x2 __attribute__((ext_vector_type(2)));
typedef float f32x16 __attribute__((ext_vector_type(16)));
typedef unsigned v2u __attribute__((ext_vector_type(2)));
struct Frame {
    LAS unsigned char* lds;
    volatile LAS unsigned* MISC;
    gu32* ctl;
    int tid, lane, wave;
    int vcu, G;
    const float* in[25]; float* out; unsigned char* ws;
};
enum { I_X = 0, I_C, I_ADAW, I_ADAB, I_N1G, I_N2G, I_WIN, I_FBIAS, I_QG, I_KG, I_MU, I_W0, I_W2, I_A0, I_A2, I_G2, I_KK, I_KA, I_RK, I_LNG, I_LNB, I_WOUT, I_WG, I_WU, I_WD };

__device__ __forceinline__ float wave_sum(float v) {
#pragma unroll
    for (int o = 1; o < 64; o <<= 1) v += __shfl_xor(v, o);
    return v;
}
__device__ __forceinline__ float wave_max(float v) {
#pragma unroll
    for (int o = 1; o < 64; o <<= 1) v = fmaxf(v, __shfl_xor(v, o));
    return v;
}
template <int CTRL> __device__ __forceinline__ float dpp_f(float x) { return __int_as_float(__builtin_amdgcn_update_dpp(0, __float_as_int(x), CTRL, 0xf, 0xf, true)); }
__device__ __forceinline__ float red16(float x) {
    x += dpp_f<0xB1>(x);
    x += dpp_f<0x4E>(x);
    x += dpp_f<0x141>(x);
    x += dpp_f<0x140>(x);
    return x;
}
__device__ __forceinline__ float red8(float x) {
    x += dpp_f<0xB1>(x); x += dpp_f<0x4E>(x); x += dpp_f<0x141>(x); return x;
}
typedef __bf16 bf16x2_t __attribute__((ext_vector_type(2)));
__device__ __forceinline__ unsigned cvtpk(float lo, float hi) { const f32x2 v = {lo, hi}; const bf16x2_t b = __builtin_convertvector(v, bf16x2_t); return __builtin_bit_cast(unsigned, b); }
__device__ __forceinline__ float bf2f(unsigned short h) { return __uint_as_float((unsigned)h << 16); }
__device__ __forceinline__ float sigmoidf_(float x) { return __builtin_amdgcn_rcpf(1.0f + __builtin_amdgcn_exp2f(-LOG2E * x)); }
__device__ __forceinline__ float tanhf_(float x) { return 1.0f - 2.0f * __builtin_amdgcn_rcpf(1.0f + __builtin_amdgcn_exp2f(2.0f * LOG2E * x)); }

template <class RowMap>
__device__ __forceinline__ void p0_transpose_item(const float* W, int K, int N, bf16* WT, int ldk, RowMap rm, LAS float* scr, int item, int lane) {
    const int nblk = (N + 31) / 32, kb = item / nblk, nb = item % nblk, k0 = 64 * kb, n0 = 32 * nb;
    const int nn = n0 + (lane & 31);
#pragma unroll
    for (int i = 0; i < 32; ++i) { const int kk = 2 * i + (lane >> 5); scr[kk * 33 + (lane & 31)] = (k0 + kk < K && nn < N) ? W[(size_t)(k0 + kk) * N + nn] : 0.f; }
    LDS_WAIT(); asm volatile("" ::: "memory");
    const int c = lane & 7;
#pragma unroll
    for (int j = 0; j < 4; ++j) { const int n = (lane >> 3) + 8 * j; const LAS float* s = scr + (8 * c) * 33 + n;
        v4u o; o.x = pk2(s[0 * 33], s[1 * 33]); o.y = pk2(s[2 * 33], s[3 * 33]); o.z = pk2(s[4 * 33], s[5 * 33]); o.w = pk2(s[6 * 33], s[7 * 33]);
        if (n0 + n < N && k0 + 8 * c < K) *(GAS v4u*)(WT + (size_t)rm(n0 + n) * ldk + k0 + 8 * c) = o; }
    LDS_WAIT(); asm volatile("" ::: "memory");
}
struct RmId { __device__ __forceinline__ int operator()(int n) const { return n; } };
struct RmWin { __device__ __forceinline__ int operator()(int n) const { return n < 1536 ? n : (n < 1544 ? PC_F + (n - 1536) : (n - 1544) + PC_R); } };
struct RmGate { int up; __device__ __forceinline__ int operator()(int n) const { return (n >> 7) * 256 + (n & 127) + up * 128; } };

__device__ __forceinline__ void p0_prologue(Frame& F) {
    LAS float* scr = (LAS float*)(F.lds + RING_OFF + F.wave * 16384);
    const int gw = F.vcu * NWAVES + F.wave, NGW = F.G * NWAVES;
    bf16* WIN = (bf16*)(F.ws + WS_WIN);
    bf16* W2T = (bf16*)(F.ws + WS_W2T); bf16* A2T = (bf16*)(F.ws + WS_A2T); bf16* G2T = (bf16*)(F.ws + WS_G2T);
    if (F.vcu < 6144 / 32) {
        LAS float* sc = (LAS float*)(F.lds + RING_OFF);
        LAS float* red = (LAS float*)(F.lds + RING_OFF + 65536);
        const float* cin = F.in[I_C];
        for (int i = F.tid; i < 16 * 1024; i += NWAVES * 64) { const int b = i >> 10, k = i & 1023; const float v = cin[i]; sc[k * 16 + b] = v * sigmoidf_(v); }
        __syncthreads();
        const int col = F.tid & 31, kg = F.tid >> 5, j0 = F.vcu * 32;
        float acc[16];
#pragma unroll
        for (int b = 0; b < 16; ++b) acc[b] = 0.f;
        const float* wp = F.in[I_ADAW] + (size_t)(kg * 64) * 6144 + j0 + col;
        for (int k = 0; k < 64; ++k) { const float w = wp[(size_t)k * 6144]; const LAS f32x4* s4 = (const LAS f32x4*)(sc + (kg * 64 + k) * 16);
#pragma unroll
            for (int q = 0; q < 4; ++q) { const f32x4 s = s4[q]; acc[4 * q] += s.x * w; acc[4 * q + 1] += s.y * w; acc[4 * q + 2] += s.z * w; acc[4 * q + 3] += s.w * w; } }
#pragma unroll
        for (int b = 0; b < 16; ++b) red[(kg * 16 + b) * 32 + col] = acc[b];
        __syncthreads();
        { const int b = F.tid >> 5; float s = F.in[I_ADAB][j0 + col];
#pragma unroll
          for (int g = 0; g < 16; ++g) s += red[(g * 16 + b) * 32 + col];
          ((float*)(F.ws + WS_MOD))[b * 6144 + j0 + col] = s; }
        __syncthreads();
    }
    constexpr int I_IN = (D / 64) * ((IN_COLS + 31) / 32), I_L = 512 / 32, I_LG = 3 * (512 / 32);
    constexpr int NITEMS = I_IN + 2 * I_L + I_LG;
    for (int it = gw; it < NITEMS; it += NGW) {
        int r = it;
        if (r < I_IN) { p0_transpose_item(F.in[I_WIN], D, IN_COLS, WIN, D, RmWin{}, scr, r, F.lane); continue; } r -= I_IN;
        if (r < I_L) { p0_transpose_item(F.in[I_W2], 64, 512, W2T, 64, RmId{}, scr, r, F.lane); continue; } r -= I_L;
        if (r < I_L) { p0_transpose_item(F.in[I_A2], 64, 512, A2T, 64, RmId{}, scr, r, F.lane); continue; } r -= I_L;
        p0_transpose_item(F.in[I_G2], 160, 512, G2T, 160, RmId{}, scr, r, F.lane);
    }
    { const int gt = F.vcu * NWAVES * 64 + F.tid, NGT = F.G * NWAVES * 64; GAS v4u* z = (GAS v4u*)(WIN + (size_t)IN_COLS * D);
      for (int i = gt; i < (NIN - IN_COLS) * D / 8; i += NGT) z[i] = (v4u){0u, 0u, 0u, 0u}; }
    if (gw < FOXH) { const float gq = wave_max(fabsf(F.in[I_QG][gw * 64 + F.lane])), gk = wave_max(fabsf(F.in[I_KG][gw * 64 + F.lane]));
        const float bh = 8.0f * gq * gk * LOG2E * 1.01f;
        if (F.lane == 0) { ((float*)(F.ws + WS_LQ))[gw] = fminf(0.f, 100.f - bh); ((float*)(F.ws + WS_LQ))[8 + gw] = bh; } }
}

__device__ __forceinline__ void xn_pass(Frame& F, const float* x, const float* gain, int shift_off, int scale_off) {
    const int gw = F.vcu * NWAVES + F.wave, NGW = F.G * NWAVES; const float* mod = (const float*)(F.ws + WS_MOD); bf16* XN = (bf16*)(F.ws + WS_XN);
    for (int m0 = 2 * gw; m0 < M; m0 += 2 * NGW) {
        f32x4 v[2][4]; float s[2];
#pragma unroll
        for (int q = 0; q < 2; ++q) { const GAS f32x4* xr = (const GAS f32x4*)(x + (size_t)(m0 + q) * D) + F.lane;
#pragma unroll
            for (int j = 0; j < 4; ++j) v[q][j] = xr[64 * j]; }
#pragma unroll
        for (int q = 0; q < 2; ++q) { s[q] = 0.f;
#pragma unroll
            for (int j = 0; j < 4; ++j) s[q] += (v[q][j].x * v[q][j].x + v[q][j].y * v[q][j].y) + (v[q][j].z * v[q][j].z + v[q][j].w * v[q][j].w); }
#pragma unroll
        for (int o = 1; o < 64; o <<= 1) { s[0] += __shfl_xor(s[0], o); s[1] += __shfl_xor(s[1], o); }
        const int b = m0 >> 11;
#pragma unroll
        for (int j = 0; j < 4; ++j) { const int c = 4 * F.lane + 256 * j;
            const f32x4 g = *(const f32x4*)(gain + c), sc = *(const f32x4*)(mod + b * 6144 + scale_off + c), sh = *(const f32x4*)(mod + b * 6144 + shift_off + c);
            const f32x4 gs = g * (sc + 1.0f);
#pragma unroll
            for (int q = 0; q < 2; ++q) { const float rs = 1.0f / sqrtf(s[q] * (1.f / D) + RMS_EPS);
                const f32x4 y = (v[q][j] * rs) * gs + sh;
                ((GAS unsigned long long*)(XN + (size_t)(m0 + q) * D) + F.lane)[64 * j] = (unsigned long long)pk2(y.x, y.y) | ((unsigned long long)pk2(y.z, y.w) << 32); } }
    }
}

__device__ __forceinline__ void fox_prep(Frame& F) {
    const int gw = F.vcu * NWAVES + F.wave, NGW = F.G * NWAVES; const bf16* P = (const bf16*)(F.ws + WS_P); bf16* QN = (bf16*)(F.ws + WS_QN); bf16* KN = (bf16*)(F.ws + WS_KN);
    const float* qg = F.in[I_QG]; const float* kg = F.in[I_KG];
    f32x4 gq0 = *(const f32x4*)(qg + 8 * F.lane), gq1 = *(const f32x4*)(qg + 8 * F.lane + 4), gk0 = *(const f32x4*)(kg + 8 * F.lane), gk1 = *(const f32x4*)(kg + 8 * F.lane + 4);
    const float C2 = 0.125f * LOG2E; float* LF = (float*)(F.ws + WS_CUM); const float fbias = F.in[I_FBIAS][F.lane & 7];
    for (int m = gw; m < M; m += NGW) {
        if (F.lane < 8) { const float z = bf2f(P[(size_t)m * NIN + PC_F + F.lane]) + fbias;
            const float lf = z < -30.f ? z * LOG2E : -__builtin_amdgcn_logf(1.0f + __builtin_amdgcn_exp2f(-LOG2E * z));
            LF[((size_t)(m >> 11) * FOXH + F.lane) * T + (m & (T - 1))] = lf; }
        const v4u qw = *(const GAS v4u*)(P + (size_t)m * NIN + PC_Q + 8 * F.lane), kw = *(const GAS v4u*)(P + (size_t)m * NIN + PC_K + 8 * F.lane);
        float q[8], k[8]; const unsigned qq[4] = {qw.x, qw.y, qw.z, qw.w}, kk[4] = {kw.x, kw.y, kw.z, kw.w};
        float sq = 0.f, sk = 0.f;
#pragma unroll
        for (int i = 0; i < 8; ++i) { q[i] = bf2f((unsigned short)(qq[i >> 1] >> (16 * (i & 1)))); k[i] = bf2f((unsigned short)(kk[i >> 1] >> (16 * (i & 1)))); sq += q[i] * q[i]; sk += k[i] * k[i]; }
        sq = red8(sq); sk = red8(sk);
        const float rq = C2 / sqrtf(sq * (1.f / 64.f) + RMS_EPS), rk = 1.0f / sqrtf(sk * (1.f / 64.f) + RMS_EPS);
        v4u oq, ok;
        oq.x = pk2(q[0] * rq * gq0.x, q[1] * rq * gq0.y); oq.y = pk2(q[2] * rq * gq0.z, q[3] * rq * gq0.w); oq.z = pk2(q[4] * rq * gq1.x, q[5] * rq * gq1.y); oq.w = pk2(q[6] * rq * gq1.z, q[7] * rq * gq1.w);
        ok.x = pk2(k[0] * rk * gk0.x, k[1] * rk * gk0.y); ok.y = pk2(k[2] * rk * gk0.z, k[3] * rk * gk0.w); ok.z = pk2(k[4] * rk * gk1.x, k[5] * rk * gk1.y); ok.w = pk2(k[6] * rk * gk1.z, k[7] * rk * gk1.w);
        *(GAS v4u*)(QN + (size_t)m * 512 + 8 * F.lane) = oq; *(GAS v4u*)(KN + (size_t)m * 512 + 8 * F.lane) = ok;
    }
}

namespace rwprep {
constexpr int ACT_ST = 592;
constexpr int LDT_ST = 2064, AT_ST = 1040;
constexpr int O_ACT = 0, O_LDT = 32 * ACT_ST, O_AT = O_LDT + 32 * LDT_ST, PRE_BYTES = O_AT + 32 * AT_ST;
static_assert(PRE_BYTES <= RING_BYTES, "pre-pass LDS");
__device__ __forceinline__ void up8(float (&o)[8], v4u w) { o[0] = bf2f((unsigned short)w.x); o[1] = bf2f((unsigned short)(w.x >> 16)); o[2] = bf2f((unsigned short)w.y); o[3] = bf2f((unsigned short)(w.y >> 16));
    o[4] = bf2f((unsigned short)w.z); o[5] = bf2f((unsigned short)(w.z >> 16)); o[6] = bf2f((unsigned short)w.w); o[7] = bf2f((unsigned short)(w.w >> 16)); }
__device__ __forceinline__ v4u pk8(const float (&x)[8]) { return (v4u){cvtpk(x[0], x[1]), cvtpk(x[2], x[3]), cvtpk(x[4], x[5]), cvtpk(x[6], x[7])}; }
__device__ __forceinline__ void run(Frame& F) {
    LAS unsigned char* L = F.lds + RING_OFF;
    const bf16* P = (const bf16*)(F.ws + WS_P); const float* mu = F.in[I_MU];
    unsigned char* IA = (unsigned char*)F.out; unsigned char* IB = IA + 32 * MiB; unsigned char* IK = IB + 32 * MiB; unsigned char* IR = IK + 32 * MiB;
    unsigned char* IV = F.ws + WS_XN; unsigned char* IG = IV + 32 * MiB; float* LCo = (float*)(F.ws + WS_SCR); float* BONo = LCo + 8192 * 64;
    const bf16* W2T = (const bf16*)(F.ws + WS_W2T); const bf16* A2T = (const bf16*)(F.ws + WS_A2T); const bf16* G2T = (const bf16*)(F.ws + WS_G2T);
    const int lane = F.lane, w = F.wave, hi = lane >> 5, r32 = lane & 31;
    const int rem = F.tid & 63, hd = rem >> 3, l8 = rem & 7, ch = hd * 64 + 8 * l8;
    float mur[8], muk[8], muv[8], ckk[8], cka[8], crk[8];
#pragma unroll
    for (int q = 0; q < 2; ++q) { const f32x4 a_ = *(const f32x4*)(mu + ch + 4 * q), b_ = *(const f32x4*)(mu + 512 + ch + 4 * q), c_ = *(const f32x4*)(mu + 1024 + ch + 4 * q);
        const f32x4 d_ = *(const f32x4*)(F.in[I_KK] + ch + 4 * q), e_ = *(const f32x4*)(F.in[I_KA] + ch + 4 * q), f_ = *(const f32x4*)(F.in[I_RK] + ch + 4 * q);
#pragma unroll
        for (int i = 0; i < 4; ++i) { mur[4 * q + i] = a_[i]; muk[4 * q + i] = b_[i]; muv[4 * q + i] = c_[i]; ckk[4 * q + i] = d_[i]; cka[4 * q + i] = e_[i]; crk[4 * q + i] = f_[i]; } }
    for (int tile = F.vcu; tile < M / 32; tile += F.G) {
        const size_t row0 = (size_t)tile * 32; const int bb = tile >> 6, cc_ = tile & 63;
        for (int g = F.tid; g < 32 * 36; g += NWAVES * 64) { const int t = g / 36, cg = g - 36 * t; const size_t row = row0 + t; const bool hp = (row & (T - 1)) != 0;
            const bf16* cp = P + row * NIN + PC_WDN + 8 * cg; const v4u c = *(const GAS v4u*)cp; v4u p = *(const GAS v4u*)(cp - (hp ? NIN : 0)); if (!hp) p = (v4u){0u, 0u, 0u, 0u};
            const f32x4 m0 = *(const f32x4*)(mu + 1536 + 8 * cg), m1 = *(const f32x4*)(mu + 1536 + 8 * cg + 4); const float mm[8] = {m0.x, m0.y, m0.z, m0.w, m1.x, m1.y, m1.z, m1.w};
            float xc[8], xp[8], x[8]; up8(xc, c); up8(xp, p);
#pragma unroll
            for (int i = 0; i < 8; ++i) x[i] = xc[i] + (xp[i] - xc[i]) * mm[i];
            if (cg < 8) {
#pragma unroll
                for (int i = 0; i < 8; ++i) x[i] = tanhf_(x[i]);
            } else if (cg >= 16) {
#pragma unroll
                for (int i = 0; i < 8; ++i) x[i] = sigmoidf_(x[i]);
            }
            *(LAS v4u*)(L + O_ACT + t * ACT_ST + 16 * cg) = pk8(x); }
        __syncthreads();
        {
            f32x16 aw[2] = {{}, {}}, aa[2] = {{}, {}}, ag[2] = {{}, {}};
            const LAS unsigned char* ap = L + O_ACT + r32 * ACT_ST + 16 * hi;
#pragma unroll
            for (int ks = 0; ks < 4; ++ks) { const bf16x8 fw = *(const LAS bf16x8*)(ap + 32 * ks), fa = *(const LAS bf16x8*)(ap + 128 + 32 * ks);
#pragma unroll
                for (int cb = 0; cb < 2; ++cb) { const size_t c = 64 * w + 32 * cb + r32;
                    aw[cb] = __builtin_amdgcn_mfma_f32_32x32x16_bf16(*(const GAS bf16x8*)(W2T + c * 64 + 16 * ks + 8 * hi), fw, aw[cb], 0, 0, 0);
                    aa[cb] = __builtin_amdgcn_mfma_f32_32x32x16_bf16(*(const GAS bf16x8*)(A2T + c * 64 + 16 * ks + 8 * hi), fa, aa[cb], 0, 0, 0); } }
#pragma unroll
            for (int ks = 0; ks < 10; ++ks) { const bf16x8 fg = *(const LAS bf16x8*)(ap + 256 + 32 * ks);
#pragma unroll
                for (int cb = 0; cb < 2; ++cb) { const size_t c = 64 * w + 32 * cb + r32;
                    ag[cb] = __builtin_amdgcn_mfma_f32_32x32x16_bf16(*(const GAS bf16x8*)(G2T + c * 160 + 16 * ks + 8 * hi), fg, ag[cb], 0, 0, 0); } }
            unsigned char* gimg = IG + ((size_t)(bb * 8 + w) * 64 + cc_) * 4096 + r32 * 128;
#pragma unroll
            for (int cb = 0; cb < 2; ++cb)
#pragma unroll
                for (int g = 0; g < 4; ++g) { const int cl = 32 * cb + 8 * g + 4 * hi, c = 64 * w + cl;
                    const f32x4 w0 = *(const f32x4*)(F.in[I_W0] + c), a0 = *(const f32x4*)(F.in[I_A0] + c);
                    f32x4 ld; float ai[4];
#pragma unroll
                    for (int i = 0; i < 4; ++i) { ld[i] = -(0.6065306597126334f * LOG2E) * sigmoidf_(w0[i] + aw[cb][4 * g + i]); ai[i] = sigmoidf_(a0[i] + aa[cb][4 * g + i]); }
                    *(LAS f32x4*)(L + O_LDT + r32 * LDT_ST + c * 4) = ld;
                    *(LAS v2u*)(L + O_AT + r32 * AT_ST + c * 2) = (v2u){cvtpk(ai[0], ai[1]), cvtpk(ai[2], ai[3])};
                    *(GAS v2u*)(gimg + cl * 2) = (v2u){cvtpk(ag[cb][4 * g], ag[cb][4 * g + 1]), cvtpk(ag[cb][4 * g + 2], ag[cb][4 * g + 3])}; }
        }
        __syncthreads();
        { LAS float* col = (LAS float*)(L + O_LDT) + F.tid; float x[32];
#pragma unroll
          for (int t = 0; t < 32; ++t) x[t] = col[t * (LDT_ST / 4)];
#pragma unroll
          for (int t = 1; t < 32; ++t) x[t] += x[t - 1];
#pragma unroll
          for (int t = 1; t < 32; ++t) col[t * (LDT_ST / 4)] = x[t]; }
        __syncthreads();
        const size_t blob = (size_t)(bb * 8 + hd) * 64 + cc_;
#pragma unroll 1
        for (int p = 0; p < 4; ++p) { const int t = (F.tid >> 6) + 8 * p; const size_t row = row0 + t; const bool hp = (row & (T - 1)) != 0;
            const bf16* pr = P + row * NIN + ch; const bf16* pp = pr - (hp ? NIN : 0);
            float rc[8], rp[8], kc[8], kp[8], vc[8], vp[8], ai[8];
            up8(rc, *(const GAS v4u*)(pr + PC_R)); up8(kc, *(const GAS v4u*)(pr + PC_RK)); up8(vc, *(const GAS v4u*)(pr + PC_RV));
            { v4u a_ = *(const GAS v4u*)(pp + PC_R), b_ = *(const GAS v4u*)(pp + PC_RK), c_ = *(const GAS v4u*)(pp + PC_RV); if (!hp) { a_ = (v4u){0u, 0u, 0u, 0u}; b_ = a_; c_ = a_; } up8(rp, a_); up8(kp, b_); up8(vp, c_); }
            up8(ai, *(const LAS v4u*)(L + O_AT + t * AT_ST + ch * 2));
            const LAS float* lrow = (const LAS float*)(L + O_LDT + t * LDT_ST) + ch;
            const f32x4 l0 = *(const LAS f32x4*)lrow, l1 = *(const LAS f32x4*)(lrow + 4);
            f32x4 q0 = (f32x4){0.f, 0.f, 0.f, 0.f}, q1 = q0; if (t > 0) { q0 = *(const LAS f32x4*)(lrow - LDT_ST / 4); q1 = *(const LAS f32x4*)(lrow - LDT_ST / 4 + 4); }
            const float lam[8] = {l0.x, l0.y, l0.z, l0.w, l1.x, l1.y, l1.z, l1.w}, lamp[8] = {q0.x, q0.y, q0.z, q0.w, q1.x, q1.y, q1.z, q1.w};
            float r[8], k[8], v[8], kkv[8]; float ss = 0.f;
#pragma unroll
            for (int i = 0; i < 8; ++i) { r[i] = rc[i] + (rp[i] - rc[i]) * mur[i]; k[i] = kc[i] + (kp[i] - kc[i]) * muk[i]; v[i] = vc[i] + (vp[i] - vc[i]) * muv[i]; kkv[i] = k[i] * ckk[i]; ss += kkv[i] * kkv[i]; }
            ss = red8(ss); const float inv = __builtin_amdgcn_rsqf(fmaxf(ss, L2_EPS * L2_EPS));
            float al[8], be[8], ka[8], rh[8]; float bon = 0.f;
#pragma unroll
            for (int i = 0; i < 8; ++i) { const float kn = kkv[i] * inv, k2 = k[i] * (1.0f + (ai[i] - 1.0f) * cka[i]); bon += r[i] * k2 * crk[i];
                const float g_ = __builtin_amdgcn_exp2f(lam[i]), gi = __builtin_amdgcn_exp2f(-lam[i]), gm1 = __builtin_amdgcn_exp2f(lamp[i]);
                al[i] = -kn * gm1; be[i] = kn * ai[i] * gi; ka[i] = k2 * gi; rh[i] = r[i] * g_; }
            bon = red8(bon);
            const size_t o = blob * 4096 + t * 128 + l8 * 16;
            *(GAS v4u*)(IA + o) = pk8(al); *(GAS v4u*)(IB + o) = pk8(be); *(GAS v4u*)(IK + o) = pk8(ka); *(GAS v4u*)(IR + o) = pk8(rh); *(GAS v4u*)(IV + o) = pk8(v);
            if (l8 == 0) BONo[blob * 32 + t] = bon;
            if (t == 31) { *(GAS f32x4*)(LCo + blob * 64 + 8 * l8) = l0; *(GAS f32x4*)(LCo + blob * 64 + 8 * l8 + 4) = l1; }
        }
    }
}
}

namespace rwkv {
constexpr int TC = 32, NCH = T / TC;
constexpr int SCM = 72;
constexpr int I_A = 0, I_B = 4096, I_K = 8192, I_R = 12288, I_V = 16384, I_BP = 20480, I_KP = 24576, IMG_BYTES = 28672;
constexpr int O_TM = 0;
constexpr int O_S0 = O_TM + 3 * 32 * SCM;
constexpr int O_YS = O_S0 + 2 * 64 * 136;
constexpr int O_NAB = O_YS + 2 * 4096;
constexpr int O_LC = O_NAB + 2 * 32 * 144;
constexpr int O_INV = O_LC + 1024;
constexpr int O_IMG = O_INV + 512;
constexpr int L_BYTES = O_IMG + 4 * IMG_BYTES;
static_assert(L_BYTES <= RING_BYTES, "scan LDS");
__device__ __forceinline__ int crow(int r, int hi) { return (r & 3) + 8 * (r >> 2) + 4 * hi; }
__device__ __forceinline__ int swz(int row, int chunk) { return row * 128 + ((chunk ^ ((row >> 1) & 7)) << 4); }
__device__ __forceinline__ bf16x8 ld_tok(const LAS unsigned char* base, int row, int ks, int h) { return *(const LAS bf16x8*)(base + swz(row, 2 * ks + h)); }
__device__ __forceinline__ bf16x8 ld_perm(const LAS unsigned char* base, int stride, int row, int s, int h) {
    const v2u lo = *(const LAS v2u*)(base + row * stride + (16 * s + 4 * h) * 2), hi2 = *(const LAS v2u*)(base + row * stride + (16 * s + 8 + 4 * h) * 2);
    return __builtin_bit_cast(bf16x8, (v4u){lo.x, lo.y, hi2.x, hi2.y});
}
typedef short v4i16_t __attribute__((ext_vector_type(4)));
__device__ __forceinline__ v2u tr4(const LAS unsigned char* img, int blk, int tok0, int lane) {
    const LAS unsigned char* p = img + swz(tok0 + ((lane & 15) >> 2), 4 * blk + 2 * ((lane >> 4) & 1) + ((lane & 3) >> 1)) + 8 * (lane & 1);
    return __builtin_bit_cast(v2u, __builtin_amdgcn_ds_read_tr16_b64_v4i16((LAS v4i16_t*)p));
}
__device__ __forceinline__ bf16x8 ld_tr(const LAS unsigned char* img, int blk, int s, int lane) {
    const int h = lane >> 5; const v2u lo = tr4(img, blk, 16 * s + 4 * h, lane), hi2 = tr4(img, blk, 16 * s + 8 + 4 * h, lane);
    return __builtin_bit_cast(bf16x8, (v4u){lo.x, lo.y, hi2.x, hi2.y});
}
__device__ __forceinline__ bf16x8 acc_frag(const f32x16& x, int s) {
    return __builtin_bit_cast(bf16x8, (v4u){cvtpk(x[8 * s], x[8 * s + 1]), cvtpk(x[8 * s + 2], x[8 * s + 3]), cvtpk(x[8 * s + 4], x[8 * s + 5]), cvtpk(x[8 * s + 6], x[8 * s + 7])});
}
#define RW_MFMA(a, b, c) __builtin_amdgcn_mfma_f32_32x32x16_bf16(a, b, c, 0, 0, 0)
__device__ __forceinline__ f32x16 gram(const LAS unsigned char* X, const LAS unsigned char* Y, int r32, int h) {
    f32x16 acc = {};
#pragma unroll
    for (int ks = 0; ks < 4; ++ks) acc = RW_MFMA(ld_tok(X, r32, ks, h), ld_tok(Y, r32, ks, h), acc);
    return acc;
}
__device__ __forceinline__ void unpack4(float (&o)[4], v2u w) { o[0] = bf2f((unsigned short)w.x); o[1] = bf2f((unsigned short)(w.x >> 16)); o[2] = bf2f((unsigned short)w.y); o[3] = bf2f((unsigned short)(w.y >> 16)); }

template <int QHI, int QLO>
__device__ __forceinline__ void invert_quads(float (&tmh)[16], const LAS unsigned char* nabs, LAS unsigned char* tmout, int lane) {
    const int hi = lane >> 5, r32 = lane & 31;
    const LAS unsigned char* nrow0 = nabs; const LAS unsigned char* nrowh = nabs + 16 * hi; LAS unsigned char* tmo = tmout + 2 * r32;
#pragma unroll
    for (int Q = QHI; Q >= QLO; --Q) {
        float part[4] = {0.f, 0.f, 0.f, 0.f}; f32x4 wq[4];
#pragma unroll
        for (int rr_ = 0; rr_ < 4; ++rr_) wq[rr_] = *(const LAS f32x4*)(nrow0 + (4 * Q + rr_) * 144 + 16 * Q);
#pragma unroll
        for (int pp = ((Q + 1) >> 1); pp < 4; pp += 2) {
            f32x4 nq[4][2];
#pragma unroll
            for (int rr_ = 0; rr_ < 4; ++rr_)
#pragma unroll
                for (int d = 0; d < 2; ++d) if (pp + d < 4) nq[rr_][d] = *(const LAS f32x4*)(nrowh + (4 * Q + rr_) * 144 + 32 * (pp + d));
            __builtin_amdgcn_sched_barrier(0);
#pragma unroll
            for (int d = 0; d < 2; ++d) if (pp + d < 4)
#pragma unroll
                for (int rr_ = 0; rr_ < 4; ++rr_) { const f32x4 n4 = nq[rr_][d]; const int p = pp + d;
                    part[rr_] = fmaf(n4.x, tmh[4 * p], part[rr_]); part[rr_] = fmaf(n4.y, tmh[4 * p + 1], part[rr_]); part[rr_] = fmaf(n4.z, tmh[4 * p + 2], part[rr_]); part[rr_] = fmaf(n4.w, tmh[4 * p + 3], part[rr_]); }
            __builtin_amdgcn_sched_barrier(0);
        }
        float tot[4];
#pragma unroll
        for (int rr_ = 0; rr_ < 4; ++rr_) { const auto sw = __builtin_amdgcn_permlane32_swap(__float_as_uint(part[rr_]), __float_as_uint(part[rr_]), false, false);
            tot[rr_] = __uint_as_float(sw[0]) + __uint_as_float(sw[1]) + ((r32 == 4 * Q + rr_) ? 1.f : 0.f); }
        tot[2] = fmaf(wq[2].w, tot[3], tot[2]);
        tot[1] = fmaf(wq[1].z, tot[2], fmaf(wq[1].w, tot[3], tot[1]));
        tot[0] = fmaf(wq[0].y, tot[1], fmaf(wq[0].z, tot[2], fmaf(wq[0].w, tot[3], tot[0])));
        const bool own = (hi == (Q & 1));
#pragma unroll
        for (int rr_ = 0; rr_ < 4; ++rr_) { const int idx = 4 * (Q >> 1) + rr_; tmh[idx] = own ? tot[rr_] : tmh[idx];
            *(LAS unsigned short*)(tmo + (4 * Q + rr_) * SCM) = (unsigned short)(cvtpk(tot[rr_], tot[rr_]) & 0xffffu); }
        asm volatile("" ::: "memory");
    }
}
__device__ __forceinline__ void invert_first(float (&tmh)[16], const LAS unsigned char* img, LAS unsigned char* nabs, LAS unsigned char* tmout, int lane) {
    const int hi = lane >> 5, r32 = lane & 31;
    { f32x16 nab = gram(img + I_B, img + I_A, r32, hi);
#pragma unroll
      for (int q = 0; q < 16; ++q) *(LAS float*)(nabs + crow(q, hi) * 144 + 4 * r32) = (crow(q, hi) < r32) ? nab[q] : 0.f; }
    asm volatile("s_waitcnt lgkmcnt(0)" ::: "memory");
#pragma unroll
    for (int i = 0; i < 16; ++i) tmh[i] = 0.f;
    invert_quads<7, 4>(tmh, nabs, tmout, lane);
}
__device__ __forceinline__ void invert_second(float (&tmh)[16], const LAS unsigned char* nabs, LAS unsigned char* tmout, int lane) { invert_quads<3, 0>(tmh, nabs, tmout, lane); }

__device__ __forceinline__ void unit(Frame& F, int b, int h, int probe) {
    LAS unsigned char* L = F.lds + RING_OFF;
    bf16* MIX = (bf16*)(F.ws + WS_MIX);
    const unsigned char* IA = (const unsigned char*)F.out; const unsigned char* IV = F.ws + WS_XN; const unsigned char* IG = IV + 32 * MiB;
    const float* LCi = (const float*)(F.ws + WS_SCR); const float* BONi = LCi + 8192 * 64;
    const int lane = F.lane, w = F.wave, hi = lane >> 5, r32 = lane & 31;
    const size_t rowbase = (size_t)b * T; const size_t blob0 = (size_t)(b * 8 + h) * 64;
    int te = F.tid >> 4, cq = F.tid & 15, c0 = h * 64 + 4 * cq;
    if (F.tid < 128) ((LAS float*)(L + O_INV))[F.tid] = (F.tid < 64 ? F.in[I_LNG] : F.in[I_LNB])[h * 64 + (F.tid & 63)];
    for (int i = F.tid; i < 2 * 64 * 136 / 4; i += NWAVES * 64) ((LAS unsigned*)(L + O_S0))[i] = 0u;
    const unsigned lds0 = (unsigned)(uintptr_t)(F.lds + RING_OFF);
#define RW_DMA(c_, set_) do { _Pragma("unroll") for (int j_ = w; j_ < 20; j_ += 8) { const int im_ = j_ >> 2, row_ = 8 * (j_ & 3) + (lane >> 3); \
        const unsigned char* src_ = (im_ < 4 ? IA + (size_t)im_ * (32 * MiB) : IV) + (blob0 + (c_)) * 4096 + row_ * 128 + (((lane & 7) ^ ((row_ >> 1) & 7)) << 4); \
        attn_body::glds16(src_, (unsigned)__builtin_amdgcn_readfirstlane(lds0 + O_IMG + (set_) * IMG_BYTES + im_ * 4096 + (j_ & 3) * 1024)); } } while (0)
#define RW_GEN(set_, lc4_) do { LAS unsigned char* is_ = L + O_IMG + (set_) * IMG_BYTES + swz(te, cq >> 1) + 8 * (cq & 1); float b4_[4], k4_[4]; unpack4(b4_, *(const LAS v2u*)(is_ + I_B)); unpack4(k4_, *(const LAS v2u*)(is_ + I_K)); \
        const float g0_ = __builtin_amdgcn_exp2f((lc4_).x), g1_ = __builtin_amdgcn_exp2f((lc4_).y), g2_ = __builtin_amdgcn_exp2f((lc4_).z), g3_ = __builtin_amdgcn_exp2f((lc4_).w); \
        *(LAS v2u*)(is_ + I_BP) = (v2u){cvtpk(b4_[0] * g0_, b4_[1] * g1_), cvtpk(b4_[2] * g2_, b4_[3] * g3_)}; *(LAS v2u*)(is_ + I_KP) = (v2u){cvtpk(k4_[0] * g0_, k4_[1] * g1_), cvtpk(k4_[2] * g2_, k4_[3] * g3_)}; \
        if (te == 0) *(LAS f32x4*)((LAS float*)(L + O_LC) + (set_) * 64 + 4 * cq) = (lc4_); } while (0)
    float tmh[16];
    RW_DMA(0, 0); RW_DMA(1, 1); RW_DMA(2, 2);
    f32x4 lcn = *(const GAS f32x4*)(LCi + blob0 * 64 + 4 * cq);
    asm volatile("s_waitcnt vmcnt(0)" ::: "memory");
    __syncthreads();
    RW_GEN(0, lcn);
    lcn = *(const GAS f32x4*)(LCi + (blob0 + 1) * 64 + 4 * cq);
    if (w == 0) { invert_first(tmh, L + O_IMG, L + O_NAB, L + O_TM, lane); invert_second(tmh, L + O_NAB, L + O_TM, lane); }
    else if (w == 3) invert_first(tmh, L + O_IMG + IMG_BYTES, L + O_NAB + 32 * 144, L + O_TM + 32 * SCM, lane);
    __syncthreads();
    v2u gst = (v2u){0u, 0u}, vst = (v2u){0u, 0u}; float bst = 0.f;
    int i3 = 0;
    for (int c = 0; c <= NCH; ++c) {
        const int pb = c & 1, nb = pb ^ 1; const int i3n = (i3 == 2) ? 0 : i3 + 1, i3nn = (i3n == 2) ? 0 : i3n + 1;
        asm volatile("" : "+v"(te), "+v"(cq));  c0 = h * 64 + 4 * cq;
        if (c > 0 && !(probe & 16)) {
            f32x4 y; { float y_[4]; unpack4(y_, *(const LAS v2u*)(L + O_YS + nb * 4096 + te * 128 + 8 * cq)); y = (f32x4){y_[0], y_[1], y_[2], y_[3]}; }
            const float mean = red16((y.x + y.y) + (y.z + y.w)) * (1.f / 64.f);
            const f32x4 dy = y - mean;
            const float var = red16((dy.x * dy.x + dy.y * dy.y) + (dy.z * dy.z + dy.w * dy.w)) * (1.f / 64.f);
            const float rstd = __builtin_amdgcn_rsqf(var + GN_EPS);
            float vv_[4], gg_[4]; unpack4(vv_, vst); unpack4(gg_, gst);
            const f32x4 lg4 = *(const LAS f32x4*)(L + O_INV + 16 * cq), lb4 = *(const LAS f32x4*)(L + O_INV + 256 + 16 * cq);
            const f32x4 o = ((dy * rstd) * lg4 + lb4 + (f32x4){vv_[0], vv_[1], vv_[2], vv_[3]} * bst) * (f32x4){gg_[0], gg_[1], gg_[2], gg_[3]};
            if (!(probe & 12)) *(GAS v2u*)(MIX + (rowbase + (c - 1) * TC + te) * 1024 + 512 + c0) = (v2u){cvtpk(o.x, o.y), cvtpk(o.z, o.w)};
        }
        if (c == NCH) break;
        if (c + 1 < NCH && !(probe & 16)) RW_GEN((c + 1) & 3, lcn);
        if (c + 3 < NCH && !(probe & 32)) RW_DMA(c + 3, (c + 3) & 3);
        { const size_t bl = blob0 + c;
          gst = *(const GAS v2u*)(IG + bl * 4096 + te * 128 + 8 * cq); vst = *(const GAS v2u*)(IV + bl * 4096 + te * 128 + 8 * cq); bst = BONi[bl * 32 + te];
          lcn = *(const GAS f32x4*)(LCi + (blob0 + (c + 2 < NCH ? c + 2 : c)) * 64 + 4 * cq); }
        const LAS unsigned char* img = L + O_IMG + (c & 3) * IMG_BYTES; const LAS unsigned char* tmc = L + O_TM + i3 * 32 * SCM;
        if ((w == 0 || w == 3) && (probe & 4)) {} else if (w == 0 || w == 3) {
            LAS unsigned char* nabw = L + O_NAB + (w == 3 ? 32 * 144 : 0);
            if ((w == 3) == ((c & 1) != 0)) { if (c + 2 < NCH) { asm volatile("s_waitcnt lgkmcnt(0)" ::: "memory"); invert_first(tmh, L + O_IMG + ((c + 2) & 3) * IMG_BYTES, nabw, L + O_TM + i3nn * 32 * SCM, lane); } }
            else { if (c + 1 < NCH) invert_second(tmh, nabw, L + O_TM + i3n * 32 * SCM, lane); }
        } else if ((w == 1 || w == 2) && !(probe & 8)) {
            const int vb = w - 1;
            f32x16 X = {};
            { f32x16 t1 = gram(img + I_B, img + I_R, r32, hi);
#pragma unroll
              for (int q = 0; q < 16; ++q) t1[q] = (crow(q, hi) <= r32) ? t1[q] : 0.f;
#pragma unroll
              for (int s_ = 0; s_ < 2; ++s_) X = RW_MFMA(ld_perm(tmc, SCM, r32, s_, hi), acc_frag(t1, s_), X); }
            f32x16 qy = gram(img + I_K, img + I_R, r32, hi);
            { f32x16 t2 = gram(img + I_A, img + I_K, r32, hi);
#pragma unroll
              for (int q = 0; q < 16; ++q) { const int cr_ = crow(q, hi); t2[q] = (r32 < cr_) ? t2[q] : 0.f; qy[q] = (cr_ <= r32) ? qy[q] : 0.f; }
#pragma unroll
              for (int s_ = 0; s_ < 2; ++s_) qy = RW_MFMA(acc_frag(t2, s_), acc_frag(X, s_), qy); }
            f32x16 y = {};
#pragma unroll
            for (int s_ = 0; s_ < 2; ++s_) y = RW_MFMA(ld_tr(img + I_V, vb, s_, lane), acc_frag(qy, s_), y);
#pragma unroll
            for (int kb = 0; kb < 2; ++kb) { f32x16 py;
#pragma unroll
                for (int g = 0; g < 4; ++g) { float c4[4]; unpack4(c4, *(const LAS v2u*)(img + I_R + swz(r32, 4 * kb + g) + 8 * hi)); py[4 * g] = c4[0]; py[4 * g + 1] = c4[1]; py[4 * g + 2] = c4[2]; py[4 * g + 3] = c4[3]; }
#pragma unroll
                for (int s_ = 0; s_ < 2; ++s_) py = RW_MFMA(ld_tr(img + I_A, kb, s_, lane), acc_frag(X, s_), py);
#pragma unroll
                for (int s_ = 0; s_ < 2; ++s_) y = RW_MFMA(ld_perm(L + O_S0 + pb * 64 * 136, 136, 32 * vb + r32, 2 * kb + s_, hi), acc_frag(py, s_), y); }
#pragma unroll
            for (int g = 0; g < 4; ++g) *(LAS v2u*)(L + O_YS + pb * 4096 + r32 * 128 + (32 * vb + 8 * g + 4 * hi) * 2) = (v2u){cvtpk(y[4 * g], y[4 * g + 1]), cvtpk(y[4 * g + 2], y[4 * g + 3])};
        } else if (w >= 4 && !(probe & 8)) {
            const int vb = (w >> 1) & 1, cb = w & 1;
            f32x16 Z = {};
#pragma unroll
            for (int s_ = 0; s_ < 2; ++s_) Z = RW_MFMA(ld_perm(tmc, SCM, r32, s_, hi), ld_tr(img + I_BP, cb, s_, lane), Z);
            f32x16 sres = {};
            { f32x16 hc;
#pragma unroll
              for (int g = 0; g < 4; ++g) { float c4[4]; unpack4(c4, tr4(img + I_KP, cb, 8 * g + 4 * hi, lane)); hc[4 * g] = c4[0]; hc[4 * g + 1] = c4[1]; hc[4 * g + 2] = c4[2]; hc[4 * g + 3] = c4[3]; }
              { f32x16 t2 = gram(img + I_A, img + I_K, r32, hi);
#pragma unroll
                for (int q = 0; q < 16; ++q) t2[q] = (r32 < crow(q, hi)) ? t2[q] : 0.f;
#pragma unroll
                for (int s_ = 0; s_ < 2; ++s_) hc = RW_MFMA(acc_frag(t2, s_), acc_frag(Z, s_), hc); }
#pragma unroll
              for (int s_ = 0; s_ < 2; ++s_) sres = RW_MFMA(ld_tr(img + I_V, vb, s_, lane), acc_frag(hc, s_), sres); }
            const float gC = __builtin_amdgcn_exp2f(((const LAS float*)(L + O_LC))[(c & 3) * 64 + 32 * cb + r32]);
#pragma unroll
            for (int kb = 0; kb < 2; ++kb) { f32x16 gc;
#pragma unroll
                for (int q = 0; q < 16; ++q) gc[q] = (kb == cb && crow(q, hi) == r32) ? gC : 0.f;
#pragma unroll
                for (int s_ = 0; s_ < 2; ++s_) gc = RW_MFMA(ld_tr(img + I_A, kb, s_, lane), acc_frag(Z, s_), gc);
#pragma unroll
                for (int s_ = 0; s_ < 2; ++s_) sres = RW_MFMA(ld_perm(L + O_S0 + pb * 64 * 136, 136, 32 * vb + r32, 2 * kb + s_, hi), acc_frag(gc, s_), sres); }
#pragma unroll
            for (int q = 0; q < 16; q += 2) { const unsigned pkd = cvtpk(sres[q], sres[q + 1]);
                *(LAS unsigned short*)(L + O_S0 + nb * 64 * 136 + (32 * vb + crow(q, hi)) * 136 + (32 * cb + r32) * 2) = (unsigned short)(pkd & 0xffffu);
                *(LAS unsigned short*)(L + O_S0 + nb * 64 * 136 + (32 * vb + crow(q + 1, hi)) * 136 + (32 * cb + r32) * 2) = (unsigned short)(pkd >> 16); }
        }
        i3 = i3n;
        asm volatile("s_waitcnt vmcnt(4)" ::: "memory");
        __syncthreads();
    }
#undef RW_DMA
#undef RW_GEN
#undef RW_MFMA
}
}

__device__ __forceinline__ void late_weights(Frame& F) {
    LAS float* scr = (LAS float*)(F.lds + RING_OFF + F.wave * 16384);
    bf16* WOUT = (bf16*)(F.ws + WS_WOUT); bf16* WGU = (bf16*)(F.ws + WS_WGU); bf16* WDN = (bf16*)(F.ws + WS_WDN);
    constexpr int I_O = (D / 64) * (D / 32), I_G = (D / 64) * (FF / 32), I_D = (FF / 64) * (D / 32), NITEMS = I_O + 2 * I_G + I_D;
    for (;;) {
        unsigned tk = 0; if (F.lane == 0) tk = __hip_atomic_fetch_add((unsigned*)(F.ctl + CW_LATE), 1u, __ATOMIC_RELAXED, __HIP_MEMORY_SCOPE_AGENT);
        int r = (int)__builtin_amdgcn_readfirstlane(tk); if (r >= NITEMS) break;
        if (r < I_O) { p0_transpose_item(F.in[I_WOUT], D, D, WOUT, D, RmId{}, scr, r, F.lane); continue; } r -= I_O;
        if (r < I_G) { p0_transpose_item(F.in[I_WG], D, FF, WGU, D, RmGate{0}, scr, r, F.lane); continue; } r -= I_G;
        if (r < I_G) { p0_transpose_item(F.in[I_WU], D, FF, WGU, D, RmGate{1}, scr, r, F.lane); continue; } r -= I_G;
        p0_transpose_item(F.in[I_WD], FF, D, WDN, FF, RmId{}, scr, r, F.lane);
    }
}
#ifndef PROBE_REP
#define PROBE_REP 0
#endif
#ifndef PROBE_SKIP
#define PROBE_SKIP 0
#endif
struct Args { const float* in[25]; float* out; unsigned char* ws; int ph_lo, ph_hi, li, pad; };
__global__ void __launch_bounds__(NWAVES * 64, 2) skel_fwd(Args args) {
    extern __shared__ __attribute__((aligned(16))) unsigned char lds[];
    Frame F;
    F.lds = (LAS unsigned char*)lds;
    F.MISC = (volatile LAS unsigned*)(F.lds + MISC_OFF);
    F.tid = threadIdx.x; F.lane = F.tid & 63; F.wave = __builtin_amdgcn_readfirstlane(F.tid >> 6);
    F.G = gridDim.x; { const int bx = blockIdx.x; F.vcu = (F.G % 8 == 0) ? (bx % 8) * (F.G / 8) + bx / 8 : bx; }
#define GRID_BAR(seam) do { if (N_LAUNCHES == PER_PHASE) { if (F.tid == 0) __hip_atomic_store(F.ctl + CW_TMO, 0xBADBA0u | (unsigned)(seam), RLX_AGENT); } \
    else { xcd_barrier(bar); } } while (0)
    unsigned char* ws = args.ws; F.ws = ws;
    F.ctl = (gu32*)(ws + WS_CTL);
#pragma unroll
    for (int i = 0; i < 25; ++i) F.in[i] = args.in[i];
    F.out = args.out;
    for (int u = F.tid; u < (LDS_BYTES - LDSCTL_OFF) / 4; u += NWAVES * 64) ((LAS unsigned*)(F.lds + LDSCTL_OFF))[u] = 0u;
    __syncthreads();
    XcdBarrier bar; bar.bar = (unsigned*)(F.ctl + CW_BAR); bar.x = 0; bar.st = nullptr;
    if (N_LAUNCHES != PER_PHASE) bar = xcd_barrier_post((unsigned*)(F.ctl + CW_BAR), F.MISC + 8);

    const int lo = args.ph_lo, hi = args.ph_hi;
#define IN(k) (lo <= (k) && (k) < hi)
#define BOTH(k) (IN(k) && IN((k) + 1))
    const float* modp = (const float*)(ws + WS_MOD);

    if (IN(0)) { p0_prologue(F); if (BOTH(0)) GRID_BAR(0); }
    if (IN(1)) { xn_pass(F, F.in[I_X], F.in[I_N1G], 0, 1024); if (BOTH(1)) GRID_BAR(1); }
    if (IN(2)) {
        pg8::Gemm g{(const bf16*)(ws + WS_XN), (const bf16*)(ws + WS_WIN), M, NIN, D}; pg8::StaticOrder S; S.init(M, NIN, F.G, (int)blockIdx.x);
        pg8::EpiBf16<0> E{(bf16*)(ws + WS_P), NIN, nullptr, 0, 0, 1.f};
        pg8::gemm_phase<pg8::EpiBf16<0>, pg8::StaticOrder, PG8_ALIGN, PG8_SP2>(F.lds + RING_OFF, g, S, E);
        if (BOTH(2)) GRID_BAR(2);
    }
    if (IN(3)) { fox_prep(F); rwprep::run(F); if (BOTH(3)) GRID_BAR(3); }
    if (IN(4)) {
        const int half = F.G >> 1, me = F.vcu >> 1;
        if ((F.vcu & 1) == 0 && F.vcu < 2 * half) { if (!(args.pad & 1))
            for (int bh = me; bh < BATCH * RWKVH; bh += half) rwkv::unit(F, bh >> 3, bh & 7, args.pad);
        } else if (F.vcu < 2 * half && !(args.pad & 2)) {
            static_assert(attn_body::ATTN_LDS_BYTES <= RING_BYTES, "attention LDS");
            const attn_body::AttnTensors AT{(const attn_body::bf16*)(ws + WS_QN), (const attn_body::bf16*)(ws + WS_KN), (const attn_body::bf16*)(ws + WS_P) + PC_V, (attn_body::bf16*)(ws + WS_MIX),
                                            (const float*)(ws + WS_CUM), (const float*)(ws + WS_LQ)};
            const attn_body::StaticOrder S(me, half);
            attn_body::attn_phase<attn_body::StaticOrder>((char*)lds + RING_OFF, AT, S);
        }
        __syncthreads(); late_weights(F);
        if (BOTH(4)) GRID_BAR(4);
    }
    if (IN(5)) {
        pg8::Gemm g{(const bf16*)(ws + WS_MIX), (const bf16*)(ws + WS_WOUT), M, D, D}; pg8::StaticOrder S; S.init(M, D, F.G, (int)blockIdx.x);
        pg8::EpiResGate E{F.in[I_X], F.out, modp + 2048, D, 6144};
        pg8::gemm_phase<pg8::EpiResGate, pg8::StaticOrder, PG8_ALIGN, PG8_SP2>(F.lds + RING_OFF, g, S, E);
        if (BOTH(5)) GRID_BAR(5);
    }
    if (IN(6)) { xn_pass(F, F.out, F.in[I_N2G], 3072, 4096); if (BOTH(6)) GRID_BAR(6); }
    if (IN(7)) {
        pg8::Gemm g{(const bf16*)(ws + WS_XN), (const bf16*)(ws + WS_WGU), M, NGU, D}; pg8::StaticOrder S; S.init(M, NGU, F.G, (int)blockIdx.x);
        pg8::EpiSwiGLU E{(bf16*)(ws + WS_HH), FF};
        pg8::gemm_phase<pg8::EpiSwiGLU, pg8::StaticOrder, PG8_ALIGN, PG8_SP2>(F.lds + RING_OFF, g, S, E);
        if (BOTH(7)) GRID_BAR(7);
    }
    if (IN(8)) {
        pg8::Gemm g{(const bf16*)(ws + WS_HH), (const bf16*)(ws + WS_WDN), M, D, FF}; pg8::StaticOrder S; S.init(M, D, F.G, (int)blockIdx.x);
        pg8::EpiResGate E{F.out, F.out, modp + 5120, D, 6144};
        pg8::gemm_phase<pg8::EpiResGate, pg8::StaticOrder, PG8_ALIGN, PG8_SP2>(F.lds + RING_OFF, g, S, E);
    }
#undef IN
#undef BOTH
}

extern "C" void kernel_launch(void* const* d_in, const int* in_sizes, int n_in, void* d_out, int out_size, void* d_ws, size_t ws_size, hipStream_t stream) {
    static int grid = 0;
    if (grid == 0) {
        if (n_in != 25 || in_sizes[0] != M * D || out_size != M * D || ws_size < WS_END) { fprintf(stderr, "kernel_launch: unexpected shapes (n_in %d, in0 %d, out %d, ws %zu); nothing launched\n", n_in, n_in > 0 ? in_sizes[0] : -1, out_size, ws_size); grid = -1; return; }
        int dev = 0, cus = 0, per_cu = 0;
        if (hipGetDevice(&dev) != hipSuccess || hipDeviceGetAttribute(&cus, hipDeviceAttributeMultiprocessorCount, dev) != hipSuccess) { fprintf(stderr, "kernel_launch: device query failed\n"); grid = -1; return; }
        if (hipFuncSetAttribute((const void*)skel_fwd, hipFuncAttributeMaxDynamicSharedMemorySize, LDS_BYTES) != hipSuccess) { fprintf(stderr, "kernel_launch: hipFuncSetAttribute failed\n"); grid = -1; return; }
        if (hipOccupancyMaxActiveBlocksPerMultiprocessor(&per_cu, (const void*)skel_fwd, NWAVES * 64, LDS_BYTES) != hipSuccess || per_cu < 1)
            fprintf(stderr, "kernel_launch: note: occupancy query reports %d workgroups per CU\n", per_cu);
        (void)hipGetLastError();
        grid = cus;
    }
    if (grid < 0) return;
    if (hipMemsetAsync((char*)d_ws + WS_CTL, 0, CTL_ZERO_BYTES, stream) != hipSuccess) { fprintf(stderr, "kernel_launch: hipMemsetAsync failed\n"); return; }
    Args a{};
    for (int i = 0; i < 25; ++i) a.in[i] = (const float*)d_in[i];
    a.out = (float*)d_out; a.ws = (unsigned char*)d_ws;
    for (int li = 0; li < N_LAUNCHES; ++li) {
        a.ph_lo = (N_LAUNCHES == PER_PHASE) ? li : 0; a.ph_hi = (N_LAUNCHES == PER_PHASE) ? li + 1 : PER_PHASE; a.li = li;
        hipLaunchKernelGGL(skel_fwd, dim3(grid), dim3(NWAVES * 64), LDS_BYTES, stream, a);
        if (N_LAUNCHES == PER_PHASE && ((PROBE_REP >> li) & 1)) { a.pad = PROBE_SKIP; hipLaunchKernelGGL(skel_fwd, dim3(grid), dim3(NWAVES * 64), LDS_BYTES, stream, a); a.pad = 0; }
        const hipError_t le = hipPeekAtLastError();
        if (le != hipSuccess) { fprintf(stderr, "kernel_launch: launch %d failed: %s\n", li, hipGetErrorName(le)); break; }
    }
}
```

```cpp
#define MK_N_LAUNCHES 1
#define PROBE_REP 0
#define PROBE_SKIP 0
#include <hip/hip_runtime.h>
#include <cstdio>
#include <cstdint>
namespace pg8 {
#define PG8_LAS __attribute__((address_space(3)))
typedef unsigned short bf16_t;
typedef short bf16x8 __attribute__((ext_vector_type(8)));
typedef float f32x4 __attribute__((ext_vector_type(4)));
typedef unsigned u32x4 __attribute__((ext_vector_type(4)));
constexpr int BM = 256, BK = 64, HALF = 128, HTB = HALF * BK * 2  , STAGE_BYTES = 8 * HTB, NXCD = 8, WGM = 8;

__host__ __device__ __forceinline__ int lds_byte(int r, int c) { const int st = (r >> 4) * 2 + (c >> 5), rr = r & 15, cc = c & 31, ob = rr * 64 + cc * 2; return st * 1024 + (ob ^ (((ob >> 9) & 1) << 5)); }
__host__ __device__ __forceinline__ void stage_rc(int b, int& R, int& C) { const int st = b / 1024, sb = b % 1024, swz = sb ^ (((sb >> 9) & 1) << 5); R = (st >> 1) * 16 + swz / 64; C = (st & 1) * 32 + (swz % 64) / 2; }
__host__ __device__ __forceinline__ int perm32(int rho) { const int n = rho >> 4, i = rho & 15; return 8 * (i >> 2) + 4 * n + (i & 3); }

struct Unit { int pm, pn; };
struct Gemm { const bf16_t* A; const bf16_t* Bt; int M, N, K; };

struct StaticOrder {
    int nM, nN, nwg, G, c;
    __host__ __device__ void init(int M, int N, int G_, int c_) { nM = M / BM; nN = N / BM; nwg = nM * nN; G = G_; c = c_; }
    __host__ __device__ bool next(int i, Unit& u) const {
        const long L = (long)i * G + c; if (L >= nwg) return false;
        int wgid = (int)L; { const int q = nwg / NXCD, r = nwg % NXCD, xcd = wgid % NXCD, off = wgid / NXCD; wgid = (xcd < r ? xcd * (q + 1) : r * (q + 1) + (xcd - r) * q) + off; }
        const int nig = WGM * nN, gid = wgid / nig, fm = gid * WGM, gsz = (nM - fm) < WGM ? (nM - fm) : WGM;
        u.pm = fm + ((wgid % nig) % gsz); u.pn = (wgid % nig) / gsz; return true;
    }
    __device__ __forceinline__ void a_ready(const Unit&) const {}
    __device__ __forceinline__ void done(const Unit&) const {}
};

__device__ __forceinline__ unsigned cvt_pk_bf16(float lo, float hi) { unsigned r; asm volatile("v_cvt_pk_bf16_f32 %0, %1, %2" : "=v"(r) : "v"(lo), "v"(hi)); return r; }
typedef float f32x2 __attribute__((ext_vector_type(2)));
__device__ __forceinline__ f32x2 gelu_pk(f32x2 v) {
    const f32x2 av = __builtin_elementwise_abs(v), d = av * 0.2316418882f + 1.0f;
    f32x2 t; t.x = __builtin_amdgcn_rcpf(d.x); t.y = __builtin_amdgcn_rcpf(d.y);
    f32x2 q = t * 0.5307027145f + (-0.7265760135f); q = q * t + 0.7107068705f; q = q * t + (-0.142248368f); q = q * t + 0.127414796f; q = q * t;
    const f32x2 s = (v * v) * (-0.72134752044f);
    f32x2 e; e.x = __builtin_amdgcn_exp2f(s.x); e.y = __builtin_amdgcn_exp2f(s.y);
    const f32x2 m = v * (q * e), r = v - m;
    f32x2 o; o.x = v.x < 0.f ? m.x : r.x; o.y = v.y < 0.f ? m.y : r.y; return o;
}

template <int ACT  > struct EpiBf16 {
    static constexpr bool PERM = true, AFTER_DRAIN = false; static_assert(ACT == 0 || ACT == 1, "EpiBf16: ACT is 0 (none) or 1 (gelu_pk)");
    bf16_t* O; int ldc; const float* bias; int split_cols; size_t split_stride; float scale0;
    __device__ __forceinline__ void operator()(const f32x4 (&acc)[2][2][4][2], const Unit& u, int wr, int wc, int fr, int fq) const {
        const int row0 = u.pm * BM + wr * 64 + fr; int colt = u.pn * BM; bf16_t* base = O;
        float sc = 1.f; if (split_cols) { const int t = colt / split_cols; base += (size_t)t * split_stride; colt -= t * split_cols; if (t == 0) sc = scale0; }
        const int col0 = colt + wc * 32 + 8 * fq, bcol0 = u.pn * BM + wc * 32 + 8 * fq;
        f32x4 bv[2][2];
#pragma unroll
        for (int bj = 0; bj < 2; ++bj)
#pragma unroll
            for (int n = 0; n < 2; ++n) bv[bj][n] = bias ? *(const f32x4*)(bias + bcol0 + bj * HALF + 4 * n) : (f32x4){0.f, 0.f, 0.f, 0.f};
#pragma unroll
        for (int ai = 0; ai < 2; ++ai)
#pragma unroll
            for (int m = 0; m < 4; ++m) { bf16_t* rowp = base + (size_t)(row0 + ai * HALF + m * 16) * ldc + col0;
#pragma unroll
                for (int bj = 0; bj < 2; ++bj) { f32x4 v0 = acc[ai][bj][m][0] + bv[bj][0], v1 = acc[ai][bj][m][1] + bv[bj][1];
                    if (ACT == 1) { f32x2 a = gelu_pk((f32x2){v0[0], v0[1]}), b = gelu_pk((f32x2){v0[2], v0[3]}), c = gelu_pk((f32x2){v1[0], v1[1]}), d = gelu_pk((f32x2){v1[2], v1[3]});
                        v0 = (f32x4){a.x, a.y, b.x, b.y}; v1 = (f32x4){c.x, c.y, d.x, d.y}; }
                    v0 = v0 * sc; v1 = v1 * sc; u32x4 w; w.x = cvt_pk_bf16(v0[0], v0[1]); w.y = cvt_pk_bf16(v0[2], v0[3]); w.z = cvt_pk_bf16(v1[0], v1[1]); w.w = cvt_pk_bf16(v1[2], v1[3]);
                    *(u32x4*)(rowp + bj * HALF) = w; } }
    }
};
struct EpiResGate {
    static constexpr bool PERM = false, AFTER_DRAIN = false;
    const float* base; float* out; const float* gate; int ldc; int gate_ld;
    __device__ __forceinline__ void operator()(const f32x4 (&acc)[2][2][4][2], const Unit& u, int wr, int wc, int fr, int fq) const {
        const int b = (u.pm * BM) >> 11; const float* g = gate + (size_t)b * gate_ld;
        const int col0 = u.pn * BM + wc * 32 + 4 * fq;
        f32x4 gv[2][2];
#pragma unroll
        for (int bj = 0; bj < 2; ++bj)
#pragma unroll
            for (int n = 0; n < 2; ++n) gv[bj][n] = *(const f32x4*)(g + col0 + bj * HALF + n * 16);
#pragma unroll
        for (int ai = 0; ai < 2; ++ai)
#pragma unroll
            for (int m = 0; m < 4; ++m) { const size_t off = (size_t)(u.pm * BM + ai * HALF + wr * 64 + m * 16 + fr) * ldc + col0;
                f32x4 bs[2][2];
#pragma unroll
                for (int bj = 0; bj < 2; ++bj)
#pragma unroll
                    for (int n = 0; n < 2; ++n) bs[bj][n] = *(const f32x4*)(base + off + bj * HALF + n * 16);
#pragma unroll
                for (int bj = 0; bj < 2; ++bj)
#pragma unroll
                    for (int n = 0; n < 2; ++n) *(f32x4*)(out + off + bj * HALF + n * 16) = bs[bj][n] + gv[bj][n] * acc[ai][bj][m][n];
                asm volatile("" ::: "memory"); }
    }
};
struct EpiSwiGLU {
    static constexpr bool PERM = true, AFTER_DRAIN = false;
    bf16_t* O; int ldc;
    __device__ __forceinline__ void operator()(const f32x4 (&acc)[2][2][4][2], const Unit& u, int wr, int wc, int fr, int fq) const {
        const int row0 = u.pm * BM + wr * 64 + fr, col0 = u.pn * HALF + wc * 32 + 8 * fq;
#pragma unroll
        for (int ai = 0; ai < 2; ++ai)
#pragma unroll
            for (int m = 0; m < 4; ++m) { bf16_t* rowp = O + (size_t)(row0 + ai * HALF + m * 16) * ldc + col0;
                float hv[8];
#pragma unroll
                for (int n = 0; n < 2; ++n)
#pragma unroll
                    for (int i = 0; i < 4; ++i) { const float g = acc[ai][0][m][n][i], up = acc[ai][1][m][n][i];
                        const float sg = g * __builtin_amdgcn_rcpf(1.0f + __builtin_amdgcn_exp2f(-1.4426950408889634f * g)); hv[4 * n + i] = sg * up; }
                u32x4 w; w.x = cvt_pk_bf16(hv[0], hv[1]); w.y = cvt_pk_bf16(hv[2], hv[3]); w.z = cvt_pk_bf16(hv[4], hv[5]); w.w = cvt_pk_bf16(hv[6], hv[7]);
                *(u32x4*)rowp = w; }
    }
};

template <class Epi, class Sched, bool ALIGN_EPI = false, bool SP2 = false>
__device__ __forceinline__ void gemm_phase(PG8_LAS unsigned char* lds, const Gemm g, const Sched& S, const Epi& E) {
    const int tid = threadIdx.x, wid = __builtin_amdgcn_readfirstlane(tid >> 6), lane = tid & 63, wr = wid >> 2, wc = wid & 3, fr = lane & 15, fq = lane >> 4;
    const int K = g.K, nt = K / BK;
    unsigned voffA[2], voffB[2];
#pragma unroll
    for (int i = 0; i < 2; ++i) { int R, C; stage_rc(tid * 16 + i * 8192, R, C); const int Rb = Epi::PERM ? ((R & ~31) + perm32(R & 31)) : R;
        voffA[i] = (unsigned)(R * K + C) * 2u; voffB[i] = (unsigned)(Rb * K + C) * 2u; }
    const size_t kstep = (size_t)(BK * 2);
    const size_t hstep = (size_t)HALF * K * 2;
    const size_t tstep = 2 * hstep;
    const unsigned ldsw = (unsigned)wid * 1024u;
    const int aoff = lds_byte(wr * 64 + fr, fq * 8), boff = lds_byte(wc * 32 + fr, fq * 8);
#define PG8_SA(b, h) (((b) * 2 + (h)) * HTB)
#define PG8_SB(b, h) ((4 + (b) * 2 + (h)) * HTB)
#define PG8_STAGE(bufoff, gbase, voff) do { _Pragma("unroll") for (int _i = 0; _i < 2; ++_i) \
        __builtin_amdgcn_global_load_lds((const unsigned*)((const char*)(gbase) + (voff)[_i]), (PG8_LAS unsigned*)(lds + (bufoff) + ldsw + _i * 8192), 16, 0, 0); } while (0)
#define PG8_LDA(dst, b, h) do { _Pragma("unroll") for (int m = 0; m < 4; ++m) _Pragma("unroll") for (int k = 0; k < 2; ++k) dst[m][k] = *(const PG8_LAS bf16x8*)(lds + PG8_SA(b, h) + aoff + m * 2048 + k * 1024); } while (0)
#define PG8_LDB(dst, b, h) do { _Pragma("unroll") for (int n = 0; n < 2; ++n) _Pragma("unroll") for (int k = 0; k < 2; ++k) dst[n][k] = *(const PG8_LAS bf16x8*)(lds + PG8_SB(b, h) + boff + n * 2048 + k * 1024); } while (0)
#define PG8_MMA(ai, bj, At, Bt) do { __builtin_amdgcn_s_setprio(1); _Pragma("unroll") for (int m = 0; m < 4; ++m) _Pragma("unroll") for (int n = 0; n < 2; ++n) _Pragma("unroll") for (int k = 0; k < 2; ++k) \
        acc[ai][bj][m][n] = __builtin_amdgcn_mfma_f32_16x16x32_bf16(Bt[n][k], At[m][k], acc[ai][bj][m][n], 0, 0, 0); __builtin_amdgcn_s_setprio(0); } while (0)
#define PG8_WAIT_V(n) asm volatile("s_waitcnt vmcnt(" #n ")" ::: "memory")
#define PG8_WAIT_L(n) asm volatile("s_waitcnt lgkmcnt(" #n ")" ::: "memory")
#define PG8_BAR __builtin_amdgcn_s_barrier()
#define PG8_SCHED __builtin_amdgcn_sched_barrier(0)
    Unit cur, nxt; int ui = 0;
    if (!S.next(0, cur)) return;
    f32x4 acc[2][2][4][2];
#pragma unroll
    for (int a = 0; a < 2; ++a)
#pragma unroll
        for (int b = 0; b < 2; ++b)
#pragma unroll
            for (int m = 0; m < 4; ++m)
#pragma unroll
                for (int n = 0; n < 2; ++n) acc[a][b][m][n] = (f32x4){0.f, 0.f, 0.f, 0.f};
    bf16x8 At[4][2], B0[2][2], B1[2][2];
    const char* cA = (const char*)g.A + (size_t)cur.pm * tstep; const char* cB = (const char*)g.Bt + (size_t)cur.pn * tstep;
    S.a_ready(cur);
    if constexpr (SP2) {
        PG8_STAGE(PG8_SB(0, 0), cB, voffB); PG8_STAGE(PG8_SB(0, 1), cB + hstep, voffB); PG8_STAGE(PG8_SA(0, 0), cA, voffA); PG8_STAGE(PG8_SA(0, 1), cA + hstep, voffA);
        if (wr == 1) PG8_BAR;
        PG8_WAIT_V(2); PG8_BAR;
        PG8_STAGE(PG8_SB(1, 0), cB + kstep, voffB); PG8_STAGE(PG8_SA(1, 0), cA + kstep, voffA); PG8_STAGE(PG8_SB(1, 1), cB + hstep + kstep, voffB);
        PG8_WAIT_V(6); PG8_BAR;
    } else {
        PG8_STAGE(PG8_SB(0, 0), cB, voffB); PG8_STAGE(PG8_SA(0, 0), cA, voffA); PG8_STAGE(PG8_SB(0, 1), cB + hstep, voffB); PG8_STAGE(PG8_SA(0, 1), cA + hstep, voffA);
        if (wr == 1) PG8_BAR;
        PG8_WAIT_V(4); PG8_BAR;
        PG8_STAGE(PG8_SB(1, 0), cB + kstep, voffB); PG8_STAGE(PG8_SA(1, 0), cA + kstep, voffA); PG8_STAGE(PG8_SB(1, 1), cB + hstep + kstep, voffB);
        PG8_WAIT_V(6); PG8_BAR;
    }
    for (;;) {
        const bool has_next = S.next(ui + 1, nxt);
        const char* nA = has_next ? (const char*)g.A + (size_t)nxt.pm * tstep : cA; const char* nB = has_next ? (const char*)g.Bt + (size_t)nxt.pn * tstep : cB;
        for (int t = 0; t < nt; t += 2) {
            const bool last = (t == nt - 2);
            const char* a1 = cA + (size_t)(t + 1) * kstep;
            const char* a2 = last ? nA : cA + (size_t)(t + 2) * kstep; const char* b2 = last ? nB : cB + (size_t)(t + 2) * kstep;
            const char* a3 = a2 + kstep; const char* b3 = b2 + kstep;
            if (last && has_next) S.a_ready(nxt);
            if constexpr (SP2) {
            PG8_LDB(B0, 0, 0); PG8_LDB(B1, 0, 1); PG8_SCHED; PG8_LDA(At, 0, 0); PG8_STAGE(PG8_SA(1, 1), a1 + hstep, voffA);
            PG8_WAIT_V(8); PG8_WAIT_L(0); PG8_BAR; PG8_MMA(0, 0, At, B0); PG8_MMA(0, 1, At, B1); PG8_BAR; PG8_SCHED;
            PG8_LDA(At, 0, 1); PG8_STAGE(PG8_SB(0, 0), b2, voffB); PG8_STAGE(PG8_SB(0, 1), b2 + hstep, voffB); PG8_STAGE(PG8_SA(0, 0), a2, voffA);
            PG8_WAIT_V(8); PG8_WAIT_L(0); PG8_BAR; PG8_MMA(1, 0, At, B0); PG8_MMA(1, 1, At, B1); PG8_BAR; PG8_SCHED;
            PG8_LDB(B0, 1, 0); PG8_LDB(B1, 1, 1); PG8_SCHED; PG8_LDA(At, 1, 0); PG8_STAGE(PG8_SA(0, 1), a2 + hstep, voffA);
            PG8_WAIT_V(8); PG8_WAIT_L(0); PG8_BAR; PG8_MMA(0, 0, At, B0); PG8_MMA(0, 1, At, B1); PG8_BAR; PG8_SCHED;
            PG8_LDA(At, 1, 1); PG8_STAGE(PG8_SB(1, 0), b3, voffB); PG8_STAGE(PG8_SB(1, 1), b3 + hstep, voffB); PG8_STAGE(PG8_SA(1, 0), a3, voffA);
            PG8_WAIT_V(8); PG8_WAIT_L(0); PG8_BAR; PG8_MMA(1, 0, At, B0); PG8_MMA(1, 1, At, B1); PG8_BAR; PG8_SCHED;
            } else {
            PG8_LDB(B0, 0, 0); PG8_SCHED; PG8_LDA(At, 0, 0); PG8_STAGE(PG8_SA(1, 1), a1 + hstep, voffA);
            PG8_WAIT_L(8); PG8_BAR; PG8_WAIT_L(0); PG8_MMA(0, 0, At, B0); PG8_BAR; PG8_SCHED;
            PG8_LDB(B1, 0, 1); PG8_STAGE(PG8_SB(0, 0), b2, voffB);
            PG8_BAR; PG8_WAIT_L(0); PG8_MMA(0, 1, At, B1); PG8_BAR;
            PG8_LDA(At, 0, 1); PG8_STAGE(PG8_SA(0, 0), a2, voffA);
            PG8_BAR; PG8_WAIT_L(0); PG8_MMA(1, 0, At, B0); PG8_BAR; PG8_SCHED;
            PG8_STAGE(PG8_SB(0, 1), b2 + hstep, voffB);
            PG8_WAIT_V(6); PG8_BAR; PG8_MMA(1, 1, At, B1); PG8_BAR;
            PG8_LDB(B0, 1, 0); PG8_SCHED; PG8_LDA(At, 1, 0); PG8_STAGE(PG8_SA(0, 1), a2 + hstep, voffA);
            PG8_WAIT_L(8); PG8_BAR; PG8_WAIT_L(0); PG8_MMA(0, 0, At, B0); PG8_BAR; PG8_SCHED;
            PG8_LDB(B1, 1, 1); PG8_STAGE(PG8_SB(1, 0), b3, voffB);
            PG8_BAR; PG8_WAIT_L(0); PG8_MMA(0, 1, At, B1); PG8_BAR;
            PG8_LDA(At, 1, 1); PG8_STAGE(PG8_SA(1, 0), a3, voffA);
            PG8_BAR; PG8_WAIT_L(0); PG8_MMA(1, 0, At, B0); PG8_BAR; PG8_SCHED;
            PG8_STAGE(PG8_SB(1, 1), b3 + hstep, voffB);
            PG8_WAIT_V(6); PG8_BAR; PG8_MMA(1, 1, At, B1); PG8_BAR;
            }
        }
        if constexpr (ALIGN_EPI) { if (wr == 0) PG8_BAR; }
        if constexpr (!Epi::AFTER_DRAIN) { E(acc, cur, wr, wc, fr, fq); S.done(cur); }
        if (!has_next) break;
#pragma unroll
        for (int a = 0; a < 2; ++a)
#pragma unroll
            for (int b = 0; b < 2; ++b)
#pragma unroll
                for (int m = 0; m < 4; ++m)
#pragma unroll
                    for (int n = 0; n < 2; ++n) acc[a][b][m][n] = (f32x4){0.f, 0.f, 0.f, 0.f};
        cur = nxt; cA = nA; cB = nB; ++ui;
        if constexpr (ALIGN_EPI) { if (wr == 1) PG8_BAR; }
    }
    PG8_WAIT_V(0);
    if constexpr (!ALIGN_EPI) { if (wr == 0) PG8_BAR; }
    PG8_BAR;
    if constexpr (Epi::AFTER_DRAIN) { E.fused(acc, cur, wr, wc, fr, fq, lds, wid, lane); S.done(cur); }
#undef PG8_SA
#undef PG8_SB
#undef PG8_STAGE
#undef PG8_LDA
#undef PG8_LDB
#undef PG8_MMA
#undef PG8_WAIT_V
#undef PG8_WAIT_L
#undef PG8_BAR
#undef PG8_SCHED
}
}

#ifndef PG8_SP2
#define PG8_SP2 true
#endif
#ifndef PG8_ALIGN
#define PG8_ALIGN true
#endif
#include <hip/hip_bf16.h>
#include <cmath>
namespace attn_body {
using bf16=__hip_bfloat16;
using bf16x8=__attribute__((ext_vector_type(8)))short;
using s16x4=__attribute__((ext_vector_type(4)))short;
using f32x16=__attribute__((ext_vector_type(16)))float;
using u32x4=__attribute__((ext_vector_type(4)))unsigned;
using f32x4_t=__attribute__((ext_vector_type(4)))float;
constexpr int BATCH=16,NHEAD=8,SEQ=2048,D=64;
constexpr int QP=512,KP=512,VP=3584,OP=1024;
constexpr int NW=8,QBLK=32,QB=QBLK*NW,KVBLK=64,NQB=SEQ/QB;
constexpr int ATTN_UNIT_ROWS=QB;
__device__ __forceinline__ int crow(int r,int hi){return (r&3)+8*(r>>2)+4*hi;}
#define SBAR() __builtin_amdgcn_sched_barrier(0)
__device__ __forceinline__ void cmask(f32x16&p0,f32x16&p1,int jb,int qrel,int hi){
  const float NEG=-INFINITY; int kb=64*jb+4*hi;
  #pragma unroll
  for(int r=0;r<16;++r){int kv=kb+(r&3)+8*(r>>2); if(kv>qrel)p0[r]=NEG; if(kv+32>qrel)p1[r]=NEG;}
}

constexpr int NSLOT=3, SLOTB=8192;
constexpr int LDS_K=0, LDS_V=NSLOT*SLOTB, LDS_WS=2*NSLOT*SLOTB, LDS_OST=LDS_WS+NW*64*4, LDS_KB=LDS_OST+NW*4096, LDS_CUM=LDS_KB+SEQ*4, LDS_WSUM=LDS_CUM+SEQ*4, LDS_Q=LDS_WSUM+64, LDS_BYTES=LDS_Q+NW*4096;
constexpr float C2=0.125f*1.4426950408889634f;
__device__ __forceinline__ void glds16(const void*gsrc,unsigned lds_dst){unsigned keep;
  asm volatile("s_mov_b32 %0, m0\n\ts_mov_b32 m0, %2\n\ts_nop 0\n\tglobal_load_lds_dwordx4 %1, off\n\ts_mov_b32 m0, %0":"=&s"(keep):"v"(gsrc),"s"(lds_dst):"memory");}
__device__ __forceinline__ float max3f(float a,float b,float c){float r;asm("v_max3_f32 %0, %1, %2, %3":"=v"(r):"v"(a),"v"(b),"v"(c));return r;}
__device__ __forceinline__ float max2f(float a,float b){float r;asm("v_max_f32_e32 %0, %1, %2":"=v"(r):"v"(a),"v"(b));return r;}
__device__ __forceinline__ float fadd_s(float a,float b){float r;asm("v_add_f32_e32 %0, %1, %2":"=v"(r):"v"(a),"v"(b));return r;}
__device__ __forceinline__ float fsub_s(float a,float b){float r;asm("v_sub_f32_e32 %0, %1, %2":"=v"(r):"v"(a),"v"(b));return r;}
typedef float f32x2_t __attribute__((ext_vector_type(2))); typedef __bf16 bf16x2_t __attribute__((ext_vector_type(2)));
__device__ __forceinline__ unsigned cvtpk_s(float lo,float hi){f32x2_t v={lo,hi};bf16x2_t b=__builtin_convertvector(v,bf16x2_t);return __builtin_bit_cast(unsigned,b);}
#define WAIT_BAR(N) asm volatile("s_waitcnt vmcnt(" #N ") lgkmcnt(0)\n\ts_barrier":::"memory")

__device__ __forceinline__ void qkt(f32x16&p0,f32x16&p1,const char*Kslot,const bf16x8*qr,const f32x16&negm,int r32,int hi,bf16x8 kb0,bf16x8 kb1,bf16x8 qone){
  p0=__builtin_amdgcn_mfma_f32_32x32x16_bf16(kb0,qone,negm,0,0,0);p1=__builtin_amdgcn_mfma_f32_32x32x16_bf16(kb1,qone,negm,0,0,0);
  const char*kb=Kslot+hi*1024+r32*16;
  #pragma unroll
  for(int d0=0;d0<4;++d0){
    const bf16x8 b0=*reinterpret_cast<const bf16x8*>(kb+d0*2048);
    const bf16x8 b1=*reinterpret_cast<const bf16x8*>(kb+d0*2048+512);
    p0=__builtin_amdgcn_mfma_f32_32x32x16_bf16(b0,qr[d0],p0,0,0,0);p1=__builtin_amdgcn_mfma_f32_32x32x16_bf16(b1,qr[d0],p1,0,0,0);}
}
typedef __attribute__((address_space(3))) const char* lds_cptr;
typedef short v4i16_t __attribute__((ext_vector_type(4)));
__device__ __forceinline__ void kload8(bf16x8*kf,lds_cptr kp){
  kf[0]=*(const __attribute__((address_space(3))) bf16x8*)(kp);      kf[1]=*(const __attribute__((address_space(3))) bf16x8*)(kp+512);
  kf[2]=*(const __attribute__((address_space(3))) bf16x8*)(kp+2048); kf[3]=*(const __attribute__((address_space(3))) bf16x8*)(kp+2560);
  kf[4]=*(const __attribute__((address_space(3))) bf16x8*)(kp+4096); kf[5]=*(const __attribute__((address_space(3))) bf16x8*)(kp+4608);
  kf[6]=*(const __attribute__((address_space(3))) bf16x8*)(kp+6144); kf[7]=*(const __attribute__((address_space(3))) bf16x8*)(kp+6656);
}
__device__ __forceinline__ void kload2(bf16x8*kf,lds_cptr kp,int j){ kf[2*j]=*(const __attribute__((address_space(3))) bf16x8*)(kp+j*2048); kf[2*j+1]=*(const __attribute__((address_space(3))) bf16x8*)(kp+j*2048+512); }
__device__ __forceinline__ s16x4 vtr(lds_cptr p){ return __builtin_bit_cast(s16x4,__builtin_amdgcn_ds_read_tr16_b64_v4i16((__attribute__((address_space(3))) v4i16_t*)p)); }
__device__ __forceinline__ float rowmax(const f32x16&p0,const f32x16&p1){
  float a=max3f(p0[0],p0[1],p1[0]),b=max3f(p0[2],p0[3],p1[1]);a=max3f(a,p1[2],p1[3]);
  #pragma unroll
  for(int r=4;r<16;r+=4){a=max3f(a,p0[r],p0[r+1]);b=max3f(b,p0[r+2],p0[r+3]);a=max3f(a,p1[r],p1[r+1]);b=max3f(b,p1[r+2],p1[r+3]);}
  const float m=max2f(a,b);
  auto rr=__builtin_amdgcn_permlane32_swap(__float_as_uint(m),__float_as_uint(m),false,false);
  return max2f(__uint_as_float(rr[0]),__uint_as_float(rr[1]));
}
__device__ __forceinline__ void pv(f32x16*o,int vb,bf16x8 pa0,bf16x8 pa1,bf16x8 pa2,bf16x8 pa3){
  #pragma unroll
  for(int d0=0;d0<2;++d0){s16x4 lo[4],hi[4];
    #pragma unroll
    for(int ks=0;ks<4;++ks){
      asm volatile("ds_read_b64_tr_b16 %0,%1 offset:%c2":"=&v"(lo[ks]):"v"(vb),"i"(d0*4096+ks*1024):"memory");
      asm volatile("ds_read_b64_tr_b16 %0,%1 offset:%c2":"=&v"(hi[ks]):"v"(vb),"i"(d0*4096+ks*1024+512):"memory");}
    asm volatile("s_waitcnt lgkmcnt(0)":::"memory");SBAR();
    #define PK(k) (bf16x8){lo[k][0],lo[k][1],lo[k][2],lo[k][3],hi[k][0],hi[k][1],hi[k][2],hi[k][3]}
    o[d0]=__builtin_amdgcn_mfma_f32_32x32x16_bf16(pa0,PK(0),o[d0],0,0,0);
    o[d0]=__builtin_amdgcn_mfma_f32_32x32x16_bf16(pa1,PK(1),o[d0],0,0,0);
    o[d0]=__builtin_amdgcn_mfma_f32_32x32x16_bf16(pa2,PK(2),o[d0],0,0,0);
    o[d0]=__builtin_amdgcn_mfma_f32_32x32x16_bf16(pa3,PK(3),o[d0],0,0,0);
    #undef PK
  }
}

#ifndef ATTN_STORE16
#define ATTN_STORE16(p,v) (*(u32x4*)(p)=(v))
#endif
template<int THRL> __device__ __forceinline__ void attn_unit(int b,int h,int qb,const bf16*Q,const bf16*__restrict__ K,const bf16*__restrict__ V,bf16*O,const float*Cum,const float*Lq,bool newbh,char*shm){
  const int tid=threadIdx.x,lane=tid&63,r32=lane&31,hi=lane>>5; const int wid=__builtin_amdgcn_readfirstlane(tid>>6);
  const long rowbase=(long)b*SEQ; const int q0=qb*QB;
  const bf16*Qw=Q+(rowbase+q0+wid*QBLK)*QP+h*D;
  const bf16*Kh=K+rowbase*KP+h*D,*Vh=V+rowbase*VP+h*D;
  const unsigned lds0=(unsigned)(uintptr_t)shm;
  float*wsf=(float*)(shm+LDS_WS)+wid*64;
  const unsigned kdst=lds0+LDS_K+wid*1024, vdst=lds0+LDS_V+wid*1024;
  #define DMA_K(t,slot) glds16(ksrc+(long)(t)*KVBLK*KP,(unsigned)__builtin_amdgcn_readfirstlane(kdst+(slot)))
  #define DMA_V(t,slot) glds16(vsrc+(long)(t)*KVBLK*VP,(unsigned)__builtin_amdgcn_readfirstlane(vdst+(slot)))
  const int vb0=(int)(lds0+LDS_V)+((lane>>4)&1)*32+(lane&3)*8+(4*hi+((lane&15)>>2))*64;
  const char*Kbase=shm+LDS_K; bf16x8 kf[8];
  const lds_cptr shm3=(lds_cptr)shm; const lds_cptr kp0=shm3+LDS_K+hi*1024+r32*16; const lds_cptr vp0=shm3+LDS_V+((lane>>4)&1)*32+(lane&3)*8+(4*hi+((lane&15)>>2))*64;
  const int NTF=(q0+QB)/KVBLK;
  __attribute__((address_space(3))) float*cumL=(__attribute__((address_space(3))) float*)(shm3+LDS_CUM);
  if(newbh){ __attribute__((address_space(3))) float*wsum=(__attribute__((address_space(3))) float*)(shm3+LDS_WSUM);
    int tid_c=tid; asm volatile("":"+v"(tid_c));
    const float*lf=Cum+((long)b*NHEAD+h)*SEQ; f32x4_t x=*(const f32x4_t*)(lf+4*tid_c); x.y+=x.x; x.z+=x.y; x.w+=x.z;
    const float tot=x.w; float incl=tot;
    #pragma unroll
    for(int o=1;o<64;o<<=1){ const float t_=__shfl_up(incl,o); if(lane>=o)incl+=t_; }
    if(lane==63)wsum[wid]=incl;
    WAIT_BAR(0);
    float woff=0.f;
    #pragma unroll
    for(int w_=0;w_<NW;++w_){ const float t_=wsum[w_]; if(w_<wid)woff+=t_; }
    const float off=woff+incl-tot; x.x+=off; x.y+=off; x.z+=off; x.w+=off;
    *(__attribute__((address_space(3))) f32x4_t*)(cumL+4*tid_c)=x;
    WAIT_BAR(0); }
  const __attribute__((address_space(3))) float*cum=cumL; const float c0=cum[q0];
  { __attribute__((address_space(3))) unsigned*kbw=(__attribute__((address_space(3))) unsigned*)(shm3+LDS_KB);
    for(int s=tid;s<q0+QB;s+=NW*64){ const float v=c0-cum[s]; const unsigned vb=__float_as_uint(v); const unsigned hb=(vb+0x7fffu+((vb>>16)&1u))&0xffff0000u; const float lo=v-__uint_as_float(hb);
      const unsigned lb=__float_as_uint(lo); const unsigned lr=(lb+0x7fffu+((lb>>16)&1u))>>16; kbw[s]=(hb>>16)|(lr<<16); } }
  const float qbias=cum[q0+wid*QBLK+r32]-c0;
  int T0; { const float thr=2.f*Lq[8+h]+36.f; const int j_=lane; const bool pr_=(j_<NTF-4)&&(cum[(j_<NTF?j_:0)*KVBLK+63]-c0>thr);
    T0=(int)__builtin_amdgcn_readfirstlane(__builtin_popcountll(__ballot(pr_)))&~1; }
  const int NT=NTF-T0;
  const float lq=Lq[h];
  const unsigned onew=hi?0u:0x3f803f80u;
  const bf16x8 qone=__builtin_bit_cast(bf16x8,(u32x4){onew,0u,0u,0u});
  const __attribute__((address_space(3))) unsigned*kbp=(const __attribute__((address_space(3))) unsigned*)(shm3+LDS_KB)+r32+T0*KVBLK;
  const bf16*ksrc=Kh+(long)(T0*KVBLK+lane)*KP+wid*8;
  const bf16*vsrc=Vh+(long)(T0*KVBLK+16*(wid&3)+(lane>>2))*VP+(wid>>2)*32+(lane&3)*8;
  #define KBF(t,half) __builtin_bit_cast(bf16x8,(u32x4){kbp[(t)*KVBLK+(half)*32],0u,0u,0u})
  DMA_K(0,0);DMA_V(0,0);DMA_K(1,SLOTB);
  bf16x8 qr[4];
  #pragma unroll
  for(int d0=0;d0<4;++d0)qr[d0]=*reinterpret_cast<const bf16x8*>(&Qw[(long)r32*QP+d0*16+hi*8]);
  const __attribute__((address_space(3))) char*qsl=(const __attribute__((address_space(3))) char*)(shm3+LDS_Q)+wid*4096+lane*64;
  #pragma unroll
  for(int d0=0;d0<4;++d0)*(__attribute__((address_space(3))) bf16x8*)(qsl+16*d0)=qr[d0];
  #define QL(d) (*(const __attribute__((address_space(3))) bf16x8*)(qsl+16*(d)))
  float mhat=0.f,l_reg=0.f;f32x16 o[2];o[0]=f32x16{};o[1]=f32x16{};f32x16 negm;
  #pragma unroll
  for(int r=0;r<16;++r)negm[r]=qbias;
  asm volatile("":"+v"(negm));
  const int qrel=wid*QBLK+r32;
  #define CMASK(P0,P1,t) do{int jb_=(t)-(NT-4); if(jb_>=0)cmask(P0,P1,jb_,qrel,hi);}while(0)
  bool resc=false;
  #define START(P0,P1) do{ const float rm=rowmax(P0,P1); resc=false; \
    { const float dl=__builtin_fmaxf(rm,lq); mhat=fadd_s(mhat,dl); \
      _Pragma("unroll") for(int r=0;r<16;++r){P0[r]=fsub_s(P0[r],dl);P1[r]=fsub_s(P1[r],dl);} \
      _Pragma("unroll") for(int r=0;r<16;++r)negm[r]=qbias-mhat; asm volatile("":"+v"(negm)); } \
    _Pragma("unroll") for(int r=0;r<16;++r)P0[r]=__builtin_amdgcn_exp2f(P0[r]); }while(0)
  #define RESC() do{ if(resc){ asm volatile("s_waitcnt lgkmcnt(0)":::"memory"); \
      _Pragma("unroll") for(int d_=0;d_<2;++d_) _Pragma("unroll") for(int r=0;r<16;++r)o[d_][r]*=wsf[crow(r,hi)]; } }while(0)
  f32x16 pA0,pA1,pB0,pB1;
  int sl_prev=0,sl_cur=0,sl_next=SLOTB;
  #define ROT() do{sl_prev=sl_cur;sl_cur=sl_next;sl_next=(sl_next==(NSLOT-1)*SLOTB)?0:sl_next+SLOTB;}while(0)
  DMA_K(2,2*SLOTB);
  WAIT_BAR(3);
  qkt(pA0,pA1,Kbase,qr,negm,r32,hi,KBF(0,0),KBF(0,1),qone);asm volatile("s_nop 15\n\ts_nop 7":"+v"(pA0),"+v"(pA1));CMASK(pA0,pA1,0);
  START(pA0,pA1);
  _Pragma("unroll") for(int r=0;r<16;++r)pA1[r]=__builtin_amdgcn_exp2f(pA1[r]);
  WAIT_BAR(0);
  DMA_K(3,0);DMA_V(1,SLOTB);
  ROT();
  kload8(kf,kp0+sl_cur);
  WAIT_BAR(2);
  s16x4 vlo[8],vhi[8]; u32x4 pw0,pw1,pw2,pw3;
  #define PKW(P,B) cvtpk_s(P[B],P[B+1])
  #define PAF(k) __builtin_bit_cast(bf16x8,pw##k)
  #define VFR(i) (bf16x8){vlo[i][0],vlo[i][1],vlo[i][2],vlo[i][3],vhi[i][0],vhi[i][1],vhi[i][2],vhi[i][3]}
  #define PIN(x) asm volatile("":"+v"(x))
  #define MX3(a,b,c) __builtin_fmaxf(__builtin_fmaxf((a),(b)),(c))
  #define GAPA(MF,A0,A1,A2,A3,W0,W1,PW) do{ MF; sacc+=A0; sacc+=A1; sacc+=A2; sacc+=A3; PIN(sacc); W0; W1; PIN(PW); SBAR(); }while(0)
  #define EX(v) __builtin_amdgcn_exp2f(v)
  #define GAPB(MF,X,B) do{ MF; X[B]=EX(X[B]); X[B+1]=EX(X[B+1]); X[B+2]=EX(X[B+2]); X[B+3]=EX(X[B+3]); PIN(X); SBAR(); }while(0)
  #define VRD(i) do{ vlo[i]=vtr(vp_+(((i)>>2)*4096+((i)&3)*1024)); vhi[i]=vtr(vp_+(((i)>>2)*4096+((i)&3)*1024+512)); }while(0)
  #define KRD(G,j) do{ if(G){ kload2(kf,kp0+sl_next,j); SBAR(); } }while(0)
  #define STEP(C0,C1,P0,P1,t,GK,GV,GL) do{ SBAR(); \
    const lds_cptr vp_=vp0+sl_prev; \
    { const bf16x8 kb0_=KBF(t,0),kb1_=KBF(t,1); C0=__builtin_amdgcn_mfma_f32_32x32x16_bf16(kb0_,qone,negm,0,0,0); C1=__builtin_amdgcn_mfma_f32_32x32x16_bf16(kb1_,qone,negm,0,0,0); SBAR(); } \
    VRD(0); SBAR(); float sacc=(P0[0]+P0[1]); \
    GAPA(C0=__builtin_amdgcn_mfma_f32_32x32x16_bf16(kf[0],QL(0),C0,0,0,0), P0[2],P0[3],P0[4],P0[5],     pw0[0]=PKW(P0,0), pw0[1]=PKW(P0,2), pw0); \
    VRD(4); SBAR(); GAPA(C1=__builtin_amdgcn_mfma_f32_32x32x16_bf16(kf[1],QL(0),C1,0,0,0), P0[6],P0[7],P0[8],P0[9],     pw0[2]=PKW(P0,4), pw0[3]=PKW(P0,6), pw0); \
    VRD(1); SBAR(); GAPA(C0=__builtin_amdgcn_mfma_f32_32x32x16_bf16(kf[2],QL(1),C0,0,0,0),   P0[10],P0[11],P0[12],P0[13], pw1[0]=PKW(P0,8), pw1[1]=PKW(P0,10), pw1); \
    VRD(5); SBAR(); GAPA(C1=__builtin_amdgcn_mfma_f32_32x32x16_bf16(kf[3],QL(1),C1,0,0,0),   P0[14],P0[15],P1[0],P1[1],   pw1[2]=PKW(P0,12),pw1[3]=PKW(P0,14), pw1); \
    VRD(2); SBAR(); GAPA(C0=__builtin_amdgcn_mfma_f32_32x32x16_bf16(kf[4],QL(2),C0,0,0,0),   P1[2],P1[3],P1[4],P1[5],     pw2[0]=PKW(P1,0), pw2[1]=PKW(P1,2), pw2); \
    VRD(6); SBAR(); GAPA(C1=__builtin_amdgcn_mfma_f32_32x32x16_bf16(kf[5],QL(2),C1,0,0,0),   P1[6],P1[7],P1[8],P1[9],     pw2[2]=PKW(P1,4), pw2[3]=PKW(P1,6), pw2); \
    VRD(3); SBAR(); GAPA(C0=__builtin_amdgcn_mfma_f32_32x32x16_bf16(kf[6],QL(3),C0,0,0,0),   P1[10],P1[11],P1[12],P1[13], pw3[0]=PKW(P1,8), pw3[1]=PKW(P1,10), pw3); \
    VRD(7); SBAR(); GAPA(C1=__builtin_amdgcn_mfma_f32_32x32x16_bf16(kf[7],QL(3),C1,0,0,0),   P1[14],P1[15],0.f,0.f,       pw3[2]=PKW(P1,12),pw3[3]=PKW(P1,14), pw3); \
    l_reg+=sacc; \
    if(GK){DMA_K((t)+3,sl_cur);} if(GV){DMA_V((t)+1,sl_next);} \
    CMASK(C0,C1,t); \
    { float a=MX3(C0[0],C0[1],C1[0]),b=MX3(C0[2],C0[3],C1[1]); a=MX3(a,C1[2],C1[3]); \
      _Pragma("unroll") for(int r=4;r<16;r+=4){a=MX3(a,C0[r],C0[r+1]);b=MX3(b,C0[r+2],C0[r+3]);a=MX3(a,C1[r],C1[r+1]);b=MX3(b,C1[r+2],C1[r+3]);} \
      float rm=__builtin_fmaxf(a,b); { auto rr=__builtin_amdgcn_permlane32_swap(__float_as_uint(rm),__float_as_uint(rm),false,false); rm=__builtin_fmaxf(__uint_as_float(rr[0]),__uint_as_float(rr[1])); } \
      resc=false; \
      if(__builtin_expect(__any(rm>(float)THRL),0)){ const float dl=__builtin_fmaxf(rm,0.f); mhat+=dl; \
        _Pragma("unroll") for(int r=0;r<16;++r){C0[r]-=dl;C1[r]-=dl;} \
        _Pragma("unroll") for(int r=0;r<16;++r)negm[r]=qbias-mhat; asm volatile("":"+v"(negm)); \
        const float f=__builtin_amdgcn_exp2f(-dl); l_reg*=f; if(hi==0)wsf[r32]=f; resc=true; } } \
    SBAR(); \
    GAPB(o[0]=__builtin_amdgcn_mfma_f32_32x32x16_bf16(PAF(0),VFR(0),o[0],0,0,0), C0,0); \
    GAPB(o[1]=__builtin_amdgcn_mfma_f32_32x32x16_bf16(PAF(0),VFR(4),o[1],0,0,0), C0,4); \
    KRD(GL,0); GAPB(o[0]=__builtin_amdgcn_mfma_f32_32x32x16_bf16(PAF(1),VFR(1),o[0],0,0,0), C0,8); \
    KRD(GL,1); GAPB(o[1]=__builtin_amdgcn_mfma_f32_32x32x16_bf16(PAF(1),VFR(5),o[1],0,0,0), C0,12); \
    KRD(GL,2); GAPB(o[0]=__builtin_amdgcn_mfma_f32_32x32x16_bf16(PAF(2),VFR(2),o[0],0,0,0), C1,0); \
    KRD(GL,3); GAPB(o[1]=__builtin_amdgcn_mfma_f32_32x32x16_bf16(PAF(2),VFR(6),o[1],0,0,0), C1,4); \
    GAPB(o[0]=__builtin_amdgcn_mfma_f32_32x32x16_bf16(PAF(3),VFR(3),o[0],0,0,0), C1,8); \
    GAPB(o[1]=__builtin_amdgcn_mfma_f32_32x32x16_bf16(PAF(3),VFR(7),o[1],0,0,0), C1,12); \
    }while(0)
  int t=1;
  #undef CMASK
  #define CMASK(P0,P1,t) do{}while(0)
  for(;t+5<NT;t+=2){
    STEP(pB0,pB1,pA0,pA1,t,true,true,true);     WAIT_BAR(2); RESC(); ROT();
    STEP(pA0,pA1,pB0,pB1,t+1,true,true,true);   WAIT_BAR(2); RESC(); ROT();
  }
  #undef CMASK
  #define CMASK(P0,P1,t) do{int jb_=(t)-(NT-4); if(jb_>=0)cmask(P0,P1,jb_,qrel,hi);}while(0)
  #define ENDW(tt) do{ if((tt)+3<NT){WAIT_BAR(2);} else if((tt)+2<NT){WAIT_BAR(1);} else {WAIT_BAR(0);} }while(0)
  for(;t+1<NT;t+=2){
    STEP(pB0,pB1,pA0,pA1,t,(t+3<NT),(t+1<NT),(t+1<NT));       ENDW(t);   RESC(); ROT();
    STEP(pA0,pA1,pB0,pB1,t+1,(t+4<NT),(t+2<NT),(t+2<NT));     ENDW(t+1); RESC(); ROT();
  }
  STEP(pB0,pB1,pA0,pA1,NT-1,false,false,false); RESC();
  { float sacc=pB0[0]+pB0[1]; _Pragma("unroll") for(int r=2;r<16;++r)sacc+=pB0[r]; _Pragma("unroll") for(int r=0;r<16;++r)sacc+=pB1[r]; l_reg+=sacc;
    pw0=(u32x4){PKW(pB0,0),PKW(pB0,2),PKW(pB0,4),PKW(pB0,6)};pw1=(u32x4){PKW(pB0,8),PKW(pB0,10),PKW(pB0,12),PKW(pB0,14)};pw2=(u32x4){PKW(pB1,0),PKW(pB1,2),PKW(pB1,4),PKW(pB1,6)};pw3=(u32x4){PKW(pB1,8),PKW(pB1,10),PKW(pB1,12),PKW(pB1,14)};
    SBAR(); pv(o,vb0+sl_cur,PAF(0),PAF(1),PAF(2),PAF(3)); }
  #undef PKW
  #undef PAF
  #undef VFR
  #undef PIN
  #undef MX3
  #undef GAPA
  #undef GAPB
  #undef EX
  #undef VRD
  #undef KRD
  #undef STEP
  #undef ENDW
  {auto rr=__builtin_amdgcn_permlane32_swap(__float_as_uint(l_reg),__float_as_uint(l_reg),false,false);l_reg=__uint_as_float(rr[0])+__uint_as_float(rr[1]);}
  if(hi==0)wsf[32+r32]=l_reg;asm volatile("s_waitcnt lgkmcnt(0)":::"memory");
  float rli[16];
  #pragma unroll
  for(int r=0;r<16;++r)rli[r]=__builtin_amdgcn_rcpf(wsf[32+crow(r,hi)]);
  bf16*Ow=O+(rowbase+q0+wid*QBLK)*OP+h*D;
  { bf16*stg=(bf16*)(shm+LDS_OST)+wid*2048;
    #pragma unroll
    for(int r=0;r<16;++r){const int orow=crow(r,hi);
      #pragma unroll
      for(int d0=0;d0<2;++d0)stg[orow*64+d0*32+r32]=__float2bfloat16(o[d0][r]*rli[r]);}
    asm volatile("s_waitcnt lgkmcnt(0)":::"memory");
    int lane_e=lane; asm volatile("":"+v"(lane_e));
    #pragma unroll
    for(int i=0;i<4;++i){const int row=i*8+(lane_e>>3),ch=lane_e&7; const u32x4 v=*(const u32x4*)(stg+row*64+ch*8); ATTN_STORE16(Ow+(long)row*OP+ch*8,v);} }
  asm volatile("s_waitcnt lgkmcnt(0)\n\ts_barrier":::"memory");
  #undef KBF
  #undef QL
  #undef DMA_K
  #undef DMA_V
  #undef CMASK
  #undef START
  #undef RESC
  #undef ROT
}
constexpr int ATTN_LDS_BYTES=LDS_BYTES;
struct AttnTensors { const bf16* Q; const bf16* K; const bf16* V; bf16* O; const float* Cum; const float* Lq; };
struct AttnUnit { int bh; int qb; };
struct StaticOrder {
  int a,na;
  __device__ __forceinline__ StaticOrder(int a_,int na_):a(a_),na(na_){}
  __device__ __forceinline__ bool next(int i,AttnUnit&u)const{ const int bh=a+(i/NQB)*na; if(a<0||bh>=BATCH*NHEAD)return false; u.bh=bh; u.qb=NQB-1-(i%NQB); return true; }
  __device__ __forceinline__ void a_ready(const AttnUnit&)const{}
  __device__ __forceinline__ void done(const AttnUnit&)const{}
};
template<class Sched,int THRL=16> __device__ __forceinline__ void attn_phase(char*lds,const AttnTensors&T,const Sched&S){
  AttnUnit u; int last_=-1;
  for(int i=0;S.next(i,u);++i){ S.a_ready(u); attn_unit<THRL>(u.bh/NHEAD,u.bh%NHEAD,u.qb,T.Q,T.K,T.V,T.O,T.Cum,T.Lq,u.bh!=last_,lds); last_=u.bh; S.done(u); }
}
#undef SBAR
#undef WAIT_BAR
}
constexpr int NWAVES = 8;
#ifndef MK_N_LAUNCHES
#define MK_N_LAUNCHES 1
#endif
constexpr int PER_PHASE = 9;
constexpr int N_LAUNCHES = MK_N_LAUNCHES;
static_assert(N_LAUNCHES == 1 || N_LAUNCHES == PER_PHASE, "MK_N_LAUNCHES is 1 or 9");

constexpr int BATCH = 16, T = 2048, D = 1024, HD = 64, FOXH = 8, RWKVH = 8, FF = 2816;
constexpr int M = BATCH * T;
constexpr int IN_COLS = 3368;
constexpr int NIN = 3584;
constexpr int PC_Q = 0, PC_K = 512, PC_V = 1024, PC_R = 1536, PC_RK = 2048, PC_RV = 2560, PC_WDN = 3072, PC_ADN = 3136, PC_GDN = 3200, PC_F = 3360;
constexpr int NGU = 2 * FF;
constexpr float RMS_EPS = 1e-6f, GN_EPS = 64e-5f, L2_EPS = 1e-12f;
constexpr float LOG2E = 1.4426950408889634f;

constexpr size_t MiB = 1u << 20, KiB = 1u << 10;
constexpr size_t WS_CTL = 0, CTL_ZERO_BYTES = 64 * KiB;
constexpr size_t WS_WIN = 1 * MiB, WS_WOUT = 8 * MiB, WS_WGU = 10 * MiB, WS_WDN = 21 * MiB;
constexpr size_t WS_W2T = 27 * MiB, WS_A2T = WS_W2T + 64 * KiB, WS_G2T = WS_A2T + 64 * KiB;
constexpr size_t WS_MOD = 27 * MiB + 512 * KiB;
constexpr size_t WS_LQ = 27 * MiB + 960 * KiB;
constexpr size_t WS_CUM = 28 * MiB;
constexpr size_t WS_XN = 32 * MiB;
constexpr size_t WS_QN = 96 * MiB, WS_KN = 128 * MiB;
constexpr size_t WS_MIX = 160 * MiB;
constexpr size_t WS_P = 224 * MiB;
constexpr size_t WS_HH = WS_P;
constexpr size_t WS_SCR = 448 * MiB;
constexpr size_t WS_END = 452 * MiB;
static_assert(WS_WIN + (size_t)NIN * D * 2 <= WS_WOUT && WS_WGU + (size_t)NGU * D * 2 <= WS_WDN && WS_WDN + (size_t)D * FF * 2 <= WS_W2T && WS_G2T + 512 * 160 * 2 <= WS_MOD && WS_MOD + 16 * 6144 * 4 <= WS_LQ, "ws map");
static_assert(WS_P + (size_t)M * NIN * 2 <= WS_END && WS_HH + (size_t)M * FF * 2 <= WS_END, "ws map");
constexpr int CW_TMO = 0, CW_CODE = 1, CW_LATE = 2048;
constexpr int CW_BAR = 4096;

constexpr int RING_OFF = 0, RING_BYTES = 162816;
constexpr int LDSCTL_OFF = RING_BYTES, MISC_OFF = LDSCTL_OFF + 320;
constexpr int LDS_BYTES = 163840;
static_assert(MISC_OFF + 128 <= LDS_BYTES, "LDS map");
#define GAS __attribute__((address_space(1)))
#define LAS __attribute__((address_space(3)))
typedef unsigned short bf16;
typedef unsigned v4u __attribute__((ext_vector_type(4)));
typedef float f32x4 __attribute__((ext_vector_type(4)));
typedef short bf16x8 __attribute__((ext_vector_type(8)));
typedef GAS unsigned gu32;
typedef GAS unsigned long long gu64;
#define RLX_AGENT __ATOMIC_RELAXED, __HIP_MEMORY_SCOPE_AGENT
#define LDS_WAIT() asm volatile("s_waitcnt lgkmcnt(0)" ::: "memory")
#define VM_WAIT() asm volatile("s_waitcnt vmcnt(0)" ::: "memory")
__device__ __forceinline__ unsigned long long rt() { return __builtin_amdgcn_s_memrealtime(); }
__device__ __forceinline__ unsigned f2bf(float f) { unsigned u = __builtin_bit_cast(unsigned, f); return (u + 0x7fffu + ((u >> 16) & 1u)) >> 16; }
__device__ __forceinline__ unsigned pk2(float lo, float hi) { return f2bf(lo) | (f2bf(hi) << 16); }

#define XB_TMO      128
#define XB_XCNT(j)  (256  + 64 * (j))
#define XB_XSUB(j)  (1280 + 64 * (j))
#define XB_XGEN(j)  (2304 + 64 * (j))
#define XB_TOP      3328
#define XB_TOPGEN   3392
#define XCD_BAR_WORDS 3456
#define XB_SPIN_CAP (1u << 18)

__device__ __forceinline__ unsigned xb_ld(unsigned* p)              { return __hip_atomic_load(p, __ATOMIC_RELAXED, __HIP_MEMORY_SCOPE_AGENT); }
__device__ __forceinline__ unsigned xb_add(unsigned* p, unsigned v) { return __hip_atomic_fetch_add(p, v, __ATOMIC_RELAXED, __HIP_MEMORY_SCOPE_AGENT); }
__device__ __forceinline__ unsigned xb_xcc_id() { return (unsigned)__builtin_amdgcn_s_getreg((3 << 11) | 20) & 0xFu; }
#define XB_SPIN(cond, bar) do { unsigned _sp = 0; while (cond) { __builtin_amdgcn_s_sleep(1); \
    if ((++_sp & 255u) == 0u) { if (xb_ld(&(bar)[XB_TMO])) break; if (_sp > XB_SPIN_CAP) { atomicAdd(&(bar)[XB_TMO], 1u); break; } } } } while (0)

struct XcdBarrier {
    unsigned* bar; unsigned x;
    volatile LAS unsigned* st;
};

__device__ __forceinline__ XcdBarrier xcd_barrier_post(unsigned* bar, volatile LAS unsigned* st) {
    XcdBarrier b; b.bar = bar; b.x = xb_xcc_id(); b.st = st;
    if (threadIdx.x == 0) (void)xb_add(&bar[XB_XCNT(b.x)], 1u);
    return b;
}
__device__ __forceinline__ void xcd_barrier_complete(unsigned* bar, unsigned x, unsigned& nloc, unsigned& nx) {
    const unsigned G = gridDim.x * gridDim.y * gridDim.z;
    unsigned sum, cnt, mine, sp = 0u;
    for (;;) {
        sum = 0u; cnt = 0u; mine = 0u;
#pragma unroll
        for (unsigned j = 0; j < 16; ++j) { const unsigned c = xb_ld(&bar[XB_XCNT(j)]); sum += c; cnt += (c > 0u) ? 1u : 0u; mine = (j == x) ? c : mine; }
        if (sum == G) break;
        __builtin_amdgcn_s_sleep(1);
        if ((++sp & 255u) == 0u) { if (xb_ld(&bar[XB_TMO])) break; if (sp > XB_SPIN_CAP) { atomicAdd(&bar[XB_TMO], 1u); break; } }
    }
    nloc = mine > 0u ? mine : 1u; nx = cnt > 0u ? cnt : 1u;
}

__device__ __forceinline__ void xcd_barrier(const XcdBarrier& b) {
    asm volatile("s_waitcnt vmcnt(0)" ::: "memory");
    __syncthreads();
    if (threadIdx.x == 0) {
        unsigned* bar = b.bar;
        __builtin_amdgcn_s_waitcnt(0);
        unsigned nloc = b.st[0], nx = b.st[1];
        if (nloc == 0u) { xcd_barrier_complete(bar, b.x, nloc, nx); b.st[0] = nloc; b.st[1] = nx; }
        const unsigned old = xb_add(&bar[XB_XSUB(b.x)], 1u);
        const unsigned gen = old / nloc;
        if (old + 1u == (gen + 1u) * nloc) {
            __builtin_amdgcn_fence(__ATOMIC_RELEASE, "agent");
            asm volatile("s_waitcnt vmcnt(0)" ::: "memory");
            const unsigned og = xb_add(&bar[XB_TOP], 1u);
            const unsigned tg = og / nx;
            if (og + 1u == (tg + 1u) * nx) xb_add(&bar[XB_TOPGEN], 1u);
            else XB_SPIN(xb_ld(&bar[XB_TOPGEN]) == tg, bar);
            __builtin_amdgcn_fence(__ATOMIC_ACQUIRE, "agent");
            xb_add(&bar[XB_XGEN(b.x)], 1u);
            asm volatile("s_waitcnt vmcnt(0)" ::: "memory");
        } else {
            XB_SPIN(xb_ld(&bar[XB_XGEN(b.x)]) == gen, bar);
            __builtin_amdgcn_fence(__ATOMIC_ACQUIRE, "agent");
            asm volatile("s_waitcnt vmcnt(0)" ::: "memory");
        }
    }
    __syncthreads();
}
typedef float f32x2 __attribute__((ext_vector_type(2)));
typedef float f32x16 __attribute__((ext_vector_type(16)));
typedef unsigned v2u __attribute__((ext_vector_type(2)));
struct Frame {
    LAS unsigned char* lds;
    volatile LAS unsigned* MISC;
    gu32* ctl;
    int tid, lane, wave;
    int vcu, G;
    const float* in[25]; float* out; unsigned char* ws;
};
enum { I_X = 0, I_C, I_ADAW, I_ADAB, I_N1G, I_N2G, I_WIN, I_FBIAS, I_QG, I_KG, I_MU, I_W0, I_W2, I_A0, I_A2, I_G2, I_KK, I_KA, I_RK, I_LNG, I_LNB, I_WOUT, I_WG, I_WU, I_WD };

__device__ __forceinline__ float wave_sum(float v) {
#pragma unroll
    for (int o = 1; o < 64; o <<= 1) v += __shfl_xor(v, o);
    return v;
}
__device__ __forceinline__ float wave_max(float v) {
#pragma unroll
    for (int o = 1; o < 64; o <<= 1) v = fmaxf(v, __shfl_xor(v, o));
    return v;
}
template <int CTRL> __device__ __forceinline__ float dpp_f(float x) { return __int_as_float(__builtin_amdgcn_update_dpp(0, __float_as_int(x), CTRL, 0xf, 0xf, true)); }
__device__ __forceinline__ float red16(float x) {
    x += dpp_f<0xB1>(x);
    x += dpp_f<0x4E>(x);
    x += dpp_f<0x141>(x);
    x += dpp_f<0x140>(x);
    return x;
}
__device__ __forceinline__ float red8(float x) {
    x += dpp_f<0xB1>(x); x += dpp_f<0x4E>(x); x += dpp_f<0x141>(x); return x;
}
typedef __bf16 bf16x2_t __attribute__((ext_vector_type(2)));
__device__ __forceinline__ unsigned cvtpk(float lo, float hi) { const f32x2 v = {lo, hi}; const bf16x2_t b = __builtin_convertvector(v, bf16x2_t); return __builtin_bit_cast(unsigned, b); }
__device__ __forceinline__ float bf2f(unsigned short h) { return __uint_as_float((unsigned)h << 16); }
__device__ __forceinline__ float sigmoidf_(float x) { return __builtin_amdgcn_rcpf(1.0f + __builtin_amdgcn_exp2f(-LOG2E * x)); }
__device__ __forceinline__ float tanhf_(float x) { return 1.0f - 2.0f * __builtin_amdgcn_rcpf(1.0f + __builtin_amdgcn_exp2f(2.0f * LOG2E * x)); }

template <class RowMap>
__device__ __forceinline__ void p0_transpose_item(const float* W, int K, int N, bf16* WT, int ldk, RowMap rm, LAS float* scr, int item, int lane) {
    const int nblk = (N + 31) / 32, kb = item / nblk, nb = item % nblk, k0 = 64 * kb, n0 = 32 * nb;
    const int nn = n0 + (lane & 31);
#pragma unroll
    for (int i = 0; i < 32; ++i) { const int kk = 2 * i + (lane >> 5); scr[kk * 33 + (lane & 31)] = (k0 + kk < K && nn < N) ? W[(size_t)(k0 + kk) * N + nn] : 0.f; }
    LDS_WAIT(); asm volatile("" ::: "memory");
    const int c = lane & 7;
#pragma unroll
    for (int j = 0; j < 4; ++j) { const int n = (lane >> 3) + 8 * j; const LAS float* s = scr + (8 * c) * 33 + n;
        v4u o; o.x = pk2(s[0 * 33], s[1 * 33]); o.y = pk2(s[2 * 33], s[3 * 33]); o.z = pk2(s[4 * 33], s[5 * 33]); o.w = pk2(s[6 * 33], s[7 * 33]);
        if (n0 + n < N && k0 + 8 * c < K) *(GAS v4u*)(WT + (size_t)rm(n0 + n) * ldk + k0 + 8 * c) = o; }
    LDS_WAIT(); asm volatile("" ::: "memory");
}
struct RmId { __device__ __forceinline__ int operator()(int n) const { return n; } };
struct RmWin { __device__ __forceinline__ int operator()(int n) const { return n < 1536 ? n : (n < 1544 ? PC_F + (n - 1536) : (n - 1544) + PC_R); } };
struct RmGate { int up; __device__ __forceinline__ int operator()(int n) const { return (n >> 7) * 256 + (n & 127) + up * 128; } };

__device__ __forceinline__ void p0_prologue(Frame& F) {
    LAS float* scr = (LAS float*)(F.lds + RING_OFF + F.wave * 16384);
    const int gw = F.vcu * NWAVES + F.wave, NGW = F.G * NWAVES;
    bf16* WIN = (bf16*)(F.ws + WS_WIN);
    bf16* W2T = (bf16*)(F.ws + WS_W2T); bf16* A2T = (bf16*)(F.ws + WS_A2T); bf16* G2T = (bf16*)(F.ws + WS_G2T);
    if (F.vcu < 6144 / 32) {
        LAS float* sc = (LAS float*)(F.lds + RING_OFF);
        LAS float* red = (LAS float*)(F.lds + RING_OFF + 65536);
        const float* cin = F.in[I_C];
        for (int i = F.tid; i < 16 * 1024; i += NWAVES * 64) { const int b = i >> 10, k = i & 1023; const float v = cin[i]; sc[k * 16 + b] = v * sigmoidf_(v); }
        __syncthreads();
        const int col = F.tid & 31, kg = F.tid >> 5, j0 = F.vcu * 32;
        float acc[16];
#pragma unroll
        for (int b = 0; b < 16; ++b) acc[b] = 0.f;
        const float* wp = F.in[I_ADAW] + (size_t)(kg * 64) * 6144 + j0 + col;
        for (int k = 0; k < 64; ++k) { const float w = wp[(size_t)k * 6144]; const LAS f32x4* s4 = (const LAS f32x4*)(sc + (kg * 64 + k) * 16);
#pragma unroll
            for (int q = 0; q < 4; ++q) { const f32x4 s = s4[q]; acc[4 * q] += s.x * w; acc[4 * q + 1] += s.y * w; acc[4 * q + 2] += s.z * w; acc[4 * q + 3] += s.w * w; } }
#pragma unroll
        for (int b = 0; b < 16; ++b) red[(kg * 16 + b) * 32 + col] = acc[b];
        __syncthreads();
        { const int b = F.tid >> 5; float s = F.in[I_ADAB][j0 + col];
#pragma unroll
          for (int g = 0; g < 16; ++g) s += red[(g * 16 + b) * 32 + col];
          ((float*)(F.ws + WS_MOD))[b * 6144 + j0 + col] = s; }
        __syncthreads();
    }
    constexpr int I_IN = (D / 64) * ((IN_COLS + 31) / 32), I_L = 512 / 32, I_LG = 3 * (512 / 32);
    constexpr int NITEMS = I_IN + 2 * I_L + I_LG;
    for (int it = gw; it < NITEMS; it += NGW) {
        int r = it;
        if (r < I_IN) { p0_transpose_item(F.in[I_WIN], D, IN_COLS, WIN, D, RmWin{}, scr, r, F.lane); continue; } r -= I_IN;
        if (r < I_L) { p0_transpose_item(F.in[I_W2], 64, 512, W2T, 64, RmId{}, scr, r, F.lane); continue; } r -= I_L;
        if (r < I_L) { p0_transpose_item(F.in[I_A2], 64, 512, A2T, 64, RmId{}, scr, r, F.lane); continue; } r -= I_L;
        p0_transpose_item(F.in[I_G2], 160, 512, G2T, 160, RmId{}, scr, r, F.lane);
    }
    { const int gt = F.vcu * NWAVES * 64 + F.tid, NGT = F.G * NWAVES * 64; GAS v4u* z = (GAS v4u*)(WIN + (size_t)IN_COLS * D);
      for (int i = gt; i < (NIN - IN_COLS) * D / 8; i += NGT) z[i] = (v4u){0u, 0u, 0u, 0u}; }
    if (gw < FOXH) { const float gq = wave_max(fabsf(F.in[I_QG][gw * 64 + F.lane])), gk = wave_max(fabsf(F.in[I_KG][gw * 64 + F.lane]));
        const float bh = 8.0f * gq * gk * LOG2E * 1.01f;
        if (F.lane == 0) { ((float*)(F.ws + WS_LQ))[gw] = fminf(0.f, 100.f - bh); ((float*)(F.ws + WS_LQ))[8 + gw] = bh; } }
}

__device__ __forceinline__ void xn_pass(Frame& F, const float* x, const float* gain, int shift_off, int scale_off) {
    const int gw = F.vcu * NWAVES + F.wave, NGW = F.G * NWAVES; const float* mod = (const float*)(F.ws + WS_MOD); bf16* XN = (bf16*)(F.ws + WS_XN);
    for (int m0 = 2 * gw; m0 < M; m0 += 2 * NGW) {
        f32x4 v[2][4]; float s[2];
#pragma unroll
        for (int q = 0; q < 2; ++q) { const GAS f32x4* xr = (const GAS f32x4*)(x + (size_t)(m0 + q) * D) + F.lane;
#pragma unroll
            for (int j = 0; j < 4; ++j) v[q][j] = xr[64 * j]; }
#pragma unroll
        for (int q = 0; q < 2; ++q) { s[q] = 0.f;
#pragma unroll
            for (int j = 0; j < 4; ++j) s[q] += (v[q][j].x * v[q][j].x + v[q][j].y * v[q][j].y) + (v[q][j].z * v[q][j].z + v[q][j].w * v[q][j].w); }
#pragma unroll
        for (int o = 1; o < 64; o <<= 1) { s[0] += __shfl_xor(s[0], o); s[1] += __shfl_xor(s[1], o); }
        const int b = m0 >> 11;
#pragma unroll
        for (int j = 0; j < 4; ++j) { const int c = 4 * F.lane + 256 * j;
            const f32x4 g = *(const f32x4*)(gain + c), sc = *(const f32x4*)(mod + b * 6144 + scale_off + c), sh = *(const f32x4*)(mod + b * 6144 + shift_off + c);
            const f32x4 gs = g * (sc + 1.0f);
#pragma unroll
            for (int q = 0; q < 2; ++q) { const float rs = 1.0f / sqrtf(s[q] * (1.f / D) + RMS_EPS);
                const f32x4 y = (v[q][j] * rs) * gs + sh;
                ((GAS unsigned long long*)(XN + (size_t)(m0 + q) * D) + F.lane)[64 * j] = (unsigned long long)pk2(y.x, y.y) | ((unsigned long long)pk2(y.z, y.w) << 32); } }
    }
}

__device__ __forceinline__ void fox_prep(Frame& F) {
    const int gw = F.vcu * NWAVES + F.wave, NGW = F.G * NWAVES; const bf16* P = (const bf16*)(F.ws + WS_P); bf16* QN = (bf16*)(F.ws + WS_QN); bf16* KN = (bf16*)(F.ws + WS_KN);
    const float* qg = F.in[I_QG]; const float* kg = F.in[I_KG];
    f32x4 gq0 = *(const f32x4*)(qg + 8 * F.lane), gq1 = *(const f32x4*)(qg + 8 * F.lane + 4), gk0 = *(const f32x4*)(kg + 8 * F.lane), gk1 = *(const f32x4*)(kg + 8 * F.lane + 4);
    const float C2 = 0.125f * LOG2E; float* LF = (float*)(F.ws + WS_CUM); const float fbias = F.in[I_FBIAS][F.lane & 7];
    for (int m = gw; m < M; m += NGW) {
        if (F.lane < 8) { const float z = bf2f(P[(size_t)m * NIN + PC_F + F.lane]) + fbias;
            const float lf = z < -30.f ? z * LOG2E : -__builtin_amdgcn_logf(1.0f + __builtin_amdgcn_exp2f(-LOG2E * z));
            LF[((size_t)(m >> 11) * FOXH + F.lane) * T + (m & (T - 1))] = lf; }
        const v4u qw = *(const GAS v4u*)(P + (size_t)m * NIN + PC_Q + 8 * F.lane), kw = *(const GAS v4u*)(P + (size_t)m * NIN + PC_K + 8 * F.lane);
        float q[8], k[8]; const unsigned qq[4] = {qw.x, qw.y, qw.z, qw.w}, kk[4] = {kw.x, kw.y, kw.z, kw.w};
        float sq = 0.f, sk = 0.f;
#pragma unroll
        for (int i = 0; i < 8; ++i) { q[i] = bf2f((unsigned short)(qq[i >> 1] >> (16 * (i & 1)))); k[i] = bf2f((unsigned short)(kk[i >> 1] >> (16 * (i & 1)))); sq += q[i] * q[i]; sk += k[i] * k[i]; }
        sq = red8(sq); sk = red8(sk);
        const float rq = C2 / sqrtf(sq * (1.f / 64.f) + RMS_EPS), rk = 1.0f / sqrtf(sk * (1.f / 64.f) + RMS_EPS);
        v4u oq, ok;
        oq.x = pk2(q[0] * rq * gq0.x, q[1] * rq * gq0.y); oq.y = pk2(q[2] * rq * gq0.z, q[3] * rq * gq0.w); oq.z = pk2(q[4] * rq * gq1.x, q[5] * rq * gq1.y); oq.w = pk2(q[6] * rq * gq1.z, q[7] * rq * gq1.w);
        ok.x = pk2(k[0] * rk * gk0.x, k[1] * rk * gk0.y); ok.y = pk2(k[2] * rk * gk0.z, k[3] * rk * gk0.w); ok.z = pk2(k[4] * rk * gk1.x, k[5] * rk * gk1.y); ok.w = pk2(k[6] * rk * gk1.z, k[7] * rk * gk1.w);
        *(GAS v4u*)(QN + (size_t)m * 512 + 8 * F.lane) = oq; *(GAS v4u*)(KN + (size_t)m * 512 + 8 * F.lane) = ok;
    }
}

namespace rwprep {
constexpr int ACT_ST = 592;
constexpr int LDT_ST = 2064, AT_ST = 1040;
constexpr int O_ACT = 0, O_LDT = 32 * ACT_ST, O_AT = O_LDT + 32 * LDT_ST, O_CST = O_AT + 32 * AT_ST, PRE_BYTES = O_CST + 6 * 2048;
static_assert(PRE_BYTES <= RING_BYTES, "pre-pass LDS");
__device__ __forceinline__ void up8(float (&o)[8], v4u w) { o[0] = bf2f((unsigned short)w.x); o[1] = bf2f((unsigned short)(w.x >> 16)); o[2] = bf2f((unsigned short)w.y); o[3] = bf2f((unsigned short)(w.y >> 16));
    o[4] = bf2f((unsigned short)w.z); o[5] = bf2f((unsigned short)(w.z >> 16)); o[6] = bf2f((unsigned short)w.w); o[7] = bf2f((unsigned short)(w.w >> 16)); }
__device__ __forceinline__ v4u pk8(const float (&x)[8]) { return (v4u){cvtpk(x[0], x[1]), cvtpk(x[2], x[3]), cvtpk(x[4], x[5]), cvtpk(x[6], x[7])}; }
__device__ __forceinline__ void run(Frame& F) {
    LAS unsigned char* L = F.lds + RING_OFF;
    const bf16* P = (const bf16*)(F.ws + WS_P); const float* mu = F.in[I_MU];
    unsigned char* IA = (unsigned char*)F.out; unsigned char* IB = IA + 32 * MiB; unsigned char* IK = IB + 32 * MiB; unsigned char* IR = IK + 32 * MiB;
    unsigned char* IV = F.ws + WS_XN; unsigned char* IG = IV + 32 * MiB; float* LCo = (float*)(F.ws + WS_SCR); float* BONo = LCo + 8192 * 64;
    const bf16* W2T = (const bf16*)(F.ws + WS_W2T); const bf16* A2T = (const bf16*)(F.ws + WS_A2T); const bf16* G2T = (const bf16*)(F.ws + WS_G2T);
    const int lane = F.lane, w = F.wave, hi = lane >> 5, r32 = lane & 31;
    const int rem = F.tid & 63, hd = rem >> 3, l8 = rem & 7, ch = hd * 64 + 8 * l8;
    { LAS float* cst = (LAS float*)(L + O_CST);
      cst[F.tid] = mu[F.tid]; cst[512 + F.tid] = mu[512 + F.tid]; cst[1024 + F.tid] = mu[1024 + F.tid]; cst[1536 + F.tid] = F.in[I_KK][F.tid]; cst[2048 + F.tid] = F.in[I_KA][F.tid]; cst[2560 + F.tid] = F.in[I_RK][F.tid]; }
    __syncthreads();
    for (int tile = F.vcu; tile < M / 32; tile += F.G) {
        const size_t row0 = (size_t)tile * 32; const int bb = tile >> 6, cc_ = tile & 63;
        { v4u ac[3], apv[3];
#pragma unroll
          for (int q = 0; q < 3; ++q) { const int g = F.tid + q * NWAVES * 64; if (g < 32 * 36) { const int t = g / 36, cg = g - 36 * t; const size_t row = row0 + t; const bool hp = (row & (T - 1)) != 0;
                const bf16* cp = P + row * NIN + PC_WDN + 8 * cg; ac[q] = *(const GAS v4u*)cp; apv[q] = *(const GAS v4u*)(cp - (hp ? NIN : 0)); if (!hp) apv[q] = (v4u){0u, 0u, 0u, 0u}; } }
#pragma unroll
          for (int q = 0; q < 3; ++q) { const int g = F.tid + q * NWAVES * 64; if (g < 32 * 36) { const int t = g / 36, cg = g - 36 * t;
                const f32x4 m0 = *(const f32x4*)(mu + 1536 + 8 * cg), m1 = *(const f32x4*)(mu + 1536 + 8 * cg + 4); const float mm[8] = {m0.x, m0.y, m0.z, m0.w, m1.x, m1.y, m1.z, m1.w};
                float xc[8], xp[8], x[8]; up8(xc, ac[q]); up8(xp, apv[q]);
#pragma unroll
                for (int i = 0; i < 8; ++i) x[i] = xc[i] + (xp[i] - xc[i]) * mm[i];
                if (cg < 8) {
#pragma unroll
                    for (int i = 0; i < 8; ++i) x[i] = tanhf_(x[i]);
                } else if (cg >= 16) {
#pragma unroll
                    for (int i = 0; i < 8; ++i) x[i] = sigmoidf_(x[i]);
                }
                *(LAS v4u*)(L + O_ACT + t * ACT_ST + 16 * cg) = pk8(x); } } }
        __syncthreads();
        {
            const LAS unsigned char* ap = L + O_ACT + r32 * ACT_ST + 16 * hi;
            unsigned char* gimg = IG + ((size_t)(bb * 8 + w) * 64 + cc_) * 4096 + r32 * 128;
            { f32x16 aw[2] = {{}, {}}, aa[2] = {{}, {}};
#pragma unroll
              for (int ks = 0; ks < 4; ++ks) { const bf16x8 fw = *(const LAS bf16x8*)(ap + 32 * ks), fa = *(const LAS bf16x8*)(ap + 128 + 32 * ks);
#pragma unroll
                  for (int cb = 0; cb < 2; ++cb) { const size_t c = 64 * w + 32 * cb + r32;
                      aw[cb] = __builtin_amdgcn_mfma_f32_32x32x16_bf16(*(const GAS bf16x8*)(W2T + c * 64 + 16 * ks + 8 * hi), fw, aw[cb], 0, 0, 0);
                      aa[cb] = __builtin_amdgcn_mfma_f32_32x32x16_bf16(*(const GAS bf16x8*)(A2T + c * 64 + 16 * ks + 8 * hi), fa, aa[cb], 0, 0, 0); } }
#pragma unroll
              for (int cb = 0; cb < 2; ++cb)
#pragma unroll
                  for (int g = 0; g < 4; ++g) { const int c = 64 * w + 32 * cb + 8 * g + 4 * hi;
                      const f32x4 w0 = *(const f32x4*)(F.in[I_W0] + c), a0 = *(const f32x4*)(F.in[I_A0] + c);
                      f32x4 ld; float ai[4];
#pragma unroll
                      for (int i = 0; i < 4; ++i) { ld[i] = -(0.6065306597126334f * LOG2E) * sigmoidf_(w0[i] + aw[cb][4 * g + i]); ai[i] = sigmoidf_(a0[i] + aa[cb][4 * g + i]); }
                      *(LAS f32x4*)(L + O_LDT + r32 * LDT_ST + c * 4) = ld;
                      *(LAS v2u*)(L + O_AT + r32 * AT_ST + c * 2) = (v2u){cvtpk(ai[0], ai[1]), cvtpk(ai[2], ai[3])}; } }
            { f32x16 ag[2] = {{}, {}};
#pragma unroll
              for (int ks = 0; ks < 10; ++ks) { const bf16x8 fg = *(const LAS bf16x8*)(ap + 256 + 32 * ks);
#pragma unroll
                  for (int cb = 0; cb < 2; ++cb) { const size_t c = 64 * w + 32 * cb + r32;
                      ag[cb] = __builtin_amdgcn_mfma_f32_32x32x16_bf16(*(const GAS bf16x8*)(G2T + c * 160 + 16 * ks + 8 * hi), fg, ag[cb], 0, 0, 0); } }
#pragma unroll
              for (int cb = 0; cb < 2; ++cb)
#pragma unroll
                  for (int g = 0; g < 4; ++g) { const int cl = 32 * cb + 8 * g + 4 * hi;
                      *(GAS v2u*)(gimg + cl * 2) = (v2u){cvtpk(ag[cb][4 * g], ag[cb][4 * g + 1]), cvtpk(ag[cb][4 * g + 2], ag[cb][4 * g + 3])}; } }
        }
        __syncthreads();
        { LAS float* col = (LAS float*)(L + O_LDT) + F.tid; float x[32];
#pragma unroll
          for (int t = 0; t < 32; ++t) x[t] = col[t * (LDT_ST / 4)];
#pragma unroll
          for (int t = 1; t < 32; ++t) x[t] += x[t - 1];
#pragma unroll
          for (int t = 1; t < 32; ++t) col[t * (LDT_ST / 4)] = x[t]; }
        __syncthreads();
        const size_t blob = (size_t)(bb * 8 + hd) * 64 + cc_;
        v4u gr[2][6];
#define PRE_LOAD(set_, p_) do { const int t_ = (F.tid >> 6) + 8 * (p_); const size_t row_ = row0 + t_; const bool hp_ = (row_ & (T - 1)) != 0; const bf16* pr_ = P + row_ * NIN + ch; const bf16* pp_ = pr_ - (hp_ ? NIN : 0); \
            gr[set_][0] = *(const GAS v4u*)(pr_ + PC_R); gr[set_][1] = *(const GAS v4u*)(pr_ + PC_RK); gr[set_][2] = *(const GAS v4u*)(pr_ + PC_RV); \
            gr[set_][3] = *(const GAS v4u*)(pp_ + PC_R); gr[set_][4] = *(const GAS v4u*)(pp_ + PC_RK); gr[set_][5] = *(const GAS v4u*)(pp_ + PC_RV); \
            if (!hp_) { gr[set_][3] = (v4u){0u, 0u, 0u, 0u}; gr[set_][4] = gr[set_][3]; gr[set_][5] = gr[set_][3]; } } while (0)
#define PRE_PASS(set_, p_) do { const int t = (F.tid >> 6) + 8 * (p_); \
            float rc[8], rp[8], kc[8], kp[8], vc[8], vp[8], ai[8]; \
            up8(rc, gr[set_][0]); up8(kc, gr[set_][1]); up8(vc, gr[set_][2]); up8(rp, gr[set_][3]); up8(kp, gr[set_][4]); up8(vp, gr[set_][5]); \
            up8(ai, *(const LAS v4u*)(L + O_AT + t * AT_ST + ch * 2)); \
            const LAS float* lrow = (const LAS float*)(L + O_LDT + t * LDT_ST) + ch; \
            const f32x4 l0 = *(const LAS f32x4*)lrow, l1 = *(const LAS f32x4*)(lrow + 4); \
            f32x4 q0 = (f32x4){0.f, 0.f, 0.f, 0.f}, q1 = q0; if (t > 0) { q0 = *(const LAS f32x4*)(lrow - LDT_ST / 4); q1 = *(const LAS f32x4*)(lrow - LDT_ST / 4 + 4); } \
            const float lam[8] = {l0.x, l0.y, l0.z, l0.w, l1.x, l1.y, l1.z, l1.w}, lamp[8] = {q0.x, q0.y, q0.z, q0.w, q1.x, q1.y, q1.z, q1.w}; \
            float r[8], k[8], v[8], kkv[8]; float ss = 0.f; float mur[8], muk[8], muv[8], ckk[8], cka[8], crk[8]; \
            { const LAS float* c_ = (const LAS float*)(L + O_CST) + ch; _Pragma("unroll") for (int q_ = 0; q_ < 2; ++q_) { const f32x4 a_ = *(const LAS f32x4*)(c_ + 4 * q_), b_ = *(const LAS f32x4*)(c_ + 512 + 4 * q_), cc2_ = *(const LAS f32x4*)(c_ + 1024 + 4 * q_), d_ = *(const LAS f32x4*)(c_ + 1536 + 4 * q_), e_ = *(const LAS f32x4*)(c_ + 2048 + 4 * q_), f_ = *(const LAS f32x4*)(c_ + 2560 + 4 * q_); \
                _Pragma("unroll") for (int i = 0; i < 4; ++i) { mur[4 * q_ + i] = a_[i]; muk[4 * q_ + i] = b_[i]; muv[4 * q_ + i] = cc2_[i]; ckk[4 * q_ + i] = d_[i]; cka[4 * q_ + i] = e_[i]; crk[4 * q_ + i] = f_[i]; } } } \
            _Pragma("unroll") for (int i = 0; i < 8; ++i) { r[i] = rc[i] + (rp[i] - rc[i]) * mur[i]; k[i] = kc[i] + (kp[i] - kc[i]) * muk[i]; v[i] = vc[i] + (vp[i] - vc[i]) * muv[i]; kkv[i] = k[i] * ckk[i]; ss += kkv[i] * kkv[i]; } \
            ss = red8(ss); const float inv = __builtin_amdgcn_rsqf(fmaxf(ss, L2_EPS * L2_EPS)); \
            float al[8], be[8], ka[8], rh[8]; float bon = 0.f; \
            _Pragma("unroll") for (int i = 0; i < 8; ++i) { const float kn = kkv[i] * inv, k2 = k[i] * (1.0f + (ai[i] - 1.0f) * cka[i]); bon += r[i] * k2 * crk[i]; \
                const float g_ = __builtin_amdgcn_exp2f(lam[i]), gi = __builtin_amdgcn_exp2f(-lam[i]), gm1 = __builtin_amdgcn_exp2f(lamp[i]); \
                al[i] = -kn * gm1; be[i] = kn * ai[i] * gi; ka[i] = k2 * gi; rh[i] = r[i] * g_; } \
            bon = red8(bon); \
            const size_t o = blob * 4096 + t * 128 + l8 * 16; \
            *(GAS v4u*)(IA + o) = pk8(al); *(GAS v4u*)(IB + o) = pk8(be); *(GAS v4u*)(IK + o) = pk8(ka); *(GAS v4u*)(IR + o) = pk8(rh); *(GAS v4u*)(IV + o) = pk8(v); \
            if (l8 == 0) BONo[blob * 32 + t] = bon; \
            if (t == 31) { *(GAS f32x4*)(LCo + blob * 64 + 8 * l8) = l0; *(GAS f32x4*)(LCo + blob * 64 + 8 * l8 + 4) = l1; } } while (0)
        PRE_LOAD(0, 0); PRE_LOAD(1, 1);
        PRE_PASS(0, 0); PRE_LOAD(0, 2);
        PRE_PASS(1, 1); PRE_LOAD(1, 3);
        PRE_PASS(0, 2);
        PRE_PASS(1, 3);
#undef PRE_LOAD
#undef PRE_PASS
    }
}
}

namespace rwkv {
constexpr int TC = 32, NCH = T / TC;
constexpr int SCM = 72;
constexpr int I_A = 0, I_B = 4096, I_K = 8192, I_R = 12288, I_V = 16384, I_BP = 20480, I_KP = 24576, IMG_BYTES = 28672;
constexpr int O_TM = 0;
constexpr int O_S0 = O_TM + 3 * 32 * SCM;
constexpr int O_YS = O_S0 + 2 * 64 * 136;
constexpr int O_NAB = O_YS + 2 * 4096;
constexpr int O_LC = O_NAB + 2 * 32 * 144;
constexpr int O_INV = O_LC + 1024;
constexpr int O_IMG = O_INV + 512;
constexpr int L_BYTES = O_IMG + 4 * IMG_BYTES;
static_assert(L_BYTES <= RING_BYTES, "scan LDS");
__device__ __forceinline__ int crow(int r, int hi) { return (r & 3) + 8 * (r >> 2) + 4 * hi; }
__device__ __forceinline__ int swz(int row, int chunk) { return row * 128 + ((chunk ^ ((row >> 1) & 7)) << 4); }
__device__ __forceinline__ bf16x8 ld_tok(const LAS unsigned char* base, int row, int ks, int h) { return *(const LAS bf16x8*)(base + swz(row, 2 * ks + h)); }
__device__ __forceinline__ bf16x8 ld_perm(const LAS unsigned char* base, int stride, int row, int s, int h) {
    const v2u lo = *(const LAS v2u*)(base + row * stride + (16 * s + 4 * h) * 2), hi2 = *(const LAS v2u*)(base + row * stride + (16 * s + 8 + 4 * h) * 2);
    return __builtin_bit_cast(bf16x8, (v4u){lo.x, lo.y, hi2.x, hi2.y});
}
typedef short v4i16_t __attribute__((ext_vector_type(4)));
__device__ __forceinline__ v2u tr4(const LAS unsigned char* img, int blk, int tok0, int lane) {
    const LAS unsigned char* p = img + swz(tok0 + ((lane & 15) >> 2), 4 * blk + 2 * ((lane >> 4) & 1) + ((lane & 3) >> 1)) + 8 * (lane & 1);
    return __builtin_bit_cast(v2u, __builtin_amdgcn_ds_read_tr16_b64_v4i16((LAS v4i16_t*)p));
}
__device__ __forceinline__ bf16x8 ld_tr(const LAS unsigned char* img, int blk, int s, int lane) {
    const int h = lane >> 5; const v2u lo = tr4(img, blk, 16 * s + 4 * h, lane), hi2 = tr4(img, blk, 16 * s + 8 + 4 * h, lane);
    return __builtin_bit_cast(bf16x8, (v4u){lo.x, lo.y, hi2.x, hi2.y});
}
__device__ __forceinline__ bf16x8 acc_frag(const f32x16& x, int s) {
    return __builtin_bit_cast(bf16x8, (v4u){cvtpk(x[8 * s], x[8 * s + 1]), cvtpk(x[8 * s + 2], x[8 * s + 3]), cvtpk(x[8 * s + 4], x[8 * s + 5]), cvtpk(x[8 * s + 6], x[8 * s + 7])});
}
#define RW_MFMA(a, b, c) __builtin_amdgcn_mfma_f32_32x32x16_bf16(a, b, c, 0, 0, 0)
__device__ __forceinline__ f32x16 gram(const LAS unsigned char* X, const LAS unsigned char* Y, int r32, int h) {
    f32x16 acc = {};
#pragma unroll
    for (int ks = 0; ks < 4; ++ks) acc = RW_MFMA(ld_tok(X, r32, ks, h), ld_tok(Y, r32, ks, h), acc);
    return acc;
}
__device__ __forceinline__ void unpack4(float (&o)[4], v2u w) { o[0] = bf2f((unsigned short)w.x); o[1] = bf2f((unsigned short)(w.x >> 16)); o[2] = bf2f((unsigned short)w.y); o[3] = bf2f((unsigned short)(w.y >> 16)); }

template <int QHI, int QLO>
__device__ __forceinline__ void invert_quads(float (&tmh)[16], const LAS unsigned char* nabs, LAS unsigned char* tmout, int lane) {
    const int hi = lane >> 5, r32 = lane & 31;
    const LAS unsigned char* nrow0 = nabs; const LAS unsigned char* nrowh = nabs + 16 * hi; LAS unsigned char* tmo = tmout + 2 * r32;
#pragma unroll
    for (int Q = QHI; Q >= QLO; --Q) {
        float part[4] = {0.f, 0.f, 0.f, 0.f}; f32x4 wq[4];
#pragma unroll
        for (int rr_ = 0; rr_ < 4; ++rr_) wq[rr_] = *(const LAS f32x4*)(nrow0 + (4 * Q + rr_) * 144 + 16 * Q);
#pragma unroll
        for (int pp = ((Q + 1) >> 1); pp < 4; pp += 2) {
            f32x4 nq[4][2];
#pragma unroll
            for (int rr_ = 0; rr_ < 4; ++rr_)
#pragma unroll
                for (int d = 0; d < 2; ++d) if (pp + d < 4) nq[rr_][d] = *(const LAS f32x4*)(nrowh + (4 * Q + rr_) * 144 + 32 * (pp + d));
            __builtin_amdgcn_sched_barrier(0);
#pragma unroll
            for (int d = 0; d < 2; ++d) if (pp + d < 4)
#pragma unroll
                for (int rr_ = 0; rr_ < 4; ++rr_) { const f32x4 n4 = nq[rr_][d]; const int p = pp + d;
                    part[rr_] = fmaf(n4.x, tmh[4 * p], part[rr_]); part[rr_] = fmaf(n4.y, tmh[4 * p + 1], part[rr_]); part[rr_] = fmaf(n4.z, tmh[4 * p + 2], part[rr_]); part[rr_] = fmaf(n4.w, tmh[4 * p + 3], part[rr_]); }
            __builtin_amdgcn_sched_barrier(0);
        }
        float tot[4];
#pragma unroll
        for (int rr_ = 0; rr_ < 4; ++rr_) { const auto sw = __builtin_amdgcn_permlane32_swap(__float_as_uint(part[rr_]), __float_as_uint(part[rr_]), false, false);
            tot[rr_] = __uint_as_float(sw[0]) + __uint_as_float(sw[1]) + ((r32 == 4 * Q + rr_) ? 1.f : 0.f); }
        tot[2] = fmaf(wq[2].w, tot[3], tot[2]);
        tot[1] = fmaf(wq[1].z, tot[2], fmaf(wq[1].w, tot[3], tot[1]));
        tot[0] = fmaf(wq[0].y, tot[1], fmaf(wq[0].z, tot[2], fmaf(wq[0].w, tot[3], tot[0])));
        const bool own = (hi == (Q & 1));
#pragma unroll
        for (int rr_ = 0; rr_ < 4; ++rr_) { const int idx = 4 * (Q >> 1) + rr_; tmh[idx] = own ? tot[rr_] : tmh[idx];
            *(LAS unsigned short*)(tmo + (4 * Q + rr_) * SCM) = (unsigned short)(cvtpk(tot[rr_], tot[rr_]) & 0xffffu); }
        asm volatile("" ::: "memory");
    }
}
__device__ __forceinline__ void invert_first(float (&tmh)[16], const LAS unsigned char* img, LAS unsigned char* nabs, LAS unsigned char* tmout, int lane) {
    const int hi = lane >> 5, r32 = lane & 31;
    { f32x16 nab = gram(img + I_B, img + I_A, r32, hi);
#pragma unroll
      for (int q = 0; q < 16; ++q) *(LAS float*)(nabs + crow(q, hi) * 144 + 4 * r32) = (crow(q, hi) < r32) ? nab[q] : 0.f; }
    asm volatile("s_waitcnt lgkmcnt(0)" ::: "memory");
#pragma unroll
    for (int i = 0; i < 16; ++i) tmh[i] = 0.f;
    invert_quads<7, 4>(tmh, nabs, tmout, lane);
}
__device__ __forceinline__ void invert_second(float (&tmh)[16], const LAS unsigned char* nabs, LAS unsigned char* tmout, int lane) { invert_quads<3, 0>(tmh, nabs, tmout, lane); }

__device__ __forceinline__ void unit(Frame& F, int b, int h, int probe) {
    LAS unsigned char* L = F.lds + RING_OFF;
    bf16* MIX = (bf16*)(F.ws + WS_MIX);
    const unsigned char* IA = (const unsigned char*)F.out; const unsigned char* IV = F.ws + WS_XN; const unsigned char* IG = IV + 32 * MiB;
    const float* LCi = (const float*)(F.ws + WS_SCR); const float* BONi = LCi + 8192 * 64;
    const int lane = F.lane, w = F.wave, hi = lane >> 5, r32 = lane & 31;
    const size_t rowbase = (size_t)b * T; const size_t blob0 = (size_t)(b * 8 + h) * 64;
    int te = F.tid >> 4, cq = F.tid & 15, c0 = h * 64 + 4 * cq;
    if (F.tid < 128) ((LAS float*)(L + O_INV))[F.tid] = (F.tid < 64 ? F.in[I_LNG] : F.in[I_LNB])[h * 64 + (F.tid & 63)];
    for (int i = F.tid; i < 2 * 64 * 136 / 4; i += NWAVES * 64) ((LAS unsigned*)(L + O_S0))[i] = 0u;
    const unsigned lds0 = (unsigned)(uintptr_t)(F.lds + RING_OFF);
#define RW_DMA(c_, set_) do { _Pragma("unroll") for (int j_ = w; j_ < 20; j_ += 8) { const int im_ = j_ >> 2, row_ = 8 * (j_ & 3) + (lane >> 3); \
        const unsigned char* src_ = (im_ < 4 ? IA + (size_t)im_ * (32 * MiB) : IV) + (blob0 + (c_)) * 4096 + row_ * 128 + (((lane & 7) ^ ((row_ >> 1) & 7)) << 4); \
        attn_body::glds16(src_, (unsigned)__builtin_amdgcn_readfirstlane(lds0 + O_IMG + (set_) * IMG_BYTES + im_ * 4096 + (j_ & 3) * 1024)); } } while (0)
#define RW_GEN(set_, lc4_) do { LAS unsigned char* is_ = L + O_IMG + (set_) * IMG_BYTES + swz(te, cq >> 1) + 8 * (cq & 1); float b4_[4], k4_[4]; unpack4(b4_, *(const LAS v2u*)(is_ + I_B)); unpack4(k4_, *(const LAS v2u*)(is_ + I_K)); \
        const float g0_ = __builtin_amdgcn_exp2f((lc4_).x), g1_ = __builtin_amdgcn_exp2f((lc4_).y), g2_ = __builtin_amdgcn_exp2f((lc4_).z), g3_ = __builtin_amdgcn_exp2f((lc4_).w); \
        *(LAS v2u*)(is_ + I_BP) = (v2u){cvtpk(b4_[0] * g0_, b4_[1] * g1_), cvtpk(b4_[2] * g2_, b4_[3] * g3_)}; *(LAS v2u*)(is_ + I_KP) = (v2u){cvtpk(k4_[0] * g0_, k4_[1] * g1_), cvtpk(k4_[2] * g2_, k4_[3] * g3_)}; \
        if (te == 0) *(LAS f32x4*)((LAS float*)(L + O_LC) + (set_) * 64 + 4 * cq) = (lc4_); } while (0)
    float tmh[16];
    RW_DMA(0, 0); RW_DMA(1, 1); RW_DMA(2, 2);
    f32x4 lcn = *(const GAS f32x4*)(LCi + blob0 * 64 + 4 * cq);
    asm volatile("s_waitcnt vmcnt(0)" ::: "memory");
    __syncthreads();
    RW_GEN(0, lcn);
    lcn = *(const GAS f32x4*)(LCi + (blob0 + 1) * 64 + 4 * cq);
    if (w == 0) { invert_first(tmh, L + O_IMG, L + O_NAB, L + O_TM, lane); invert_second(tmh, L + O_NAB, L + O_TM, lane); }
    else if (w == 3) invert_first(tmh, L + O_IMG + IMG_BYTES, L + O_NAB + 32 * 144, L + O_TM + 32 * SCM, lane);
    __syncthreads();
    v2u gst = (v2u){0u, 0u}, vst = (v2u){0u, 0u}; float bst = 0.f;
    int i3 = 0;
    for (int c = 0; c <= NCH; ++c) {
        const int pb = c & 1, nb = pb ^ 1; const int i3n = (i3 == 2) ? 0 : i3 + 1, i3nn = (i3n == 2) ? 0 : i3n + 1;
        asm volatile("" : "+v"(te), "+v"(cq));  c0 = h * 64 + 4 * cq;
        if (c > 0 && !(probe & 16)) {
            f32x4 y; { float y_[4]; unpack4(y_, *(const LAS v2u*)(L + O_YS + nb * 4096 + te * 128 + 8 * cq)); y = (f32x4){y_[0], y_[1], y_[2], y_[3]}; }
            const float mean = red16((y.x + y.y) + (y.z + y.w)) * (1.f / 64.f);
            const f32x4 dy = y - mean;
            const float var = red16((dy.x * dy.x + dy.y * dy.y) + (dy.z * dy.z + dy.w * dy.w)) * (1.f / 64.f);
            const float rstd = __builtin_amdgcn_rsqf(var + GN_EPS);
            float vv_[4], gg_[4]; unpack4(vv_, vst); unpack4(gg_, gst);
            const f32x4 lg4 = *(const LAS f32x4*)(L + O_INV + 16 * cq), lb4 = *(const LAS f32x4*)(L + O_INV + 256 + 16 * cq);
            const f32x4 o = ((dy * rstd) * lg4 + lb4 + (f32x4){vv_[0], vv_[1], vv_[2], vv_[3]} * bst) * (f32x4){gg_[0], gg_[1], gg_[2], gg_[3]};
            if (!(probe & 12)) *(GAS v2u*)(MIX + (rowbase + (c - 1) * TC + te) * 1024 + 512 + c0) = (v2u){cvtpk(o.x, o.y), cvtpk(o.z, o.w)};
        }
        if (c == NCH) break;
        if (c + 1 < NCH && !(probe & 16)) RW_GEN((c + 1) & 3, lcn);
        if (c + 3 < NCH && !(probe & 32)) RW_DMA(c + 3, (c + 3) & 3);
        { const size_t bl = blob0 + c;
          gst = *(const GAS v2u*)(IG + bl * 4096 + te * 128 + 8 * cq); vst = *(const GAS v2u*)(IV + bl * 4096 + te * 128 + 8 * cq); bst = BONi[bl * 32 + te];
          lcn = *(const GAS f32x4*)(LCi + (blob0 + (c + 2 < NCH ? c + 2 : c)) * 64 + 4 * cq); }
        const LAS unsigned char* img = L + O_IMG + (c & 3) * IMG_BYTES; const LAS unsigned char* tmc = L + O_TM + i3 * 32 * SCM;
        if ((w == 0 || w == 3) && (probe & 4)) {} else if (w == 0 || w == 3) {
            LAS unsigned char* nabw = L + O_NAB + (w == 3 ? 32 * 144 : 0);
            if ((w == 3) == ((c & 1) != 0)) { if (c + 2 < NCH) { asm volatile("s_waitcnt lgkmcnt(0)" ::: "memory"); invert_first(tmh, L + O_IMG + ((c + 2) & 3) * IMG_BYTES, nabw, L + O_TM + i3nn * 32 * SCM, lane); } }
            else { if (c + 1 < NCH) invert_second(tmh, nabw, L + O_TM + i3n * 32 * SCM, lane); }
        } else if ((w == 1 || w == 2) && !(probe & 8)) {
            const int vb = w - 1;
            f32x16 X = {};
            { f32x16 t1 = gram(img + I_B, img + I_R, r32, hi);
#pragma unroll
              for (int q = 0; q < 16; ++q) t1[q] = (crow(q, hi) <= r32) ? t1[q] : 0.f;
#pragma unroll
              for (int s_ = 0; s_ < 2; ++s_) X = RW_MFMA(ld_perm(tmc, SCM, r32, s_, hi), acc_frag(t1, s_), X); }
            f32x16 qy = gram(img + I_K, img + I_R, r32, hi);
            { f32x16 t2 = gram(img + I_A, img + I_K, r32, hi);
#pragma unroll
              for (int q = 0; q < 16; ++q) { const int cr_ = crow(q, hi); t2[q] = (r32 < cr_) ? t2[q] : 0.f; qy[q] = (cr_ <= r32) ? qy[q] : 0.f; }
#pragma unroll
              for (int s_ = 0; s_ < 2; ++s_) qy = RW_MFMA(acc_frag(t2, s_), acc_frag(X, s_), qy); }
            f32x16 y = {};
#pragma unroll
            for (int s_ = 0; s_ < 2; ++s_) y = RW_MFMA(ld_tr(img + I_V, vb, s_, lane), acc_frag(qy, s_), y);
#pragma unroll
            for (int kb = 0; kb < 2; ++kb) { f32x16 py;
#pragma unroll
                for (int g = 0; g < 4; ++g) { float c4[4]; unpack4(c4, *(const LAS v2u*)(img + I_R + swz(r32, 4 * kb + g) + 8 * hi)); py[4 * g] = c4[0]; py[4 * g + 1] = c4[1]; py[4 * g + 2] = c4[2]; py[4 * g + 3] = c4[3]; }
#pragma unroll
                for (int s_ = 0; s_ < 2; ++s_) py = RW_MFMA(ld_tr(img + I_A, kb, s_, lane), acc_frag(X, s_), py);
#pragma unroll
                for (int s_ = 0; s_ < 2; ++s_) y = RW_MFMA(ld_perm(L + O_S0 + pb * 64 * 136, 136, 32 * vb + r32, 2 * kb + s_, hi), acc_frag(py, s_), y); }
#pragma unroll
            for (int g = 0; g < 4; ++g) *(LAS v2u*)(L + O_YS + pb * 4096 + r32 * 128 + (32 * vb + 8 * g + 4 * hi) * 2) = (v2u){cvtpk(y[4 * g], y[4 * g + 1]), cvtpk(y[4 * g + 2], y[4 * g + 3])};
        } else if (w >= 4 && !(probe & 8)) {
            const int vb = (w >> 1) & 1, cb = w & 1;
            f32x16 Z = {};
#pragma unroll
            for (int s_ = 0; s_ < 2; ++s_) Z = RW_MFMA(ld_perm(tmc, SCM, r32, s_, hi), ld_tr(img + I_BP, cb, s_, lane), Z);
            f32x16 sres = {};
            { f32x16 hc;
#pragma unroll
              for (int g = 0; g < 4; ++g) { float c4[4]; unpack4(c4, tr4(img + I_KP, cb, 8 * g + 4 * hi, lane)); hc[4 * g] = c4[0]; hc[4 * g + 1] = c4[1]; hc[4 * g + 2] = c4[2]; hc[4 * g + 3] = c4[3]; }
              { f32x16 t2 = gram(img + I_A, img + I_K, r32, hi);
#pragma unroll
                for (int q = 0; q < 16; ++q) t2[q] = (r32 < crow(q, hi)) ? t2[q] : 0.f;
#pragma unroll
                for (int s_ = 0; s_ < 2; ++s_) hc = RW_MFMA(acc_frag(t2, s_), acc_frag(Z, s_), hc); }
#pragma unroll
              for (int s_ = 0; s_ < 2; ++s_) sres = RW_MFMA(ld_tr(img + I_V, vb, s_, lane), acc_frag(hc, s_), sres); }
            const float gC = __builtin_amdgcn_exp2f(((const LAS float*)(L + O_LC))[(c & 3) * 64 + 32 * cb + r32]);
#pragma unroll
            for (int kb = 0; kb < 2; ++kb) { f32x16 gc;
#pragma unroll
                for (int q = 0; q < 16; ++q) gc[q] = (kb == cb && crow(q, hi) == r32) ? gC : 0.f;
#pragma unroll
                for (int s_ = 0; s_ < 2; ++s_) gc = RW_MFMA(ld_tr(img + I_A, kb, s_, lane), acc_frag(Z, s_), gc);
#pragma unroll
                for (int s_ = 0; s_ < 2; ++s_) sres = RW_MFMA(ld_perm(L + O_S0 + pb * 64 * 136, 136, 32 * vb + r32, 2 * kb + s_, hi), acc_frag(gc, s_), sres); }
#pragma unroll
            for (int q = 0; q < 16; q += 2) { const unsigned pkd = cvtpk(sres[q], sres[q + 1]);
                *(LAS unsigned short*)(L + O_S0 + nb * 64 * 136 + (32 * vb + crow(q, hi)) * 136 + (32 * cb + r32) * 2) = (unsigned short)(pkd & 0xffffu);
                *(LAS unsigned short*)(L + O_S0 + nb * 64 * 136 + (32 * vb + crow(q + 1, hi)) * 136 + (32 * cb + r32) * 2) = (unsigned short)(pkd >> 16); }
        }
        i3 = i3n;
        asm volatile("s_waitcnt vmcnt(4)" ::: "memory");
        __syncthreads();
    }
#undef RW_DMA
#undef RW_GEN
#undef RW_MFMA
}
}

__device__ __forceinline__ void late_weights(Frame& F) {
    LAS float* scr = (LAS float*)(F.lds + RING_OFF + F.wave * 16384);
    bf16* WOUT = (bf16*)(F.ws + WS_WOUT); bf16* WGU = (bf16*)(F.ws + WS_WGU); bf16* WDN = (bf16*)(F.ws + WS_WDN);
    constexpr int I_O = (D / 64) * (D / 32), I_G = (D / 64) * (FF / 32), I_D = (FF / 64) * (D / 32), NITEMS = I_O + 2 * I_G + I_D;
    for (;;) {
        unsigned tk = 0; if (F.lane == 0) tk = __hip_atomic_fetch_add((unsigned*)(F.ctl + CW_LATE), 1u, __ATOMIC_RELAXED, __HIP_MEMORY_SCOPE_AGENT);
        int r = (int)__builtin_amdgcn_readfirstlane(tk); if (r >= NITEMS) break;
        if (r < I_O) { p0_transpose_item(F.in[I_WOUT], D, D, WOUT, D, RmId{}, scr, r, F.lane); continue; } r -= I_O;
        if (r < I_G) { p0_transpose_item(F.in[I_WG], D, FF, WGU, D, RmGate{0}, scr, r, F.lane); continue; } r -= I_G;
        if (r < I_G) { p0_transpose_item(F.in[I_WU], D, FF, WGU, D, RmGate{1}, scr, r, F.lane); continue; } r -= I_G;
        p0_transpose_item(F.in[I_WD], FF, D, WDN, FF, RmId{}, scr, r, F.lane);
    }
}
#ifndef PROBE_REP
#define PROBE_REP 0
#endif
#ifndef PROBE_SKIP
#define PROBE_SKIP 0
#endif
struct Args { const float* in[25]; float* out; unsigned char* ws; int ph_lo, ph_hi, li, pad; };
__global__ void __launch_bounds__(NWAVES * 64, 2) skel_fwd(Args args) {
    extern __shared__ __attribute__((aligned(16))) unsigned char lds[];
    Frame F;
    F.lds = (LAS unsigned char*)lds;
    F.MISC = (volatile LAS unsigned*)(F.lds + MISC_OFF);
    F.tid = threadIdx.x; F.lane = F.tid & 63; F.wave = __builtin_amdgcn_readfirstlane(F.tid >> 6);
    F.G = gridDim.x; { const int bx = blockIdx.x; F.vcu = (F.G % 8 == 0) ? (bx % 8) * (F.G / 8) + bx / 8 : bx; }
#define GRID_BAR(seam) do { if (N_LAUNCHES == PER_PHASE) { if (F.tid == 0) __hip_atomic_store(F.ctl + CW_TMO, 0xBADBA0u | (unsigned)(seam), RLX_AGENT); } \
    else { xcd_barrier(bar); } } while (0)
    unsigned char* ws = args.ws; F.ws = ws;
    F.ctl = (gu32*)(ws + WS_CTL);
#pragma unroll
    for (int i = 0; i < 25; ++i) F.in[i] = args.in[i];
    F.out = args.out;
    for (int u = F.tid; u < (LDS_BYTES - LDSCTL_OFF) / 4; u += NWAVES * 64) ((LAS unsigned*)(F.lds + LDSCTL_OFF))[u] = 0u;
    __syncthreads();
    XcdBarrier bar; bar.bar = (unsigned*)(F.ctl + CW_BAR); bar.x = 0; bar.st = nullptr;
    if (N_LAUNCHES != PER_PHASE) bar = xcd_barrier_post((unsigned*)(F.ctl + CW_BAR), F.MISC + 8);

    const int lo = args.ph_lo, hi = args.ph_hi;
#define IN(k) (lo <= (k) && (k) < hi)
#define BOTH(k) (IN(k) && IN((k) + 1))
    const float* modp = (const float*)(ws + WS_MOD);

    if (IN(0)) { p0_prologue(F); if (BOTH(0)) GRID_BAR(0); }
    if (IN(1)) { xn_pass(F, F.in[I_X], F.in[I_N1G], 0, 1024); if (BOTH(1)) GRID_BAR(1); }
    if (IN(2)) {
        pg8::Gemm g{(const bf16*)(ws + WS_XN), (const bf16*)(ws + WS_WIN), M, NIN, D}; pg8::StaticOrder S; S.init(M, NIN, F.G, (int)blockIdx.x);
        pg8::EpiBf16<0> E{(bf16*)(ws + WS_P), NIN, nullptr, 0, 0, 1.f};
        pg8::gemm_phase<pg8::EpiBf16<0>, pg8::StaticOrder, PG8_ALIGN, PG8_SP2>(F.lds + RING_OFF, g, S, E);
        if (BOTH(2)) GRID_BAR(2);
    }
    if (IN(3)) { fox_prep(F); rwprep::run(F); if (BOTH(3)) GRID_BAR(3); }
    if (IN(4)) {
        const int half = F.G >> 1, me = F.vcu >> 1;
        if ((F.vcu & 1) == 0 && F.vcu < 2 * half) { if (!(args.pad & 1))
            for (int bh = me; bh < BATCH * RWKVH; bh += half) rwkv::unit(F, bh >> 3, bh & 7, args.pad);
        } else if (F.vcu < 2 * half && !(args.pad & 2)) {
            static_assert(attn_body::ATTN_LDS_BYTES <= RING_BYTES, "attention LDS");
            const attn_body::AttnTensors AT{(const attn_body::bf16*)(ws + WS_QN), (const attn_body::bf16*)(ws + WS_KN), (const attn_body::bf16*)(ws + WS_P) + PC_V, (attn_body::bf16*)(ws + WS_MIX),
                                            (const float*)(ws + WS_CUM), (const float*)(ws + WS_LQ)};
            const attn_body::StaticOrder S(me, half);
            attn_body::attn_phase<attn_body::StaticOrder>((char*)lds + RING_OFF, AT, S);
        }
        __syncthreads(); late_weights(F);
        if (BOTH(4)) GRID_BAR(4);
    }
    if (IN(5)) {
        pg8::Gemm g{(const bf16*)(ws + WS_MIX), (const bf16*)(ws + WS_WOUT), M, D, D}; pg8::StaticOrder S; S.init(M, D, F.G, (int)blockIdx.x);
        pg8::EpiResGate E{F.in[I_X], F.out, modp + 2048, D, 6144};
        pg8::gemm_phase<pg8::EpiResGate, pg8::StaticOrder, PG8_ALIGN, PG8_SP2>(F.lds + RING_OFF, g, S, E);
        if (BOTH(5)) GRID_BAR(5);
    }
    if (IN(6)) { xn_pass(F, F.out, F.in[I_N2G], 3072, 4096); if (BOTH(6)) GRID_BAR(6); }
    if (IN(7)) {
        pg8::Gemm g{(const bf16*)(ws + WS_XN), (const bf16*)(ws + WS_WGU), M, NGU, D}; pg8::StaticOrder S; S.init(M, NGU, F.G, (int)blockIdx.x);
        pg8::EpiSwiGLU E{(bf16*)(ws + WS_HH), FF};
        pg8::gemm_phase<pg8::EpiSwiGLU, pg8::StaticOrder, PG8_ALIGN, PG8_SP2>(F.lds + RING_OFF, g, S, E);
        if (BOTH(7)) GRID_BAR(7);
    }
    if (IN(8)) {
        pg8::Gemm g{(const bf16*)(ws + WS_HH), (const bf16*)(ws + WS_WDN), M, D, FF}; pg8::StaticOrder S; S.init(M, D, F.G, (int)blockIdx.x);
        pg8::EpiResGate E{F.out, F.out, modp + 5120, D, 6144};
        pg8::gemm_phase<pg8::EpiResGate, pg8::StaticOrder, PG8_ALIGN, PG8_SP2>(F.lds + RING_OFF, g, S, E);
    }
#undef IN
#undef BOTH
}

extern "C" void kernel_launch(void* const* d_in, const int* in_sizes, int n_in, void* d_out, int out_size, void* d_ws, size_t ws_size, hipStream_t stream) {
    static int grid = 0;
    if (grid == 0) {
        if (n_in != 25 || in_sizes[0] != M * D || out_size != M * D || ws_size < WS_END) { fprintf(stderr, "kernel_launch: unexpected shapes (n_in %d, in0 %d, out %d, ws %zu); nothing launched\n", n_in, n_in > 0 ? in_sizes[0] : -1, out_size, ws_size); grid = -1; return; }
        int dev = 0, cus = 0, per_cu = 0;
        if (hipGetDevice(&dev) != hipSuccess || hipDeviceGetAttribute(&cus, hipDeviceAttributeMultiprocessorCount, dev) != hipSuccess) { fprintf(stderr, "kernel_launch: device query failed\n"); grid = -1; return; }
        if (hipFuncSetAttribute((const void*)skel_fwd, hipFuncAttributeMaxDynamicSharedMemorySize, LDS_BYTES) != hipSuccess) { fprintf(stderr, "kernel_launch: hipFuncSetAttribute failed\n"); grid = -1; return; }
        if (hipOccupancyMaxActiveBlocksPerMultiprocessor(&per_cu, (const void*)skel_fwd, NWAVES * 64, LDS_BYTES) != hipSuccess || per_cu < 1)
            fprintf(stderr, "kernel_launch: note: occupancy query reports %d workgroups per CU\n", per_cu);
        (void)hipGetLastError();
        grid = cus;
    }
    if (grid < 0) return;
    if (hipMemsetAsync((char*)d_ws + WS_CTL, 0, CTL_ZERO_BYTES, stream) != hipSuccess) { fprintf(stderr, "kernel_launch: hipMemsetAsync failed\n"); return; }
    Args a{};
    for (int i = 0; i < 25; ++i) a.in[i] = (const float*)d_in[i];
    a.out = (float*)d_out; a.ws = (unsigned char*)d_ws;
    for (int li = 0; li < N_LAUNCHES; ++li) {
        a.ph_lo = (N_LAUNCHES == PER_PHASE) ? li : 0; a.ph_hi = (N_LAUNCHES == PER_PHASE) ? li + 1 : PER_PHASE; a.li = li;
        hipLaunchKernelGGL(skel_fwd, dim3(grid), dim3(NWAVES * 64), LDS_BYTES, stream, a);
        if (N_LAUNCHES == PER_PHASE && ((PROBE_REP >> li) & 1)) { a.pad = PROBE_SKIP; hipLaunchKernelGGL(skel_fwd, dim3(grid), dim3(NWAVES * 64), LDS_BYTES, stream, a); a.pad = 0; }
        const hipError_t le = hipPeekAtLastError();
        if (le != hipSuccess) { fprintf(stderr, "kernel_launch: launch %d failed: %s\n", li, hipGetErrorName(le)); break; }
    }
}
```

```cpp
#define MK_N_LAUNCHES 1
#define PROBE_REP 0
#define PROBE_SKIP 0
#define PROBE_N 1
#include <hip/hip_runtime.h>
#include <cstdio>
#include <cstdint>
namespace pg8 {
#define PG8_LAS __attribute__((address_space(3)))
typedef unsigned short bf16_t;
typedef short bf16x8 __attribute__((ext_vector_type(8)));
typedef float f32x4 __attribute__((ext_vector_type(4)));
typedef unsigned u32x4 __attribute__((ext_vector_type(4)));
constexpr int BM = 256, BK = 64, HALF = 128, HTB = HALF * BK * 2  , STAGE_BYTES = 8 * HTB, NXCD = 8, WGM = 8;

__host__ __device__ __forceinline__ int lds_byte(int r, int c) { const int st = (r >> 4) * 2 + (c >> 5), rr = r & 15, cc = c & 31, ob = rr * 64 + cc * 2; return st * 1024 + (ob ^ (((ob >> 9) & 1) << 5)); }
__host__ __device__ __forceinline__ void stage_rc(int b, int& R, int& C) { const int st = b / 1024, sb = b % 1024, swz = sb ^ (((sb >> 9) & 1) << 5); R = (st >> 1) * 16 + swz / 64; C = (st & 1) * 32 + (swz % 64) / 2; }
__host__ __device__ __forceinline__ int perm32(int rho) { const int n = rho >> 4, i = rho & 15; return 8 * (i >> 2) + 4 * n + (i & 3); }

struct Unit { int pm, pn; };
struct Gemm { const bf16_t* A; const bf16_t* Bt; int M, N, K; };

struct StaticOrder {
    int nM, nN, nwg, G, c;
    __host__ __device__ void init(int M, int N, int G_, int c_) { nM = M / BM; nN = N / BM; nwg = nM * nN; G = G_; c = c_; }
    __host__ __device__ bool next(int i, Unit& u) const {
        const long L = (long)i * G + c; if (L >= nwg) return false;
        int wgid = (int)L; { const int q = nwg / NXCD, r = nwg % NXCD, xcd = wgid % NXCD, off = wgid / NXCD; wgid = (xcd < r ? xcd * (q + 1) : r * (q + 1) + (xcd - r) * q) + off; }
        const int nig = WGM * nN, gid = wgid / nig, fm = gid * WGM, gsz = (nM - fm) < WGM ? (nM - fm) : WGM;
        u.pm = fm + ((wgid % nig) % gsz); u.pn = (wgid % nig) / gsz; return true;
    }
    __device__ __forceinline__ void a_ready(const Unit&) const {}
    __device__ __forceinline__ void done(const Unit&) const {}
};

typedef float cvt_f2_t __attribute__((ext_vector_type(2))); typedef __bf16 cvt_b2_t __attribute__((ext_vector_type(2)));
__device__ __forceinline__ unsigned cvt_pk_bf16(float lo, float hi) { const cvt_f2_t v = {lo, hi}; const cvt_b2_t b = __builtin_convertvector(v, cvt_b2_t); return __builtin_bit_cast(unsigned, b); }
typedef float f32x2 __attribute__((ext_vector_type(2)));
__device__ __forceinline__ f32x2 gelu_pk(f32x2 v) {
    const f32x2 av = __builtin_elementwise_abs(v), d = av * 0.2316418882f + 1.0f;
    f32x2 t; t.x = __builtin_amdgcn_rcpf(d.x); t.y = __builtin_amdgcn_rcpf(d.y);
    f32x2 q = t * 0.5307027145f + (-0.7265760135f); q = q * t + 0.7107068705f; q = q * t + (-0.142248368f); q = q * t + 0.127414796f; q = q * t;
    const f32x2 s = (v * v) * (-0.72134752044f);
    f32x2 e; e.x = __builtin_amdgcn_exp2f(s.x); e.y = __builtin_amdgcn_exp2f(s.y);
    const f32x2 m = v * (q * e), r = v - m;
    f32x2 o; o.x = v.x < 0.f ? m.x : r.x; o.y = v.y < 0.f ? m.y : r.y; return o;
}

template <int ACT  > struct EpiBf16 {
    static constexpr bool PERM = true, AFTER_DRAIN = false; static_assert(ACT == 0 || ACT == 1, "EpiBf16: ACT is 0 (none) or 1 (gelu_pk)");
    bf16_t* O; int ldc; const float* bias; int split_cols; size_t split_stride; float scale0;
    __device__ __forceinline__ void operator()(const f32x4 (&acc)[2][2][4][2], const Unit& u, int wr, int wc, int fr, int fq) const {
        const int row0 = u.pm * BM + wr * 64 + fr; int colt = u.pn * BM; bf16_t* base = O;
        float sc = 1.f; if (split_cols) { const int t = colt / split_cols; base += (size_t)t * split_stride; colt -= t * split_cols; if (t == 0) sc = scale0; }
        const int col0 = colt + wc * 32 + 8 * fq, bcol0 = u.pn * BM + wc * 32 + 8 * fq;
        f32x4 bv[2][2];
#pragma unroll
        for (int bj = 0; bj < 2; ++bj)
#pragma unroll
            for (int n = 0; n < 2; ++n) bv[bj][n] = bias ? *(const f32x4*)(bias + bcol0 + bj * HALF + 4 * n) : (f32x4){0.f, 0.f, 0.f, 0.f};
#pragma unroll
        for (int ai = 0; ai < 2; ++ai)
#pragma unroll
            for (int m = 0; m < 4; ++m) { bf16_t* rowp = base + (size_t)(row0 + ai * HALF + m * 16) * ldc + col0;
#pragma unroll
                for (int bj = 0; bj < 2; ++bj) { f32x4 v0 = acc[ai][bj][m][0] + bv[bj][0], v1 = acc[ai][bj][m][1] + bv[bj][1];
                    if (ACT == 1) { f32x2 a = gelu_pk((f32x2){v0[0], v0[1]}), b = gelu_pk((f32x2){v0[2], v0[3]}), c = gelu_pk((f32x2){v1[0], v1[1]}), d = gelu_pk((f32x2){v1[2], v1[3]});
                        v0 = (f32x4){a.x, a.y, b.x, b.y}; v1 = (f32x4){c.x, c.y, d.x, d.y}; }
                    v0 = v0 * sc; v1 = v1 * sc; u32x4 w; w.x = cvt_pk_bf16(v0[0], v0[1]); w.y = cvt_pk_bf16(v0[2], v0[3]); w.z = cvt_pk_bf16(v1[0], v1[1]); w.w = cvt_pk_bf16(v1[2], v1[3]);
                    *(u32x4*)(rowp + bj * HALF) = w; } }
    }
};
template <bool BASE_BF, bool OUT_BF> struct EpiResGate {
    static constexpr bool PERM = true, AFTER_DRAIN = false;
    const void* base; void* out; const float* gate; int ldc; int gate_ld;
    __device__ __forceinline__ void operator()(const f32x4 (&acc)[2][2][4][2], const Unit& u, int wr, int wc, int fr, int fq) const {
        const int b = (u.pm * BM) >> 11; const float* g = gate + (size_t)b * gate_ld;
        const int col0 = u.pn * BM + wc * 32 + 8 * fq;
        f32x4 gv[2][2];
#pragma unroll
        for (int bj = 0; bj < 2; ++bj)
#pragma unroll
            for (int n = 0; n < 2; ++n) gv[bj][n] = *(const f32x4*)(g + col0 + bj * HALF + 4 * n);
        constexpr int NRAW = BASE_BF ? 2 : 4; u32x4 raw[2][NRAW];
        const size_t rowb = (size_t)(u.pm * BM + wr * 64 + fr) * ldc + col0;
#define ERG_LOAD(i_) do { const size_t off_ = rowb + (size_t)(((i_) >> 2) * HALF + ((i_) & 3) * 16) * ldc; _Pragma("unroll") for (int bj = 0; bj < 2; ++bj) { \
            if (BASE_BF) raw[(i_) & 1][bj] = *(const u32x4*)((const bf16_t*)base + off_ + bj * HALF); \
            else { raw[(i_) & 1][2 * bj] = *(const u32x4*)((const float*)base + off_ + bj * HALF); raw[(i_) & 1][2 * bj + 1] = *(const u32x4*)((const float*)base + off_ + bj * HALF + 4); } } } while (0)
        ERG_LOAD(0);
#pragma unroll
        for (int i = 0; i < 8; ++i) { const int ai = i >> 2, m = i & 3; const size_t off = rowb + (size_t)(ai * HALF + m * 16) * ldc;
            if (i + 1 < 8) ERG_LOAD(i + 1);
            __builtin_amdgcn_sched_barrier(0);
#pragma unroll
            for (int bj = 0; bj < 2; ++bj) { f32x4 b0, b1;
                if (BASE_BF) { const u32x4 r = raw[i & 1][bj];
                    b0 = (f32x4){__builtin_bit_cast(float, r.x << 16), __builtin_bit_cast(float, r.x & 0xffff0000u), __builtin_bit_cast(float, r.y << 16), __builtin_bit_cast(float, r.y & 0xffff0000u)};
                    b1 = (f32x4){__builtin_bit_cast(float, r.z << 16), __builtin_bit_cast(float, r.z & 0xffff0000u), __builtin_bit_cast(float, r.w << 16), __builtin_bit_cast(float, r.w & 0xffff0000u)}; }
                else { b0 = __builtin_bit_cast(f32x4, raw[i & 1][2 * bj]); b1 = __builtin_bit_cast(f32x4, raw[i & 1][2 * bj + 1]); }
                const f32x4 o0 = b0 + gv[bj][0] * acc[ai][bj][m][0], o1 = b1 + gv[bj][1] * acc[ai][bj][m][1];
                if (OUT_BF) { u32x4 w; w.x = cvt_pk_bf16(o0[0], o0[1]); w.y = cvt_pk_bf16(o0[2], o0[3]); w.z = cvt_pk_bf16(o1[0], o1[1]); w.w = cvt_pk_bf16(o1[2], o1[3]); *(u32x4*)((bf16_t*)out + off + bj * HALF) = w; }
                else { *(f32x4*)((float*)out + off + bj * HALF) = o0; *(f32x4*)((float*)out + off + bj * HALF + 4) = o1; } }
            __builtin_amdgcn_sched_barrier(0); }
#undef ERG_LOAD
    }
};
struct EpiSwiGLU {
    static constexpr bool PERM = true, AFTER_DRAIN = false;
    bf16_t* O; int ldc;
    __device__ __forceinline__ void operator()(const f32x4 (&acc)[2][2][4][2], const Unit& u, int wr, int wc, int fr, int fq) const {
        const int row0 = u.pm * BM + wr * 64 + fr, col0 = u.pn * HALF + wc * 32 + 8 * fq;
#pragma unroll
        for (int ai = 0; ai < 2; ++ai)
#pragma unroll
            for (int m = 0; m < 4; ++m) { bf16_t* rowp = O + (size_t)(row0 + ai * HALF + m * 16) * ldc + col0;
                float hv[8];
#pragma unroll
                for (int n = 0; n < 2; ++n)
#pragma unroll
                    for (int i = 0; i < 4; ++i) { const float g = acc[ai][0][m][n][i], up = acc[ai][1][m][n][i];
                        const float sg = g * __builtin_amdgcn_rcpf(1.0f + __builtin_amdgcn_exp2f(-1.4426950408889634f * g)); hv[4 * n + i] = sg * up; }
                u32x4 w; w.x = cvt_pk_bf16(hv[0], hv[1]); w.y = cvt_pk_bf16(hv[2], hv[3]); w.z = cvt_pk_bf16(hv[4], hv[5]); w.w = cvt_pk_bf16(hv[6], hv[7]);
                *(u32x4*)rowp = w; }
    }
};

template <class Epi, class Sched, bool ALIGN_EPI = false, bool SP2 = false>
__device__ __forceinline__ void gemm_phase(PG8_LAS unsigned char* lds, const Gemm g, const Sched& S, const Epi& E) {
    const int tid = threadIdx.x, wid = __builtin_amdgcn_readfirstlane(tid >> 6), lane = tid & 63, wr = wid >> 2, wc = wid & 3, fr = lane & 15, fq = lane >> 4;
    const int K = g.K, nt = K / BK;
    unsigned voffA[2], voffB[2];
#pragma unroll
    for (int i = 0; i < 2; ++i) { int R, C; stage_rc(tid * 16 + i * 8192, R, C); const int Rb = Epi::PERM ? ((R & ~31) + perm32(R & 31)) : R;
        voffA[i] = (unsigned)(R * K + C) * 2u; voffB[i] = (unsigned)(Rb * K + C) * 2u; }
    const size_t kstep = (size_t)(BK * 2);
    const size_t hstep = (size_t)HALF * K * 2;
    const size_t tstep = 2 * hstep;
    const unsigned ldsw = (unsigned)wid * 1024u;
    const int aoff = lds_byte(wr * 64 + fr, fq * 8), boff = lds_byte(wc * 32 + fr, fq * 8);
#define PG8_SA(b, h) (((b) * 2 + (h)) * HTB)
#define PG8_SB(b, h) ((4 + (b) * 2 + (h)) * HTB)
#define PG8_STAGE(bufoff, gbase, voff) do { _Pragma("unroll") for (int _i = 0; _i < 2; ++_i) \
        __builtin_amdgcn_global_load_lds((const unsigned*)((const char*)(gbase) + (voff)[_i]), (PG8_LAS unsigned*)(lds + (bufoff) + ldsw + _i * 8192), 16, 0, 0); } while (0)
#define PG8_LDA(dst, b, h) do { _Pragma("unroll") for (int m = 0; m < 4; ++m) _Pragma("unroll") for (int k = 0; k < 2; ++k) dst[m][k] = *(const PG8_LAS bf16x8*)(lds + PG8_SA(b, h) + aoff + m * 2048 + k * 1024); } while (0)
#define PG8_LDB(dst, b, h) do { _Pragma("unroll") for (int n = 0; n < 2; ++n) _Pragma("unroll") for (int k = 0; k < 2; ++k) dst[n][k] = *(const PG8_LAS bf16x8*)(lds + PG8_SB(b, h) + boff + n * 2048 + k * 1024); } while (0)
#define PG8_MMA(ai, bj, At, Bt) do { __builtin_amdgcn_s_setprio(1); _Pragma("unroll") for (int m = 0; m < 4; ++m) _Pragma("unroll") for (int n = 0; n < 2; ++n) _Pragma("unroll") for (int k = 0; k < 2; ++k) \
        acc[ai][bj][m][n] = __builtin_amdgcn_mfma_f32_16x16x32_bf16(Bt[n][k], At[m][k], acc[ai][bj][m][n], 0, 0, 0); __builtin_amdgcn_s_setprio(0); } while (0)
#define PG8_WAIT_V(n) asm volatile("s_waitcnt vmcnt(" #n ")" ::: "memory")
#define PG8_WAIT_L(n) asm volatile("s_waitcnt lgkmcnt(" #n ")" ::: "memory")
#define PG8_BAR __builtin_amdgcn_s_barrier()
#define PG8_SCHED __builtin_amdgcn_sched_barrier(0)
    Unit cur, nxt; int ui = 0;
    if (!S.next(0, cur)) return;
    f32x4 acc[2][2][4][2];
#pragma unroll
    for (int a = 0; a < 2; ++a)
#pragma unroll
        for (int b = 0; b < 2; ++b)
#pragma unroll
            for (int m = 0; m < 4; ++m)
#pragma unroll
                for (int n = 0; n < 2; ++n) acc[a][b][m][n] = (f32x4){0.f, 0.f, 0.f, 0.f};
    bf16x8 At[4][2], B0[2][2], B1[2][2];
    const char* cA = (const char*)g.A + (size_t)cur.pm * tstep; const char* cB = (const char*)g.Bt + (size_t)cur.pn * tstep;
    S.a_ready(cur);
    if constexpr (SP2) {
        PG8_STAGE(PG8_SB(0, 0), cB, voffB); PG8_STAGE(PG8_SB(0, 1), cB + hstep, voffB); PG8_STAGE(PG8_SA(0, 0), cA, voffA); PG8_STAGE(PG8_SA(0, 1), cA + hstep, voffA);
        if (wr == 1) PG8_BAR;
        PG8_WAIT_V(2); PG8_BAR;
        PG8_STAGE(PG8_SB(1, 0), cB + kstep, voffB); PG8_STAGE(PG8_SA(1, 0), cA + kstep, voffA); PG8_STAGE(PG8_SB(1, 1), cB + hstep + kstep, voffB);
        PG8_WAIT_V(6); PG8_BAR;
    } else {
        PG8_STAGE(PG8_SB(0, 0), cB, voffB); PG8_STAGE(PG8_SA(0, 0), cA, voffA); PG8_STAGE(PG8_SB(0, 1), cB + hstep, voffB); PG8_STAGE(PG8_SA(0, 1), cA + hstep, voffA);
        if (wr == 1) PG8_BAR;
        PG8_WAIT_V(4); PG8_BAR;
        PG8_STAGE(PG8_SB(1, 0), cB + kstep, voffB); PG8_STAGE(PG8_SA(1, 0), cA + kstep, voffA); PG8_STAGE(PG8_SB(1, 1), cB + hstep + kstep, voffB);
        PG8_WAIT_V(6); PG8_BAR;
    }
    for (;;) {
        const bool has_next = S.next(ui + 1, nxt);
        const char* nA = has_next ? (const char*)g.A + (size_t)nxt.pm * tstep : cA; const char* nB = has_next ? (const char*)g.Bt + (size_t)nxt.pn * tstep : cB;
        asm volatile(".p2align 7\n\ts_nop 0\n\ts_nop 0");
        for (int t = 0; t < nt; t += 2) {
            const bool last = (t == nt - 2);
            const char* a1 = cA + (size_t)(t + 1) * kstep;
            const char* a2 = last ? nA : cA + (size_t)(t + 2) * kstep; const char* b2 = last ? nB : cB + (size_t)(t + 2) * kstep;
            const char* a3 = a2 + kstep; const char* b3 = b2 + kstep;
            if (last && has_next) S.a_ready(nxt);
            if constexpr (SP2) {
            PG8_LDB(B0, 0, 0); PG8_LDB(B1, 0, 1); PG8_SCHED; PG8_LDA(At, 0, 0); PG8_STAGE(PG8_SA(1, 1), a1 + hstep, voffA);
            PG8_WAIT_V(8); PG8_WAIT_L(0); PG8_BAR; PG8_MMA(0, 0, At, B0); PG8_MMA(0, 1, At, B1); PG8_BAR; PG8_SCHED;
            PG8_LDA(At, 0, 1); PG8_STAGE(PG8_SB(0, 0), b2, voffB); PG8_STAGE(PG8_SB(0, 1), b2 + hstep, voffB); PG8_STAGE(PG8_SA(0, 0), a2, voffA);
            PG8_WAIT_V(8); PG8_WAIT_L(0); PG8_BAR; PG8_MMA(1, 0, At, B0); PG8_MMA(1, 1, At, B1); PG8_BAR; PG8_SCHED;
            PG8_LDB(B0, 1, 0); PG8_LDB(B1, 1, 1); PG8_SCHED; PG8_LDA(At, 1, 0); PG8_STAGE(PG8_SA(0, 1), a2 + hstep, voffA);
            PG8_WAIT_V(8); PG8_WAIT_L(0); PG8_BAR; PG8_MMA(0, 0, At, B0); PG8_MMA(0, 1, At, B1); PG8_BAR; PG8_SCHED;
            PG8_LDA(At, 1, 1); PG8_STAGE(PG8_SB(1, 0), b3, voffB); PG8_STAGE(PG8_SB(1, 1), b3 + hstep, voffB); PG8_STAGE(PG8_SA(1, 0), a3, voffA);
            PG8_WAIT_V(8); PG8_WAIT_L(0); PG8_BAR; PG8_MMA(1, 0, At, B0); PG8_MMA(1, 1, At, B1); PG8_BAR; PG8_SCHED;
            } else {
            PG8_LDB(B0, 0, 0); PG8_SCHED; PG8_LDA(At, 0, 0); PG8_STAGE(PG8_SA(1, 1), a1 + hstep, voffA);
            PG8_WAIT_L(8); PG8_BAR; PG8_WAIT_L(0); PG8_MMA(0, 0, At, B0); PG8_BAR; PG8_SCHED;
            PG8_LDB(B1, 0, 1); PG8_STAGE(PG8_SB(0, 0), b2, voffB);
            PG8_BAR; PG8_WAIT_L(0); PG8_MMA(0, 1, At, B1); PG8_BAR;
            PG8_LDA(At, 0, 1); PG8_STAGE(PG8_SA(0, 0), a2, voffA);
            PG8_BAR; PG8_WAIT_L(0); PG8_MMA(1, 0, At, B0); PG8_BAR; PG8_SCHED;
            PG8_STAGE(PG8_SB(0, 1), b2 + hstep, voffB);
            PG8_WAIT_V(6); PG8_BAR; PG8_MMA(1, 1, At, B1); PG8_BAR;
            PG8_LDB(B0, 1, 0); PG8_SCHED; PG8_LDA(At, 1, 0); PG8_STAGE(PG8_SA(0, 1), a2 + hstep, voffA);
            PG8_WAIT_L(8); PG8_BAR; PG8_WAIT_L(0); PG8_MMA(0, 0, At, B0); PG8_BAR; PG8_SCHED;
            PG8_LDB(B1, 1, 1); PG8_STAGE(PG8_SB(1, 0), b3, voffB);
            PG8_BAR; PG8_WAIT_L(0); PG8_MMA(0, 1, At, B1); PG8_BAR;
            PG8_LDA(At, 1, 1); PG8_STAGE(PG8_SA(1, 0), a3, voffA);
            PG8_BAR; PG8_WAIT_L(0); PG8_MMA(1, 0, At, B0); PG8_BAR; PG8_SCHED;
            PG8_STAGE(PG8_SB(1, 1), b3 + hstep, voffB);
            PG8_WAIT_V(6); PG8_BAR; PG8_MMA(1, 1, At, B1); PG8_BAR;
            }
        }
        if constexpr (ALIGN_EPI) { if (wr == 0) PG8_BAR; }
        if constexpr (!Epi::AFTER_DRAIN) { E(acc, cur, wr, wc, fr, fq); S.done(cur); }
        if (!has_next) break;
#pragma unroll
        for (int a = 0; a < 2; ++a)
#pragma unroll
            for (int b = 0; b < 2; ++b)
#pragma unroll
                for (int m = 0; m < 4; ++m)
#pragma unroll
                    for (int n = 0; n < 2; ++n) acc[a][b][m][n] = (f32x4){0.f, 0.f, 0.f, 0.f};
        cur = nxt; cA = nA; cB = nB; ++ui;
        if constexpr (ALIGN_EPI) { if (wr == 1) PG8_BAR; }
    }
    PG8_WAIT_V(0);
    if constexpr (!ALIGN_EPI) { if (wr == 0) PG8_BAR; }
    PG8_BAR;
    if constexpr (Epi::AFTER_DRAIN) { E.fused(acc, cur, wr, wc, fr, fq, lds, wid, lane); S.done(cur); }
#undef PG8_SA
#undef PG8_SB
#undef PG8_STAGE
#undef PG8_LDA
#undef PG8_LDB
#undef PG8_MMA
#undef PG8_WAIT_V
#undef PG8_WAIT_L
#undef PG8_BAR
#undef PG8_SCHED
}
}

#ifndef PG8_SP2
#define PG8_SP2 true
#endif
#ifndef PG8_ALIGN
#define PG8_ALIGN true
#endif
#include <hip/hip_bf16.h>
#include <cmath>
namespace attn_body {
using bf16=__hip_bfloat16;
using bf16x8=__attribute__((ext_vector_type(8)))short;
using s16x4=__attribute__((ext_vector_type(4)))short;
using f32x16=__attribute__((ext_vector_type(16)))float;
using u32x4=__attribute__((ext_vector_type(4)))unsigned;
using f32x4_t=__attribute__((ext_vector_type(4)))float;
constexpr int BATCH=16,NHEAD=8,SEQ=2048,D=64;
constexpr int QP=512,KP=512,VP=3584,OP=1024;
constexpr int NW=8,QBLK=32,QB=QBLK*NW,KVBLK=64,NQB=SEQ/QB;
constexpr int ATTN_UNIT_ROWS=QB;
__device__ __forceinline__ int crow(int r,int hi){return (r&3)+8*(r>>2)+4*hi;}
#define SBAR() __builtin_amdgcn_sched_barrier(0)
__device__ __forceinline__ void cmask(f32x16&p0,f32x16&p1,int jb,int qrel,int hi){
  const float NEG=-INFINITY; int kb=64*jb+4*hi;
  #pragma unroll
  for(int r=0;r<16;++r){int kv=kb+(r&3)+8*(r>>2); if(kv>qrel)p0[r]=NEG; if(kv+32>qrel)p1[r]=NEG;}
}

constexpr int NSLOT=3, SLOTB=8192;
constexpr int LDS_K=0, LDS_V=NSLOT*SLOTB, LDS_WS=2*NSLOT*SLOTB, LDS_OST=LDS_WS+NW*64*4, LDS_KB=LDS_OST+NW*4096, LDS_CUM=LDS_KB+SEQ*4, LDS_WSUM=LDS_CUM+SEQ*4, LDS_BYTES=LDS_WSUM+64;
constexpr float C2=0.125f*1.4426950408889634f;
__device__ __forceinline__ void glds16(const void*gsrc,unsigned lds_dst){unsigned keep;
  asm volatile("s_mov_b32 %0, m0\n\ts_mov_b32 m0, %2\n\ts_nop 0\n\tglobal_load_lds_dwordx4 %1, off\n\ts_mov_b32 m0, %0":"=&s"(keep):"v"(gsrc),"s"(lds_dst):"memory");}
__device__ __forceinline__ float max3f(float a,float b,float c){float r;asm("v_max3_f32 %0, %1, %2, %3":"=v"(r):"v"(a),"v"(b),"v"(c));return r;}
__device__ __forceinline__ float max2f(float a,float b){float r;asm("v_max_f32_e32 %0, %1, %2":"=v"(r):"v"(a),"v"(b));return r;}
__device__ __forceinline__ float fadd_s(float a,float b){float r;asm("v_add_f32_e32 %0, %1, %2":"=v"(r):"v"(a),"v"(b));return r;}
__device__ __forceinline__ float fsub_s(float a,float b){float r;asm("v_sub_f32_e32 %0, %1, %2":"=v"(r):"v"(a),"v"(b));return r;}
typedef float f32x2_t __attribute__((ext_vector_type(2))); typedef __bf16 bf16x2_t __attribute__((ext_vector_type(2)));
__device__ __forceinline__ unsigned cvtpk_s(float lo,float hi){f32x2_t v={lo,hi};bf16x2_t b=__builtin_convertvector(v,bf16x2_t);return __builtin_bit_cast(unsigned,b);}
#define WAIT_BAR(N) asm volatile("s_waitcnt vmcnt(" #N ") lgkmcnt(0)\n\ts_barrier":::"memory")

__device__ __forceinline__ void qkt(f32x16&p0,f32x16&p1,const char*Kslot,const bf16x8*qr,const f32x16&negm,int r32,int hi,bf16x8 kb0,bf16x8 kb1,bf16x8 qone){
  p0=__builtin_amdgcn_mfma_f32_32x32x16_bf16(kb0,qone,negm,0,0,0);p1=__builtin_amdgcn_mfma_f32_32x32x16_bf16(kb1,qone,negm,0,0,0);
  const char*kb=Kslot+hi*1024+r32*16;
  #pragma unroll
  for(int d0=0;d0<4;++d0){
    const bf16x8 b0=*reinterpret_cast<const bf16x8*>(kb+d0*2048);
    const bf16x8 b1=*reinterpret_cast<const bf16x8*>(kb+d0*2048+512);
    p0=__builtin_amdgcn_mfma_f32_32x32x16_bf16(b0,qr[d0],p0,0,0,0);p1=__builtin_amdgcn_mfma_f32_32x32x16_bf16(b1,qr[d0],p1,0,0,0);}
}
typedef __attribute__((address_space(3))) const char* lds_cptr;
typedef short v4i16_t __attribute__((ext_vector_type(4)));
__device__ __forceinline__ void kload8(bf16x8*kf,lds_cptr kp){
  kf[0]=*(const __attribute__((address_space(3))) bf16x8*)(kp);      kf[1]=*(const __attribute__((address_space(3))) bf16x8*)(kp+512);
  kf[2]=*(const __attribute__((address_space(3))) bf16x8*)(kp+2048); kf[3]=*(const __attribute__((address_space(3))) bf16x8*)(kp+2560);
  kf[4]=*(const __attribute__((address_space(3))) bf16x8*)(kp+4096); kf[5]=*(const __attribute__((address_space(3))) bf16x8*)(kp+4608);
  kf[6]=*(const __attribute__((address_space(3))) bf16x8*)(kp+6144); kf[7]=*(const __attribute__((address_space(3))) bf16x8*)(kp+6656);
}
__device__ __forceinline__ void kload2(bf16x8*kf,lds_cptr kp,int j){ kf[2*j]=*(const __attribute__((address_space(3))) bf16x8*)(kp+j*2048); kf[2*j+1]=*(const __attribute__((address_space(3))) bf16x8*)(kp+j*2048+512); }
__device__ __forceinline__ s16x4 vtr(lds_cptr p){ return __builtin_bit_cast(s16x4,__builtin_amdgcn_ds_read_tr16_b64_v4i16((__attribute__((address_space(3))) v4i16_t*)p)); }
__device__ __forceinline__ float rowmax(const f32x16&p0,const f32x16&p1){
  float a=max3f(p0[0],p0[1],p1[0]),b=max3f(p0[2],p0[3],p1[1]);a=max3f(a,p1[2],p1[3]);
  #pragma unroll
  for(int r=4;r<16;r+=4){a=max3f(a,p0[r],p0[r+1]);b=max3f(b,p0[r+2],p0[r+3]);a=max3f(a,p1[r],p1[r+1]);b=max3f(b,p1[r+2],p1[r+3]);}
  const float m=max2f(a,b);
  auto rr=__builtin_amdgcn_permlane32_swap(__float_as_uint(m),__float_as_uint(m),false,false);
  return max2f(__uint_as_float(rr[0]),__uint_as_float(rr[1]));
}
__device__ __forceinline__ void pv(f32x16*o,int vb,bf16x8 pa0,bf16x8 pa1,bf16x8 pa2,bf16x8 pa3){
  #pragma unroll
  for(int d0=0;d0<2;++d0){s16x4 lo[4],hi[4];
    #pragma unroll
    for(int ks=0;ks<4;++ks){
      asm volatile("ds_read_b64_tr_b16 %0,%1 offset:%c2":"=&v"(lo[ks]):"v"(vb),"i"(d0*4096+ks*1024):"memory");
      asm volatile("ds_read_b64_tr_b16 %0,%1 offset:%c2":"=&v"(hi[ks]):"v"(vb),"i"(d0*4096+ks*1024+512):"memory");}
    asm volatile("s_waitcnt lgkmcnt(0)":::"memory");SBAR();
    #define PK(k) (bf16x8){lo[k][0],lo[k][1],lo[k][2],lo[k][3],hi[k][0],hi[k][1],hi[k][2],hi[k][3]}
    o[d0]=__builtin_amdgcn_mfma_f32_32x32x16_bf16(pa0,PK(0),o[d0],0,0,0);
    o[d0]=__builtin_amdgcn_mfma_f32_32x32x16_bf16(pa1,PK(1),o[d0],0,0,0);
    o[d0]=__builtin_amdgcn_mfma_f32_32x32x16_bf16(pa2,PK(2),o[d0],0,0,0);
    o[d0]=__builtin_amdgcn_mfma_f32_32x32x16_bf16(pa3,PK(3),o[d0],0,0,0);
    #undef PK
  }
}

#ifndef ATTN_STORE16
#define ATTN_STORE16(p,v) (*(u32x4*)(p)=(v))
#endif
template<int THRL> __device__ __forceinline__ void attn_unit(int b,int h,int qb,const bf16*Q,const bf16*__restrict__ K,const bf16*__restrict__ V,bf16*O,const float*Cum,const float*Lq,bool newbh,char*shm){
  const int tid=threadIdx.x,lane=tid&63,r32=lane&31,hi=lane>>5; const int wid=__builtin_amdgcn_readfirstlane(tid>>6);
  const long rowbase=(long)b*SEQ; const int q0=qb*QB;
  const bf16*Qw=Q+(rowbase+q0+wid*QBLK)*QP+h*D;
  const bf16*Kh=K+rowbase*KP+h*D,*Vh=V+rowbase*VP+h*D;
  const unsigned lds0=(unsigned)(uintptr_t)shm;
  float*wsf=(float*)(shm+LDS_WS)+wid*64;
  const unsigned kdst=lds0+LDS_K+wid*1024, vdst=lds0+LDS_V+wid*1024;
  #define DMA_K(t,slot) glds16(ksrc+(long)(t)*KVBLK*KP,(unsigned)__builtin_amdgcn_readfirstlane(kdst+(slot)))
  #define DMA_V(t,slot) glds16(vsrc+(long)(t)*KVBLK*VP,(unsigned)__builtin_amdgcn_readfirstlane(vdst+(slot)))
  const int vb0=(int)(lds0+LDS_V)+((lane>>4)&1)*32+(lane&3)*8+(4*hi+((lane&15)>>2))*64;
  const char*Kbase=shm+LDS_K; bf16x8 kf[8];
  const lds_cptr shm3=(lds_cptr)shm; const lds_cptr kp0=shm3+LDS_K+hi*1024+r32*16; const lds_cptr vp0=shm3+LDS_V+((lane>>4)&1)*32+(lane&3)*8+(4*hi+((lane&15)>>2))*64;
  const int NTF=(q0+QB)/KVBLK;
  __attribute__((address_space(3))) float*cumL=(__attribute__((address_space(3))) float*)(shm3+LDS_CUM);
  if(newbh){ __attribute__((address_space(3))) float*wsum=(__attribute__((address_space(3))) float*)(shm3+LDS_WSUM);
    int tid_c=tid; asm volatile("":"+v"(tid_c));
    const float*lf=Cum+((long)b*NHEAD+h)*SEQ; f32x4_t x=*(const f32x4_t*)(lf+4*tid_c); x.y+=x.x; x.z+=x.y; x.w+=x.z;
    const float tot=x.w; float incl=tot;
    #pragma unroll
    for(int o=1;o<64;o<<=1){ const float t_=__shfl_up(incl,o); if(lane>=o)incl+=t_; }
    if(lane==63)wsum[wid]=incl;
    WAIT_BAR(0);
    float woff=0.f;
    #pragma unroll
    for(int w_=0;w_<NW;++w_){ const float t_=wsum[w_]; if(w_<wid)woff+=t_; }
    const float off=woff+incl-tot; x.x+=off; x.y+=off; x.z+=off; x.w+=off;
    *(__attribute__((address_space(3))) f32x4_t*)(cumL+4*tid_c)=x;
    WAIT_BAR(0); }
  const __attribute__((address_space(3))) float*cum=cumL; const float c0=cum[q0];
  int T0; { const float thr=2.f*Lq[8+h]+36.f; const int j_=lane; const bool pr_=(j_<NTF-4)&&(cum[(j_<NTF?j_:0)*KVBLK+63]-c0>thr);
    T0=(int)__builtin_amdgcn_readfirstlane(__builtin_popcountll(__ballot(pr_)))&~1; }
  const int NT=NTF-T0;
  const bf16*ksrc=Kh+(long)(T0*KVBLK+lane)*KP+wid*8;
  const bf16*vsrc=Vh+(long)(T0*KVBLK+16*(wid&3)+(lane>>2))*VP+(wid>>2)*32+(lane&3)*8;
  DMA_K(0,0);DMA_V(0,0);DMA_K(1,SLOTB);
  { __attribute__((address_space(3))) unsigned*kbw=(__attribute__((address_space(3))) unsigned*)(shm3+LDS_KB);
    for(int s=T0*KVBLK+tid;s<q0+QB;s+=NW*64){ const float v=c0-cum[s]; const unsigned vb=__float_as_uint(v); const unsigned hb=(vb+0x7fffu+((vb>>16)&1u))&0xffff0000u; const float lo=v-__uint_as_float(hb);
      const unsigned lb=__float_as_uint(lo); const unsigned lr=(lb+0x7fffu+((lb>>16)&1u))>>16; kbw[s]=(hb>>16)|(lr<<16); } }
  const float qbias=cum[q0+wid*QBLK+r32]-c0;
  const float lq=Lq[h];
  unsigned qw0=hi?0u:0x3f803f80u,qw1=0u,qw2=0u;
  #define SETNB(x_) do{ const float x0_=(x_); const unsigned a_=__float_as_uint(x0_); const unsigned h_=(a_+0x7fffu+((a_>>16)&1u))&0xffff0000u; const float r1_=x0_-__uint_as_float(h_); \
      const unsigned b_=__float_as_uint(r1_); const unsigned m_=(b_+0x7fffu+((b_>>16)&1u))&0xffff0000u; const float r2_=r1_-__uint_as_float(m_); const unsigned c_=__float_as_uint(r2_); const unsigned l_=(c_+0x7fffu+((c_>>16)&1u))>>16; \
      qw1=hi?0u:((h_>>16)|m_); qw2=hi?0u:l_; }while(0)
  #define QONE __builtin_bit_cast(bf16x8,(u32x4){qw0,qw1,qw2,0u})
  const __attribute__((address_space(3))) unsigned*kbp=(const __attribute__((address_space(3))) unsigned*)(shm3+LDS_KB)+r32+T0*KVBLK;
  #define KBF(t,half) __builtin_bit_cast(bf16x8,(u32x4){kbp[(t)*KVBLK+(half)*32],0x3f803f80u,0x00003f80u,0u})
  bf16x8 qr[4];
  #pragma unroll
  for(int d0=0;d0<4;++d0)qr[d0]=*reinterpret_cast<const bf16x8*>(&Qw[(long)r32*QP+d0*16+hi*8]);
  float mhat=0.f,l_reg=0.f;f32x16 o[2];o[0]=f32x16{};o[1]=f32x16{};SETNB(qbias);
  const int qrel=wid*QBLK+r32;
  #define CMASK(P0,P1,t) do{int jb_=(t)-(NT-4); if(jb_>=0)cmask(P0,P1,jb_,qrel,hi);}while(0)
  bool resc=false;
  #define START(P0,P1) do{ const float rm=rowmax(P0,P1); resc=false; \
    { const float dl=__builtin_fmaxf(rm,lq); mhat=fadd_s(mhat,dl); \
      _Pragma("unroll") for(int r=0;r<16;++r){P0[r]=fsub_s(P0[r],dl);P1[r]=fsub_s(P1[r],dl);} \
      SETNB(qbias-mhat); } \
    _Pragma("unroll") for(int r=0;r<16;++r)P0[r]=__builtin_amdgcn_exp2f(P0[r]); }while(0)
  #define RESC() do{ if(resc){ asm volatile("s_waitcnt lgkmcnt(0)":::"memory"); \
      _Pragma("unroll") for(int d_=0;d_<2;++d_) _Pragma("unroll") for(int r=0;r<16;++r)o[d_][r]*=wsf[crow(r,hi)]; } }while(0)
  f32x16 pA0,pA1,pB0,pB1;
  int sl_prev=0,sl_cur=0,sl_next=SLOTB;
  #define ROT() do{sl_prev=sl_cur;sl_cur=sl_next;sl_next=(sl_next==(NSLOT-1)*SLOTB)?0:sl_next+SLOTB;}while(0)
  DMA_K(2,2*SLOTB);
  WAIT_BAR(3);
  qkt(pA0,pA1,Kbase,qr,f32x16{},r32,hi,KBF(0,0),KBF(0,1),QONE);asm volatile("s_nop 15\n\ts_nop 7":"+v"(pA0),"+v"(pA1));CMASK(pA0,pA1,0);
  START(pA0,pA1);
  _Pragma("unroll") for(int r=0;r<16;++r)pA1[r]=__builtin_amdgcn_exp2f(pA1[r]);
  WAIT_BAR(0);
  DMA_K(3,0);DMA_V(1,SLOTB);
  ROT();
  kload8(kf,kp0+sl_cur);
  WAIT_BAR(2);
  s16x4 vlo[8],vhi[8]; u32x4 pw0,pw1,pw2,pw3;
  #define PKW(P,B) cvtpk_s(P[B],P[B+1])
  #define PAF(k) __builtin_bit_cast(bf16x8,pw##k)
  #define VFR(i) (bf16x8){vlo[i][0],vlo[i][1],vlo[i][2],vlo[i][3],vhi[i][0],vhi[i][1],vhi[i][2],vhi[i][3]}
  #define PIN(x) asm volatile("":"+v"(x))
  #define MX3(a,b,c) __builtin_fmaxf(__builtin_fmaxf((a),(b)),(c))
  #define GAPA(MF,A0,A1,A2,A3,W0,W1,PW) do{ MF; sacc+=A0; sacc+=A1; sacc+=A2; sacc+=A3; PIN(sacc); W0; W1; PIN(PW); SBAR(); }while(0)
  #define EX(v) __builtin_amdgcn_exp2f(v)
  #define GAPB(MF,X,B) do{ MF; X[B]=EX(X[B]); X[B+1]=EX(X[B+1]); X[B+2]=EX(X[B+2]); X[B+3]=EX(X[B+3]); PIN(X); SBAR(); }while(0)
  #define VRD(i) do{ vlo[i]=vtr(vp_+(((i)>>2)*4096+((i)&3)*1024)); vhi[i]=vtr(vp_+(((i)>>2)*4096+((i)&3)*1024+512)); }while(0)
  #define KRD(G,j) do{ if(G){ kload2(kf,kp0+sl_next,j); SBAR(); } }while(0)
  #define STEP(C0,C1,P0,P1,t,GK,GV,GL) do{ SBAR(); \
    const lds_cptr vp_=vp0+sl_prev; \
    { const bf16x8 kb0_=KBF(t,0),kb1_=KBF(t,1); const bf16x8 qo_=QONE; C0=__builtin_amdgcn_mfma_f32_32x32x16_bf16(kb0_,qo_,f32x16{},0,0,0); C1=__builtin_amdgcn_mfma_f32_32x32x16_bf16(kb1_,qo_,f32x16{},0,0,0); SBAR(); } \
    VRD(0); SBAR(); float sacc=(P0[0]+P0[1]); \
    GAPA(C0=__builtin_amdgcn_mfma_f32_32x32x16_bf16(kf[0],qr[0],C0,0,0,0), P0[2],P0[3],P0[4],P0[5],     pw0[0]=PKW(P0,0), pw0[1]=PKW(P0,2), pw0); \
    VRD(4); SBAR(); GAPA(C1=__builtin_amdgcn_mfma_f32_32x32x16_bf16(kf[1],qr[0],C1,0,0,0), P0[6],P0[7],P0[8],P0[9],     pw0[2]=PKW(P0,4), pw0[3]=PKW(P0,6), pw0); \
    VRD(1); SBAR(); GAPA(C0=__builtin_amdgcn_mfma_f32_32x32x16_bf16(kf[2],qr[1],C0,0,0,0),   P0[10],P0[11],P0[12],P0[13], pw1[0]=PKW(P0,8), pw1[1]=PKW(P0,10), pw1); \
    VRD(5); SBAR(); GAPA(C1=__builtin_amdgcn_mfma_f32_32x32x16_bf16(kf[3],qr[1],C1,0,0,0),   P0[14],P0[15],P1[0],P1[1],   pw1[2]=PKW(P0,12),pw1[3]=PKW(P0,14), pw1); \
    VRD(2); SBAR(); GAPA(C0=__builtin_amdgcn_mfma_f32_32x32x16_bf16(kf[4],qr[2],C0,0,0,0),   P1[2],P1[3],P1[4],P1[5],     pw2[0]=PKW(P1,0), pw2[1]=PKW(P1,2), pw2); \
    VRD(6); SBAR(); GAPA(C1=__builtin_amdgcn_mfma_f32_32x32x16_bf16(kf[5],qr[2],C1,0,0,0),   P1[6],P1[7],P1[8],P1[9],     pw2[2]=PKW(P1,4), pw2[3]=PKW(P1,6), pw2); \
    VRD(3); SBAR(); GAPA(C0=__builtin_amdgcn_mfma_f32_32x32x16_bf16(kf[6],qr[3],C0,0,0,0),   P1[10],P1[11],P1[12],P1[13], pw3[0]=PKW(P1,8), pw3[1]=PKW(P1,10), pw3); \
    VRD(7); SBAR(); GAPA(C1=__builtin_amdgcn_mfma_f32_32x32x16_bf16(kf[7],qr[3],C1,0,0,0),   P1[14],P1[15],0.f,0.f,       pw3[2]=PKW(P1,12),pw3[3]=PKW(P1,14), pw3); \
    l_reg+=sacc; \
    if(GK){DMA_K((t)+3,sl_cur);} if(GV){DMA_V((t)+1,sl_next);} \
    CMASK(C0,C1,t); \
    { float a=MX3(C0[0],C0[1],C1[0]),b=MX3(C0[2],C0[3],C1[1]); a=MX3(a,C1[2],C1[3]); \
      _Pragma("unroll") for(int r=4;r<16;r+=4){a=MX3(a,C0[r],C0[r+1]);b=MX3(b,C0[r+2],C0[r+3]);a=MX3(a,C1[r],C1[r+1]);b=MX3(b,C1[r+2],C1[r+3]);} \
      float rm=__builtin_fmaxf(a,b); { auto rr=__builtin_amdgcn_permlane32_swap(__float_as_uint(rm),__float_as_uint(rm),false,false); rm=__builtin_fmaxf(__uint_as_float(rr[0]),__uint_as_float(rr[1])); } \
      resc=false; \
      if(__builtin_expect(__any(rm>(float)THRL),0)){ const float dl=__builtin_fmaxf(rm,0.f); mhat+=dl; \
        _Pragma("unroll") for(int r=0;r<16;++r){C0[r]-=dl;C1[r]-=dl;} \
        SETNB(qbias-mhat); \
        const float f=__builtin_amdgcn_exp2f(-dl); l_reg*=f; if(hi==0)wsf[r32]=f; resc=true; } } \
    SBAR(); \
    GAPB(o[0]=__builtin_amdgcn_mfma_f32_32x32x16_bf16(PAF(0),VFR(0),o[0],0,0,0), C0,0); \
    GAPB(o[1]=__builtin_amdgcn_mfma_f32_32x32x16_bf16(PAF(0),VFR(4),o[1],0,0,0), C0,4); \
    KRD(GL,0); GAPB(o[0]=__builtin_amdgcn_mfma_f32_32x32x16_bf16(PAF(1),VFR(1),o[0],0,0,0), C0,8); \
    KRD(GL,1); GAPB(o[1]=__builtin_amdgcn_mfma_f32_32x32x16_bf16(PAF(1),VFR(5),o[1],0,0,0), C0,12); \
    KRD(GL,2); GAPB(o[0]=__builtin_amdgcn_mfma_f32_32x32x16_bf16(PAF(2),VFR(2),o[0],0,0,0), C1,0); \
    KRD(GL,3); GAPB(o[1]=__builtin_amdgcn_mfma_f32_32x32x16_bf16(PAF(2),VFR(6),o[1],0,0,0), C1,4); \
    GAPB(o[0]=__builtin_amdgcn_mfma_f32_32x32x16_bf16(PAF(3),VFR(3),o[0],0,0,0), C1,8); \
    GAPB(o[1]=__builtin_amdgcn_mfma_f32_32x32x16_bf16(PAF(3),VFR(7),o[1],0,0,0), C1,12); \
    }while(0)
  int t=1;
  #undef CMASK
  #define CMASK(P0,P1,t) do{}while(0)
  for(;t+5<NT;t+=2){
    STEP(pB0,pB1,pA0,pA1,t,true,true,true);     WAIT_BAR(2); RESC(); ROT();
    STEP(pA0,pA1,pB0,pB1,t+1,true,true,true);   WAIT_BAR(2); RESC(); ROT();
  }
  #undef CMASK
  #define CMASK(P0,P1,t) do{int jb_=(t)-(NT-4); if(jb_>=0)cmask(P0,P1,jb_,qrel,hi);}while(0)
  #define ENDW(tt) do{ if((tt)+3<NT){WAIT_BAR(2);} else if((tt)+2<NT){WAIT_BAR(1);} else {WAIT_BAR(0);} }while(0)
  for(;t+1<NT;t+=2){
    STEP(pB0,pB1,pA0,pA1,t,(t+3<NT),(t+1<NT),(t+1<NT));       ENDW(t);   RESC(); ROT();
    STEP(pA0,pA1,pB0,pB1,t+1,(t+4<NT),(t+2<NT),(t+2<NT));     ENDW(t+1); RESC(); ROT();
  }
  STEP(pB0,pB1,pA0,pA1,NT-1,false,false,false); RESC();
  { float sacc=pB0[0]+pB0[1]; _Pragma("unroll") for(int r=2;r<16;++r)sacc+=pB0[r]; _Pragma("unroll") for(int r=0;r<16;++r)sacc+=pB1[r]; l_reg+=sacc;
    pw0=(u32x4){PKW(pB0,0),PKW(pB0,2),PKW(pB0,4),PKW(pB0,6)};pw1=(u32x4){PKW(pB0,8),PKW(pB0,10),PKW(pB0,12),PKW(pB0,14)};pw2=(u32x4){PKW(pB1,0),PKW(pB1,2),PKW(pB1,4),PKW(pB1,6)};pw3=(u32x4){PKW(pB1,8),PKW(pB1,10),PKW(pB1,12),PKW(pB1,14)};
    SBAR(); pv(o,vb0+sl_cur,PAF(0),PAF(1),PAF(2),PAF(3)); }
  #undef PKW
  #undef PAF
  #undef VFR
  #undef PIN
  #undef MX3
  #undef GAPA
  #undef GAPB
  #undef EX
  #undef VRD
  #undef KRD
  #undef STEP
  #undef ENDW
  {auto rr=__builtin_amdgcn_permlane32_swap(__float_as_uint(l_reg),__float_as_uint(l_reg),false,false);l_reg=__uint_as_float(rr[0])+__uint_as_float(rr[1]);}
  if(hi==0)wsf[32+r32]=l_reg;asm volatile("s_waitcnt lgkmcnt(0)":::"memory");
  float rli[16];
  #pragma unroll
  for(int r=0;r<16;++r)rli[r]=__builtin_amdgcn_rcpf(wsf[32+crow(r,hi)]);
  bf16*Ow=O+(rowbase+q0+wid*QBLK)*OP+h*D;
  { bf16*stg=(bf16*)(shm+LDS_OST)+wid*2048;
    #pragma unroll
    for(int r=0;r<16;++r){const int orow=crow(r,hi);
      #pragma unroll
      for(int d0=0;d0<2;++d0)stg[orow*64+d0*32+r32]=__float2bfloat16(o[d0][r]*rli[r]);}
    asm volatile("s_waitcnt lgkmcnt(0)":::"memory");
    int lane_e=lane; asm volatile("":"+v"(lane_e));
    #pragma unroll
    for(int i=0;i<4;++i){const int row=i*8+(lane_e>>3),ch=lane_e&7; const u32x4 v=*(const u32x4*)(stg+row*64+ch*8); ATTN_STORE16(Ow+(long)row*OP+ch*8,v);} }
  asm volatile("s_waitcnt lgkmcnt(0)\n\ts_barrier":::"memory");
  #undef KBF
  #undef SETNB
  #undef QONE
  #undef DMA_K
  #undef DMA_V
  #undef CMASK
  #undef START
  #undef RESC
  #undef ROT
}
constexpr int ATTN_LDS_BYTES=LDS_BYTES;
struct AttnTensors { const bf16* Q; const bf16* K; const bf16* V; bf16* O; const float* Cum; const float* Lq; };
struct AttnUnit { int bh; int qb; };
struct StaticOrder {
  int a,na;
  __device__ __forceinline__ StaticOrder(int a_,int na_):a(a_),na(na_){}
  __device__ __forceinline__ bool next(int i,AttnUnit&u)const{ const int bh=a+(i/NQB)*na; if(a<0||bh>=BATCH*NHEAD)return false; u.bh=bh; u.qb=NQB-1-(i%NQB); return true; }
  __device__ __forceinline__ void a_ready(const AttnUnit&)const{}
  __device__ __forceinline__ void done(const AttnUnit&)const{}
};
template<class Sched,int THRL=16> __device__ __forceinline__ void attn_phase(char*lds,const AttnTensors&T,const Sched&S){
  AttnUnit u; int last_=-1;
  for(int i=0;S.next(i,u);++i){ S.a_ready(u); attn_unit<THRL>(u.bh/NHEAD,u.bh%NHEAD,u.qb,T.Q,T.K,T.V,T.O,T.Cum,T.Lq,u.bh!=last_,lds); last_=u.bh; S.done(u); }
}
#undef SBAR
#undef WAIT_BAR
}
constexpr int NWAVES = 8;
#ifndef MK_N_LAUNCHES
#define MK_N_LAUNCHES 1
#endif
constexpr int PER_PHASE = 9;
constexpr int N_LAUNCHES = MK_N_LAUNCHES;
static_assert(N_LAUNCHES == 1 || N_LAUNCHES == PER_PHASE, "MK_N_LAUNCHES is 1 or 9");

constexpr int BATCH = 16, T = 2048, D = 1024, HD = 64, FOXH = 8, RWKVH = 8, FF = 2816;
constexpr int M = BATCH * T;
constexpr int IN_COLS = 3368;
constexpr int NIN = 3584;
constexpr int PC_Q = 0, PC_K = 512, PC_V = 1024, PC_R = 1536, PC_RK = 2048, PC_RV = 2560, PC_WDN = 3072, PC_ADN = 3136, PC_GDN = 3200, PC_F = 3360;
constexpr int NGU = 2 * FF;
constexpr float RMS_EPS = 1e-6f, GN_EPS = 64e-5f, L2_EPS = 1e-12f;
constexpr float LOG2E = 1.4426950408889634f;

constexpr size_t MiB = 1u << 20, KiB = 1u << 10;
constexpr size_t WS_CTL = 0, CTL_ZERO_BYTES = 64 * KiB;
constexpr size_t WS_WIN = 1 * MiB, WS_WOUT = 8 * MiB, WS_WGU = 10 * MiB, WS_WDN = 21 * MiB;
constexpr size_t WS_W2T = 27 * MiB, WS_A2T = WS_W2T + 64 * KiB, WS_G2T = WS_A2T + 64 * KiB;
constexpr size_t WS_MOD = 27 * MiB + 512 * KiB;
constexpr size_t WS_LQ = 27 * MiB + 960 * KiB;
constexpr size_t WS_CUM = 28 * MiB;
constexpr size_t WS_XN = 32 * MiB;
constexpr size_t WS_QN = 96 * MiB, WS_KN = 128 * MiB;
constexpr size_t WS_X1 = WS_QN;
constexpr size_t WS_MIX = 160 * MiB;
constexpr size_t WS_P = 224 * MiB;
constexpr size_t WS_HH = WS_P;
constexpr size_t WS_SCR = 448 * MiB;
constexpr size_t WS_END = 452 * MiB;
static_assert(WS_WIN + (size_t)NIN * D * 2 <= WS_WOUT && WS_WGU + (size_t)NGU * D * 2 <= WS_WDN && WS_WDN + (size_t)D * FF * 2 <= WS_W2T && WS_G2T + 512 * 160 * 2 <= WS_MOD && WS_MOD + 16 * 6144 * 4 <= WS_LQ, "ws map");
static_assert(WS_P + (size_t)M * NIN * 2 <= WS_END && WS_HH + (size_t)M * FF * 2 <= WS_END, "ws map");
constexpr int CW_TMO = 0, CW_CODE = 1;
constexpr int CW_BAR = 4096;

constexpr int RING_OFF = 0, RING_BYTES = 162816;
constexpr int LDSCTL_OFF = RING_BYTES, MISC_OFF = LDSCTL_OFF + 320;
constexpr int LDS_BYTES = 163840;
static_assert(MISC_OFF + 128 <= LDS_BYTES, "LDS map");
#define GAS __attribute__((address_space(1)))
#define LAS __attribute__((address_space(3)))
typedef unsigned short bf16;
typedef unsigned v4u __attribute__((ext_vector_type(4)));
typedef float f32x4 __attribute__((ext_vector_type(4)));
typedef short bf16x8 __attribute__((ext_vector_type(8)));
typedef GAS unsigned gu32;
typedef GAS unsigned long long gu64;
#define RLX_AGENT __ATOMIC_RELAXED, __HIP_MEMORY_SCOPE_AGENT
#define LDS_WAIT() asm volatile("s_waitcnt lgkmcnt(0)" ::: "memory")
#define VM_WAIT() asm volatile("s_waitcnt vmcnt(0)" ::: "memory")
__device__ __forceinline__ unsigned long long rt() { return __builtin_amdgcn_s_memrealtime(); }
__device__ __forceinline__ unsigned f2bf(float f) { unsigned u = __builtin_bit_cast(unsigned, f); return (u + 0x7fffu + ((u >> 16) & 1u)) >> 16; }
typedef float pk2_f2_t __attribute__((ext_vector_type(2))); typedef __bf16 pk2_b2_t __attribute__((ext_vector_type(2)));
__device__ __forceinline__ unsigned pk2(float lo, float hi) { const pk2_f2_t v = {lo, hi}; const pk2_b2_t b = __builtin_convertvector(v, pk2_b2_t); return __builtin_bit_cast(unsigned, b); }

#define XB_TMO      128
#define XB_XCNT(j)  (256  + 64 * (j))
#define XB_XSUB(j)  (1280 + 64 * (j))
#define XB_XGEN(j)  (2304 + 64 * (j))
#define XB_TOP      3328
#define XB_TOPGEN   3392
#define XCD_BAR_WORDS 3456
#define XB_SPIN_CAP (1u << 18)

__device__ __forceinline__ unsigned xb_ld(unsigned* p)              { return __hip_atomic_load(p, __ATOMIC_RELAXED, __HIP_MEMORY_SCOPE_AGENT); }
__device__ __forceinline__ unsigned xb_add(unsigned* p, unsigned v) { return __hip_atomic_fetch_add(p, v, __ATOMIC_RELAXED, __HIP_MEMORY_SCOPE_AGENT); }
__device__ __forceinline__ unsigned xb_xcc_id() { return (unsigned)__builtin_amdgcn_s_getreg((3 << 11) | 20) & 0xFu; }
#define XB_SPIN(cond, bar) do { unsigned _sp = 0; while (cond) { __builtin_amdgcn_s_sleep(1); \
    if ((++_sp & 255u) == 0u) { if (xb_ld(&(bar)[XB_TMO])) break; if (_sp > XB_SPIN_CAP) { atomicAdd(&(bar)[XB_TMO], 1u); break; } } } } while (0)

struct XcdBarrier {
    unsigned* bar; unsigned x;
    volatile LAS unsigned* st;
};

__device__ __forceinline__ XcdBarrier xcd_barrier_post(unsigned* bar, volatile LAS unsigned* st) {
    XcdBarrier b; b.bar = bar; b.x = xb_xcc_id(); b.st = st;
    if (threadIdx.x == 0) (void)xb_add(&bar[XB_XCNT(b.x)], 1u);
    return b;
}
__device__ __forceinline__ void xcd_barrier_complete(unsigned* bar, unsigned x, unsigned& nloc, unsigned& nx) {
    const unsigned G = gridDim.x * gridDim.y * gridDim.z;
    unsigned sum, cnt, mine, sp = 0u;
    for (;;) {
        sum = 0u; cnt = 0u; mine = 0u;
#pragma unroll
        for (unsigned j = 0; j < 16; ++j) { const unsigned c = xb_ld(&bar[XB_XCNT(j)]); sum += c; cnt += (c > 0u) ? 1u : 0u; mine = (j == x) ? c : mine; }
        if (sum == G) break;
        __builtin_amdgcn_s_sleep(1);
        if ((++sp & 255u) == 0u) { if (xb_ld(&bar[XB_TMO])) break; if (sp > XB_SPIN_CAP) { atomicAdd(&bar[XB_TMO], 1u); break; } }
    }
    nloc = mine > 0u ? mine : 1u; nx = cnt > 0u ? cnt : 1u;
}

__device__ __forceinline__ void xcd_barrier(const XcdBarrier& b) {
    asm volatile("s_waitcnt vmcnt(0)" ::: "memory");
    __syncthreads();
    if (threadIdx.x == 0) {
        unsigned* bar = b.bar;
        __builtin_amdgcn_s_waitcnt(0);
        unsigned nloc = b.st[0], nx = b.st[1];
        if (nloc == 0u) { xcd_barrier_complete(bar, b.x, nloc, nx); b.st[0] = nloc; b.st[1] = nx; }
        const unsigned old = xb_add(&bar[XB_XSUB(b.x)], 1u);
        const unsigned gen = old / nloc;
        if (old + 1u == (gen + 1u) * nloc) {
            __builtin_amdgcn_fence(__ATOMIC_RELEASE, "agent");
            asm volatile("s_waitcnt vmcnt(0)" ::: "memory");
            const unsigned og = xb_add(&bar[XB_TOP], 1u);
            const unsigned tg = og / nx;
            if (og + 1u == (tg + 1u) * nx) xb_add(&bar[XB_TOPGEN], 1u);
            else XB_SPIN(xb_ld(&bar[XB_TOPGEN]) == tg, bar);
            __builtin_amdgcn_fence(__ATOMIC_ACQUIRE, "agent");
            xb_add(&bar[XB_XGEN(b.x)], 1u);
            asm volatile("s_waitcnt vmcnt(0)" ::: "memory");
        } else {
            if (old == gen * nloc || old == gen * nloc + (nloc >> 1)) { __builtin_amdgcn_fence(__ATOMIC_RELEASE, "agent"); asm volatile("s_waitcnt vmcnt(0)" ::: "memory"); }
            XB_SPIN(xb_ld(&bar[XB_XGEN(b.x)]) == gen, bar);
            __builtin_amdgcn_fence(__ATOMIC_ACQUIRE, "agent");
            asm volatile("s_waitcnt vmcnt(0)" ::: "memory");
        }
    }
    __syncthreads();
}
typedef float f32x2 __attribute__((ext_vector_type(2)));
typedef float f32x16 __attribute__((ext_vector_type(16)));
typedef unsigned v2u __attribute__((ext_vector_type(2)));
struct Frame {
    LAS unsigned char* lds;
    volatile LAS unsigned* MISC;
    gu32* ctl;
    int tid, lane, wave;
    int vcu, G;
    const float* in[25]; float* out; unsigned char* ws;
};
enum { I_X = 0, I_C, I_ADAW, I_ADAB, I_N1G, I_N2G, I_WIN, I_FBIAS, I_QG, I_KG, I_MU, I_W0, I_W2, I_A0, I_A2, I_G2, I_KK, I_KA, I_RK, I_LNG, I_LNB, I_WOUT, I_WG, I_WU, I_WD };

__device__ __forceinline__ float wave_sum(float v) {
#pragma unroll
    for (int o = 1; o < 64; o <<= 1) v += __shfl_xor(v, o);
    return v;
}
__device__ __forceinline__ float wave_max(float v) {
#pragma unroll
    for (int o = 1; o < 64; o <<= 1) v = fmaxf(v, __shfl_xor(v, o));
    return v;
}
template <int CTRL> __device__ __forceinline__ float dpp_f(float x) { return __int_as_float(__builtin_amdgcn_update_dpp(0, __float_as_int(x), CTRL, 0xf, 0xf, true)); }
__device__ __forceinline__ float red16(float x) {
    x += dpp_f<0xB1>(x);
    x += dpp_f<0x4E>(x);
    x += dpp_f<0x141>(x);
    x += dpp_f<0x140>(x);
    return x;
}
__device__ __forceinline__ float red8(float x) {
    x += dpp_f<0xB1>(x); x += dpp_f<0x4E>(x); x += dpp_f<0x141>(x); return x;
}
typedef __bf16 bf16x2_t __attribute__((ext_vector_type(2)));
__device__ __forceinline__ unsigned cvtpk(float lo, float hi) { const f32x2 v = {lo, hi}; const bf16x2_t b = __builtin_convertvector(v, bf16x2_t); return __builtin_bit_cast(unsigned, b); }
__device__ __forceinline__ float bf2f(unsigned short h) { return __uint_as_float((unsigned)h << 16); }
__device__ __forceinline__ float sigmoidf_(float x) { return __builtin_amdgcn_rcpf(1.0f + __builtin_amdgcn_exp2f(-LOG2E * x)); }
__device__ __forceinline__ float tanhf_(float x) { return 1.0f - 2.0f * __builtin_amdgcn_rcpf(1.0f + __builtin_amdgcn_exp2f(2.0f * LOG2E * x)); }

struct WItem { const float* W; bf16* WT; int K, N, ldk, kind, r; };
__device__ __forceinline__ int w_rowmap(int kind, int n) {
    if (kind == 0) return n;
    if (kind == 1) return n < 1536 ? n : (n < 1544 ? PC_F + (n - 1536) : (n - 1544) + PC_R);
    return (n >> 7) * 256 + (n & 127) + (kind - 2) * 128;
}
__device__ __forceinline__ void w_load(const WItem& a, int lane, float (&v)[64]) {
    const int nblk = (a.N + 63) / 64, kb = a.r / nblk, nb = a.r % nblk, nn = 64 * nb + lane, ncl = nn < a.N ? nn : a.N - 1;
    const float* src = a.W + ncl;
#pragma unroll
    for (int i = 0; i < 64; ++i) { const int k = 64 * kb + i; v[i] = *(const GAS float*)(src + (size_t)(k < a.K ? k : a.K - 1) * a.N); }
}
__device__ __forceinline__ void w_store(const WItem& a, const float (&v)[64], LAS float* scr, int lane) {
    const int nblk = (a.N + 63) / 64, kb = a.r / nblk, nb = a.r % nblk, k0 = 64 * kb, n0 = 64 * nb;
#pragma unroll
    for (int i = 0; i < 64; ++i) scr[i * 64 + (lane ^ (4 * ((i >> 3) & 7)))] = v[i];
    LDS_WAIT(); asm volatile("" ::: "memory");
    const int c = lane & 7;
#pragma unroll
    for (int j = 0; j < 8; ++j) { const int n = (lane >> 3) + 8 * j; const LAS float* s = scr + (8 * c) * 64 + (n ^ (4 * c));
        v4u o; o.x = pk2(s[0 * 64], s[1 * 64]); o.y = pk2(s[2 * 64], s[3 * 64]); o.z = pk2(s[4 * 64], s[5 * 64]); o.w = pk2(s[6 * 64], s[7 * 64]);
        if (n0 + n < a.N && k0 + 8 * c < a.K) *(GAS v4u*)(a.WT + (size_t)w_rowmap(a.kind, n0 + n) * a.ldk + k0 + 8 * c) = o; }
    LDS_WAIT(); asm volatile("" ::: "memory");
}

constexpr int WI_IN = (D / 64) * ((IN_COLS + 63) / 64), WI_L = 512 / 64, WI_LG = 3 * (512 / 64), WI_O = (D / 64) * (D / 64), WI_G = (D / 64) * (FF / 64), WI_D = (FF / 64) * (D / 64);
constexpr int WI_EARLY = WI_IN + 2 * WI_L + WI_LG, WI_ALL = WI_EARLY + WI_O + 2 * WI_G + WI_D;
__device__ __forceinline__ WItem w_decode(Frame& F, int it) { int r = it;
    if (r < WI_IN) return WItem{F.in[I_WIN], (bf16*)(F.ws + WS_WIN), D, IN_COLS, D, 1, r}; r -= WI_IN;
    if (r < WI_L) return WItem{F.in[I_W2], (bf16*)(F.ws + WS_W2T), 64, 512, 64, 0, r}; r -= WI_L;
    if (r < WI_L) return WItem{F.in[I_A2], (bf16*)(F.ws + WS_A2T), 64, 512, 64, 0, r}; r -= WI_L;
    if (r < WI_LG) return WItem{F.in[I_G2], (bf16*)(F.ws + WS_G2T), 160, 512, 160, 0, r}; r -= WI_LG;
    if (r < WI_O) return WItem{F.in[I_WOUT], (bf16*)(F.ws + WS_WOUT), D, D, D, 0, r}; r -= WI_O;
    if (r < WI_G) return WItem{F.in[I_WG], (bf16*)(F.ws + WS_WGU), D, FF, D, 2, r}; r -= WI_G;
    if (r < WI_G) return WItem{F.in[I_WU], (bf16*)(F.ws + WS_WGU), D, FF, D, 3, r}; r -= WI_G;
    return WItem{F.in[I_WD], (bf16*)(F.ws + WS_WDN), FF, D, FF, 0, r}; }

__device__ __forceinline__ void p0_prologue(Frame& F, const int probe) {
    LAS float* scr = (LAS float*)(F.lds + RING_OFF + F.wave * 16384);
    const int gw = F.vcu * NWAVES + F.wave, NGW = F.G * NWAVES;
    bf16* WIN = (bf16*)(F.ws + WS_WIN);
    bf16* W2T = (bf16*)(F.ws + WS_W2T); bf16* A2T = (bf16*)(F.ws + WS_A2T); bf16* G2T = (bf16*)(F.ws + WS_G2T);
    if (F.vcu < 6144 / 32 && !(probe & 256)) {
        LAS float* sc = (LAS float*)(F.lds + RING_OFF);
        LAS float* red = (LAS float*)(F.lds + RING_OFF + 65536);
        const float* cin = F.in[I_C];
        const int col = F.tid & 31, j0 = F.vcu * 32;
        const int cg = F.lane & 7, bg = (F.lane >> 3) & 3, kg = F.wave * 2 + (F.lane >> 5);
        const float* wp = F.in[I_ADAW] + (size_t)(kg * 64) * 6144 + j0 + 4 * cg;
        f32x4 cv[8], wa[16], wb[16], wc[16];
#pragma unroll
        for (int j = 0; j < 8; ++j) { const int idx = F.tid + NWAVES * 64 * j, k = idx & 1023, bq = idx >> 10;
#pragma unroll
            for (int e = 0; e < 4; ++e) cv[j][e] = cin[(4 * bq + e) * 1024 + k]; }
#pragma unroll
        for (int k = 0; k < 16; ++k) wa[k] = *(const GAS f32x4*)(wp + (size_t)k * 6144);
#pragma unroll
        for (int k = 0; k < 16; ++k) wb[k] = *(const GAS f32x4*)(wp + (size_t)(16 + k) * 6144);
#pragma unroll
        for (int k = 0; k < 16; ++k) wc[k] = *(const GAS f32x4*)(wp + (size_t)(32 + k) * 6144);
        __builtin_amdgcn_sched_barrier(0);
#pragma unroll
        for (int j = 0; j < 8; ++j) { const int idx = F.tid + NWAVES * 64 * j, k = idx & 1023, bq = idx >> 10; f32x4 sv;
#pragma unroll
            for (int e = 0; e < 4; ++e) sv[e] = cv[j][e] * sigmoidf_(cv[j][e]);
            *(LAS f32x4*)(sc + k * 16 + 4 * bq) = sv; }
        __syncthreads();
        f32x4 acc[4];
#pragma unroll
        for (int b = 0; b < 4; ++b) acc[b] = (f32x4){0.f, 0.f, 0.f, 0.f};
#define MOD_FMA(W_, K0_) do { _Pragma("unroll") for (int k = 0; k < 16; ++k) { const f32x4 s4 = *(const LAS f32x4*)(sc + (kg * 64 + (K0_) + k) * 16 + 4 * bg); \
            acc[0] += W_[k] * s4.x; acc[1] += W_[k] * s4.y; acc[2] += W_[k] * s4.z; acc[3] += W_[k] * s4.w; } } while (0)
        MOD_FMA(wa, 0);
        __builtin_amdgcn_sched_barrier(0);
#pragma unroll
        for (int k = 0; k < 16; ++k) wa[k] = *(const GAS f32x4*)(wp + (size_t)(48 + k) * 6144);
        __builtin_amdgcn_sched_barrier(0);
        MOD_FMA(wb, 16);
        MOD_FMA(wc, 32);
        MOD_FMA(wa, 48);
#undef MOD_FMA
#pragma unroll
        for (int b = 0; b < 4; ++b) *(LAS f32x4*)(red + (kg * 16 + 4 * bg + b) * 32 + 4 * cg) = acc[b];
        __syncthreads();
        { const int b = F.tid >> 5; float s = F.in[I_ADAB][j0 + col];
#pragma unroll
          for (int g = 0; g < 16; ++g) s += red[(g * 16 + b) * 32 + col];
          ((float*)(F.ws + WS_MOD))[b * 6144 + j0 + col] = s; }
        __syncthreads();
    }
    int it0, it1, st;
    if (F.G > 6144 / 32 + 8) { const int nmod = (6144 / 32) * NWAVES, nfree = (F.G - 6144 / 32) * NWAVES, na = 0;
        if (F.vcu < 6144 / 32) { it0 = gw; it1 = na; st = nmod; } else { it0 = na + gw - nmod; it1 = WI_EARLY; st = nfree; } }
    else { it0 = gw; it1 = WI_EARLY; st = NGW; }
    if (it0 < it1 && !(probe & 512)) { WItem a = w_decode(F, it0); float v[64]; w_load(a, F.lane, v);
        for (int it = it0;;) { const int nx = it + st; const bool more = nx < it1; WItem b = a; float vn[64];
#pragma unroll
            for (int i = 0; i < 64; ++i) vn[i] = v[i];
            if (more) { b = w_decode(F, nx); w_load(b, F.lane, vn); }
            __builtin_amdgcn_sched_barrier(0);
            w_store(a, v, scr, F.lane);
            if (!more) break;
            a = b; it = nx;
#pragma unroll
            for (int i = 0; i < 64; ++i) v[i] = vn[i]; } }
    { const int gt = F.vcu * NWAVES * 64 + F.tid, NGT = F.G * NWAVES * 64; GAS v4u* z = (GAS v4u*)(WIN + (size_t)IN_COLS * D);
      for (int i = gt; i < (NIN - IN_COLS) * D / 8; i += NGT) z[i] = (v4u){0u, 0u, 0u, 0u}; }
    if (gw < FOXH) { const float gq = wave_max(fabsf(F.in[I_QG][gw * 64 + F.lane])), gk = wave_max(fabsf(F.in[I_KG][gw * 64 + F.lane]));
        const float bh = 8.0f * gq * gk * LOG2E * 1.01f;
        if (F.lane == 0) { ((float*)(F.ws + WS_LQ))[gw] = fminf(0.f, 100.f - bh); ((float*)(F.ws + WS_LQ))[8 + gw] = bh; } }
}

template <bool IN_BF> __device__ __forceinline__ void xn_pass(Frame& F, const void* x, const float* gain, int shift_off, int scale_off) {
    const int gw = F.vcu * NWAVES + F.wave, NGW = F.G * NWAVES; const float* mod = (const float*)(F.ws + WS_MOD); bf16* XN = (bf16*)(F.ws + WS_XN);
    for (int m0 = 4 * gw; m0 < M; m0 += 4 * NGW) {
        f32x4 v[4][4]; float s[4];
        const int b = m0 >> 11; f32x4 cg_[4], csc_[4], csh_[4];
#pragma unroll
        for (int j = 0; j < 4; ++j) { const int c = 8 * F.lane + 512 * (j >> 1) + 4 * (j & 1); cg_[j] = *(const GAS f32x4*)(gain + c); csc_[j] = *(const GAS f32x4*)(mod + b * 6144 + scale_off + c); csh_[j] = *(const GAS f32x4*)(mod + b * 6144 + shift_off + c); }
#pragma unroll
        for (int q = 0; q < 4; ++q) {
            if (IN_BF) { const bf16* xr = (const bf16*)x + (size_t)(m0 + q) * D + 8 * F.lane; v4u raw[2];
#pragma unroll
                for (int jj = 0; jj < 2; ++jj) raw[jj] = *(const GAS v4u*)(xr + 512 * jj);
#pragma unroll
                for (int jj = 0; jj < 2; ++jj) {
                    v[q][2 * jj] = (f32x4){__builtin_bit_cast(float, raw[jj].x << 16), __builtin_bit_cast(float, raw[jj].x & 0xffff0000u), __builtin_bit_cast(float, raw[jj].y << 16), __builtin_bit_cast(float, raw[jj].y & 0xffff0000u)};
                    v[q][2 * jj + 1] = (f32x4){__builtin_bit_cast(float, raw[jj].z << 16), __builtin_bit_cast(float, raw[jj].z & 0xffff0000u), __builtin_bit_cast(float, raw[jj].w << 16), __builtin_bit_cast(float, raw[jj].w & 0xffff0000u)}; } }
            else { const float* xr = (const float*)x + (size_t)(m0 + q) * D + 8 * F.lane;
#pragma unroll
                for (int j = 0; j < 4; ++j) v[q][j] = *(const GAS f32x4*)(xr + 512 * (j >> 1) + 4 * (j & 1)); } }
        __builtin_amdgcn_sched_barrier(0);
#pragma unroll
        for (int q = 0; q < 4; ++q) { s[q] = 0.f;
#pragma unroll
            for (int j = 0; j < 4; ++j) s[q] += (v[q][j].x * v[q][j].x + v[q][j].y * v[q][j].y) + (v[q][j].z * v[q][j].z + v[q][j].w * v[q][j].w); }
#pragma unroll
        for (int o = 1; o < 64; o <<= 1) { s[0] += __shfl_xor(s[0], o); s[1] += __shfl_xor(s[1], o); s[2] += __shfl_xor(s[2], o); s[3] += __shfl_xor(s[3], o); }
#pragma unroll
        for (int q = 0; q < 4; ++q) s[q] = 1.0f / sqrtf(s[q] * (1.f / D) + RMS_EPS);
#pragma unroll
        for (int jj = 0; jj < 2; ++jj) { const f32x4 gs0 = cg_[2 * jj] * (csc_[2 * jj] + 1.0f), gs1 = cg_[2 * jj + 1] * (csc_[2 * jj + 1] + 1.0f);
#pragma unroll
            for (int q = 0; q < 4; ++q) { const f32x4 y0 = (v[q][2 * jj] * s[q]) * gs0 + csh_[2 * jj], y1 = (v[q][2 * jj + 1] * s[q]) * gs1 + csh_[2 * jj + 1];
                *(GAS v4u*)(XN + (size_t)(m0 + q) * D + 8 * F.lane + 512 * jj) = (v4u){pk2(y0.x, y0.y), pk2(y0.z, y0.w), pk2(y1.x, y1.y), pk2(y1.z, y1.w)}; } }
    }
}

template <int NWV> __device__ __forceinline__ void fox_prep_part(Frame& F, int b, int h, int wv, int tix) {
    const bf16* P = (const bf16*)(F.ws + WS_P); bf16* QN = (bf16*)(F.ws + WS_QN); bf16* KN = (bf16*)(F.ws + WS_KN);
    const int l8 = F.lane & 7, rsub = F.lane >> 3; const size_t rowb = (size_t)b * T;
    const float* qg = F.in[I_QG] + 64 * h + 8 * l8; const float* kg = F.in[I_KG] + 64 * h + 8 * l8;
    const f32x4 gq0 = *(const f32x4*)qg, gq1 = *(const f32x4*)(qg + 4), gk0 = *(const f32x4*)kg, gk1 = *(const f32x4*)(kg + 4);
    const float C2 = 0.125f * LOG2E; float* LF = (float*)(F.ws + WS_CUM) + ((size_t)b * FOXH + h) * T; const float fbias = F.in[I_FBIAS][h];
    constexpr int NTH = 64 * NWV, NFJ = (T + NTH - 1) / NTH;
    { unsigned short fz[NFJ];
#pragma unroll
      for (int j = 0; j < NFJ; ++j) { const int tk = tix + NTH * j; fz[j] = *(const GAS unsigned short*)(P + (rowb + ((T % NTH == 0 || tk < T) ? tk : T - 1)) * NIN + PC_F + h); }
      __builtin_amdgcn_sched_barrier(0);
#pragma unroll
      for (int j = 0; j < NFJ; ++j) { const int tk = tix + NTH * j; const float z = bf2f(fz[j]) + fbias;
          if (T % NTH == 0 || tk < T) LF[tk] = z < -30.f ? z * LOG2E : -__builtin_amdgcn_logf(1.0f + __builtin_amdgcn_exp2f(-LOG2E * z)); } }
    constexpr int NSTEP = T / 8, NB = (NSTEP + 8 * NWV - 1) / (8 * NWV);
    v4u qa[8], ka[8], qb[8], kb[8];
#define FP_LOAD(Q_, K_, j0_) do { _Pragma("unroll") for (int u = 0; u < 8; ++u) { const int s_ = wv + NWV * ((j0_) + u); const size_t row_ = rowb + 8 * ((NSTEP % (8 * NWV) == 0 || s_ < NSTEP) ? s_ : NSTEP - 1) + rsub; \
        Q_[u] = *(const GAS v4u*)(P + row_ * NIN + PC_Q + 64 * h + 8 * l8); K_[u] = *(const GAS v4u*)(P + row_ * NIN + PC_K + 64 * h + 8 * l8); } } while (0)
#define FP_CALC(Q_, K_, j0_) do { _Pragma("unroll") for (int u = 0; u < 8; ++u) { const int s_ = wv + NWV * ((j0_) + u); const size_t row = rowb + 8 * s_ + rsub; const v4u qw = Q_[u], kw = K_[u]; \
        float q[8], k[8]; const unsigned qq[4] = {qw.x, qw.y, qw.z, qw.w}, kk[4] = {kw.x, kw.y, kw.z, kw.w}; float sq = 0.f, sk = 0.f; \
        _Pragma("unroll") for (int i = 0; i < 8; ++i) { q[i] = bf2f((unsigned short)(qq[i >> 1] >> (16 * (i & 1)))); k[i] = bf2f((unsigned short)(kk[i >> 1] >> (16 * (i & 1)))); sq += q[i] * q[i]; sk += k[i] * k[i]; } \
        sq = red8(sq); sk = red8(sk); \
        const float rq = C2 * __builtin_amdgcn_rsqf(sq * (1.f / 64.f) + RMS_EPS), rk = __builtin_amdgcn_rsqf(sk * (1.f / 64.f) + RMS_EPS); \
        v4u oq, ok; \
        oq.x = pk2(q[0] * rq * gq0.x, q[1] * rq * gq0.y); oq.y = pk2(q[2] * rq * gq0.z, q[3] * rq * gq0.w); oq.z = pk2(q[4] * rq * gq1.x, q[5] * rq * gq1.y); oq.w = pk2(q[6] * rq * gq1.z, q[7] * rq * gq1.w); \
        ok.x = pk2(k[0] * rk * gk0.x, k[1] * rk * gk0.y); ok.y = pk2(k[2] * rk * gk0.z, k[3] * rk * gk0.w); ok.z = pk2(k[4] * rk * gk1.x, k[5] * rk * gk1.y); ok.w = pk2(k[6] * rk * gk1.z, k[7] * rk * gk1.w); \
        if (NSTEP % (8 * NWV) == 0 || s_ < NSTEP) { *(GAS v4u*)(QN + row * 512 + 64 * h + 8 * l8) = oq; *(GAS v4u*)(KN + row * 512 + 64 * h + 8 * l8) = ok; } } } while (0)
    FP_LOAD(qa, ka, 0);
    FP_LOAD(qb, kb, 8);  __builtin_amdgcn_sched_barrier(0);
    FP_CALC(qa, ka, 0);  __builtin_amdgcn_sched_barrier(0);
    FP_LOAD(qa, ka, 16); __builtin_amdgcn_sched_barrier(0);
    FP_CALC(qb, kb, 8);  __builtin_amdgcn_sched_barrier(0);
    FP_LOAD(qb, kb, 24); __builtin_amdgcn_sched_barrier(0);
    FP_CALC(qa, ka, 16); __builtin_amdgcn_sched_barrier(0);
    if (NB > 4) { FP_LOAD(qa, ka, 32); __builtin_amdgcn_sched_barrier(0); }
    FP_CALC(qb, kb, 24);
    if (NB > 4) { __builtin_amdgcn_sched_barrier(0); FP_CALC(qa, ka, 32); }
#undef FP_LOAD
#undef FP_CALC
}
__device__ __forceinline__ void fox_prep_bh(Frame& F, int b, int h) {
    fox_prep_part<NWAVES>(F, b, h, F.wave, F.tid);
    asm volatile("s_waitcnt vmcnt(0)" ::: "memory");
    __syncthreads();
}

namespace rwprep {
constexpr int ACT_ST = 592;
constexpr int LDT_ST = 2064, AT_ST = 1040;
constexpr int O_ACT = 0, O_LDT = 32 * ACT_ST, O_AT = O_LDT + 32 * LDT_ST, O_CST = O_AT + 32 * AT_ST, O_AIN = O_CST + 6 * 2048, O_W0A = O_AIN + 19 * 1024, O_MUD = O_W0A + 4096, PRE_BYTES = O_MUD + 1152;
static_assert(PRE_BYTES <= RING_BYTES, "pre-pass LDS");
__device__ __forceinline__ void up8(float (&o)[8], v4u w) { o[0] = bf2f((unsigned short)w.x); o[1] = bf2f((unsigned short)(w.x >> 16)); o[2] = bf2f((unsigned short)w.y); o[3] = bf2f((unsigned short)(w.y >> 16));
    o[4] = bf2f((unsigned short)w.z); o[5] = bf2f((unsigned short)(w.z >> 16)); o[6] = bf2f((unsigned short)w.w); o[7] = bf2f((unsigned short)(w.w >> 16)); }
__device__ __forceinline__ v4u pk8(const float (&x)[8]) { return (v4u){cvtpk(x[0], x[1]), cvtpk(x[2], x[3]), cvtpk(x[4], x[5]), cvtpk(x[6], x[7])}; }
__device__ __forceinline__ void run(Frame& F) {
    LAS unsigned char* L = F.lds + RING_OFF;
    const bf16* P = (const bf16*)(F.ws + WS_P); const float* mu = F.in[I_MU];
    unsigned char* IA = (unsigned char*)F.out; unsigned char* IB = IA + 32 * MiB; unsigned char* IK = IB + 32 * MiB; unsigned char* IR = IK + 32 * MiB;
    unsigned char* IV = F.ws + WS_XN; unsigned char* IG = IV + 32 * MiB; float* LCo = (float*)(F.ws + WS_SCR); float* BONo = LCo + 8192 * 64;
    const bf16* W2T = (const bf16*)(F.ws + WS_W2T); const bf16* A2T = (const bf16*)(F.ws + WS_A2T); const bf16* G2T = (const bf16*)(F.ws + WS_G2T);
    const int lane = F.lane, w = F.wave, hi = lane >> 5, r32 = lane & 31;
    const int rem = F.tid & 63, hd = rem >> 3, l8 = rem & 7, ch = hd * 64 + 8 * l8;
    { LAS float* cst = (LAS float*)(L + O_CST);
      cst[F.tid] = mu[F.tid]; cst[512 + F.tid] = mu[512 + F.tid]; cst[1024 + F.tid] = mu[1024 + F.tid]; cst[1536 + F.tid] = F.in[I_KK][F.tid]; cst[2048 + F.tid] = F.in[I_KA][F.tid]; cst[2560 + F.tid] = F.in[I_RK][F.tid];
      ((LAS float*)(L + O_W0A))[F.tid] = F.in[I_W0][F.tid]; ((LAS float*)(L + O_W0A))[512 + F.tid] = F.in[I_A0][F.tid]; if (F.tid < 288) ((LAS float*)(L + O_MUD))[F.tid] = mu[1536 + F.tid]; }
    const unsigned lds0 = (unsigned)(uintptr_t)L;
#define PRE_DMA(tile_) do { int ln_ = lane; asm volatile("" : "+v"(ln_)); _Pragma("unroll") for (int j_ = w; j_ < 19; j_ += 8) { int p_ = 64 * j_ + ln_; p_ = p_ < 33 * 36 ? p_ : 33 * 36 - 1; const int t1_ = p_ / 36, cg_ = p_ - 36 * t1_; \
        long rowi_ = (long)(tile_) * 32 + t1_ - 1; rowi_ = rowi_ < 0 ? 0 : rowi_; \
        attn_body::glds16(P + (size_t)rowi_ * NIN + PC_WDN + 8 * cg_, (unsigned)__builtin_amdgcn_readfirstlane(lds0 + O_AIN + 1024 * j_)); } } while (0)
    if (F.vcu < M / 32) PRE_DMA(F.vcu);
    asm volatile("s_waitcnt vmcnt(0)" ::: "memory");
    __syncthreads();
    for (int tile = F.vcu; tile < M / 32; tile += F.G) {
        const size_t row0 = (size_t)tile * 32; const int bb = tile >> 6, cc_ = tile & 63;
        if (tile != F.vcu) __syncthreads();
        { v4u ac[3], apv[3];
#pragma unroll
          for (int q = 0; q < 3; ++q) { const int g = F.tid + q * NWAVES * 64; if (g < 32 * 36) { const int t = g / 36; const bool hp = ((row0 + t) & (T - 1)) != 0;
                ac[q] = *(const LAS v4u*)(L + O_AIN + (g + 36) * 16); apv[q] = *(const LAS v4u*)(L + O_AIN + g * 16); if (!hp) apv[q] = (v4u){0u, 0u, 0u, 0u}; } }
#pragma unroll
          for (int q = 0; q < 3; ++q) { const int g = F.tid + q * NWAVES * 64; if (g < 32 * 36) { const int t = g / 36, cg = g - 36 * t;
                const f32x4 m0 = *(const LAS f32x4*)(L + O_MUD + 32 * cg), m1 = *(const LAS f32x4*)(L + O_MUD + 32 * cg + 16); const float mm[8] = {m0.x, m0.y, m0.z, m0.w, m1.x, m1.y, m1.z, m1.w};
                float xc[8], xp[8], x[8]; up8(xc, ac[q]); up8(xp, apv[q]);
#pragma unroll
                for (int i = 0; i < 8; ++i) x[i] = xc[i] + (xp[i] - xc[i]) * mm[i];
                if (cg < 8) {
#pragma unroll
                    for (int i = 0; i < 8; ++i) x[i] = tanhf_(x[i]);
                } else if (cg >= 16) {
#pragma unroll
                    for (int i = 0; i < 8; ++i) x[i] = sigmoidf_(x[i]);
                }
                *(LAS v4u*)(L + O_ACT + t * ACT_ST + 16 * cg) = pk8(x); } } }
        __syncthreads();
        if (tile + F.G < M / 32) PRE_DMA(tile + F.G);
        {
            int r32b = r32, hib = hi; asm volatile("" : "+v"(r32b), "+v"(hib));
            const LAS unsigned char* ap = L + O_ACT + r32b * ACT_ST + 16 * hib;
            unsigned char* gimg = IG + ((size_t)(bb * 8 + w) * 64 + cc_) * 4096 + r32b * 128;
            const bf16* wrow = W2T + (size_t)(64 * w + r32b) * 64 + 8 * hib; const bf16* arow = A2T + (size_t)(64 * w + r32b) * 64 + 8 * hib; const bf16* grow = G2T + (size_t)(64 * w + r32b) * 160 + 8 * hib;
            f32x16 aw[2] = {{}, {}}, aa[2] = {{}, {}};
            { bf16x8 bw[4][2], ba[4][2];
#pragma unroll
              for (int ks = 0; ks < 4; ++ks)
#pragma unroll
                  for (int cb = 0; cb < 2; ++cb) { bw[ks][cb] = *(const GAS bf16x8*)(wrow + cb * 32 * 64 + 16 * ks); ba[ks][cb] = *(const GAS bf16x8*)(arow + cb * 32 * 64 + 16 * ks); }
              __builtin_amdgcn_sched_barrier(0);
#pragma unroll
              for (int ks = 0; ks < 4; ++ks) { const bf16x8 fw = *(const LAS bf16x8*)(ap + 32 * ks), fa = *(const LAS bf16x8*)(ap + 128 + 32 * ks);
#pragma unroll
                  for (int cb = 0; cb < 2; ++cb) { aw[cb] = __builtin_amdgcn_mfma_f32_32x32x16_bf16(bw[ks][cb], fw, aw[cb], 0, 0, 0); aa[cb] = __builtin_amdgcn_mfma_f32_32x32x16_bf16(ba[ks][cb], fa, aa[cb], 0, 0, 0); } } }
            __builtin_amdgcn_sched_barrier(0);
            bf16x8 bga[5][2], bgb[5][2];
#pragma unroll
            for (int ks = 0; ks < 5; ++ks)
#pragma unroll
                for (int cb = 0; cb < 2; ++cb) bga[ks][cb] = *(const GAS bf16x8*)(grow + cb * 32 * 160 + 16 * ks);
            __builtin_amdgcn_sched_barrier(0);
#pragma unroll
            for (int cb = 0; cb < 2; ++cb) {
#pragma unroll
                for (int g = 0; g < 4; ++g) { const int c = 64 * w + 32 * cb + 8 * g + 4 * hib;
                    const f32x4 w0 = *(const LAS f32x4*)(L + O_W0A + c * 4), a0 = *(const LAS f32x4*)(L + O_W0A + 2048 + c * 4);
                    f32x4 ld; float ai[4];
#pragma unroll
                    for (int i = 0; i < 4; ++i) { ld[i] = -(0.6065306597126334f * LOG2E) * sigmoidf_(w0[i] + aw[cb][4 * g + i]); ai[i] = sigmoidf_(a0[i] + aa[cb][4 * g + i]); }
                    *(LAS f32x4*)(L + O_LDT + r32b * LDT_ST + c * 4) = ld;
                    *(LAS v2u*)(L + O_AT + r32b * AT_ST + c * 2) = (v2u){cvtpk(ai[0], ai[1]), cvtpk(ai[2], ai[3])}; }
                if (cb == 0) { __builtin_amdgcn_sched_barrier(0);
#pragma unroll
                    for (int ks = 0; ks < 5; ++ks)
#pragma unroll
                        for (int c2 = 0; c2 < 2; ++c2) bgb[ks][c2] = *(const GAS bf16x8*)(grow + c2 * 32 * 160 + 16 * (5 + ks));
                    __builtin_amdgcn_sched_barrier(0); } }
            __builtin_amdgcn_sched_barrier(0);
            { f32x16 ag[2] = {{}, {}};
#pragma unroll
              for (int ks = 0; ks < 10; ++ks) { const bf16x8 fg = *(const LAS bf16x8*)(ap + 256 + 32 * ks);
#pragma unroll
                  for (int cb = 0; cb < 2; ++cb) ag[cb] = __builtin_amdgcn_mfma_f32_32x32x16_bf16(ks < 5 ? bga[ks][cb] : bgb[ks - 5][cb], fg, ag[cb], 0, 0, 0); }
#pragma unroll
              for (int cb = 0; cb < 2; ++cb)
#pragma unroll
                  for (int g = 0; g < 4; ++g) { const int cl = 32 * cb + 8 * g + 4 * hib;
                      *(GAS v2u*)(gimg + cl * 2) = (v2u){cvtpk(ag[cb][4 * g], ag[cb][4 * g + 1]), cvtpk(ag[cb][4 * g + 2], ag[cb][4 * g + 3])}; } }
        }
        __syncthreads();
        const size_t blob = (size_t)(bb * 8 + hd) * 64 + cc_;
        v4u cur[4][3], prv[3];
        { const size_t rowa_ = row0 + 4 * (F.tid >> 6); const bool hp_ = (rowa_ & (T - 1)) != 0; const bf16* pr_ = P + rowa_ * NIN + ch; const bf16* pp_ = pr_ - (hp_ ? NIN : 0);
          prv[0] = *(const GAS v4u*)(pp_ + PC_R); prv[1] = *(const GAS v4u*)(pp_ + PC_RK); prv[2] = *(const GAS v4u*)(pp_ + PC_RV);
#pragma unroll
          for (int p_ = 0; p_ < 4; ++p_) { cur[p_][0] = *(const GAS v4u*)(pr_ + (size_t)p_ * NIN + PC_R); cur[p_][1] = *(const GAS v4u*)(pr_ + (size_t)p_ * NIN + PC_RK); cur[p_][2] = *(const GAS v4u*)(pr_ + (size_t)p_ * NIN + PC_RV); }
          if (!hp_) { prv[0] = (v4u){0u, 0u, 0u, 0u}; prv[1] = prv[0]; prv[2] = prv[0]; } }
        { LAS float* col = (LAS float*)(L + O_LDT) + F.tid; float x[32];
#pragma unroll
          for (int t = 0; t < 32; ++t) x[t] = col[t * (LDT_ST / 4)];
#pragma unroll
          for (int t = 1; t < 32; ++t) x[t] += x[t - 1];
#pragma unroll
          for (int t = 1; t < 32; ++t) col[t * (LDT_ST / 4)] = x[t]; }
        __syncthreads();
#define PRE_PASS(p_, PR_) do { const int t = 4 * (F.tid >> 6) + (p_); \
            float rc[8], rp[8], kc[8], kp[8], vc[8], vp[8], ai[8]; \
            up8(rc, cur[p_][0]); up8(kc, cur[p_][1]); up8(vc, cur[p_][2]); up8(rp, PR_[0]); up8(kp, PR_[1]); up8(vp, PR_[2]); \
            up8(ai, *(const LAS v4u*)(L + O_AT + t * AT_ST + ch * 2)); \
            const LAS float* lrow = (const LAS float*)(L + O_LDT + t * LDT_ST) + ch; \
            const f32x4 l0 = *(const LAS f32x4*)lrow, l1 = *(const LAS f32x4*)(lrow + 4); \
            f32x4 q0 = (f32x4){0.f, 0.f, 0.f, 0.f}, q1 = q0; if (t > 0) { q0 = *(const LAS f32x4*)(lrow - LDT_ST / 4); q1 = *(const LAS f32x4*)(lrow - LDT_ST / 4 + 4); } \
            const float lam[8] = {l0.x, l0.y, l0.z, l0.w, l1.x, l1.y, l1.z, l1.w}, lamp[8] = {q0.x, q0.y, q0.z, q0.w, q1.x, q1.y, q1.z, q1.w}; \
            float r[8], k[8], v[8], kkv[8]; float ss = 0.f; float mur[8], muk[8], muv[8], ckk[8], cka[8], crk[8]; \
            { const LAS float* c_ = (const LAS float*)(L + O_CST) + ch; _Pragma("unroll") for (int q_ = 0; q_ < 2; ++q_) { const f32x4 a_ = *(const LAS f32x4*)(c_ + 4 * q_), b_ = *(const LAS f32x4*)(c_ + 512 + 4 * q_), cc2_ = *(const LAS f32x4*)(c_ + 1024 + 4 * q_), d_ = *(const LAS f32x4*)(c_ + 1536 + 4 * q_), e_ = *(const LAS f32x4*)(c_ + 2048 + 4 * q_), f_ = *(const LAS f32x4*)(c_ + 2560 + 4 * q_); \
                _Pragma("unroll") for (int i = 0; i < 4; ++i) { mur[4 * q_ + i] = a_[i]; muk[4 * q_ + i] = b_[i]; muv[4 * q_ + i] = cc2_[i]; ckk[4 * q_ + i] = d_[i]; cka[4 * q_ + i] = e_[i]; crk[4 * q_ + i] = f_[i]; } } } \
            _Pragma("unroll") for (int i = 0; i < 8; ++i) { r[i] = rc[i] + (rp[i] - rc[i]) * mur[i]; k[i] = kc[i] + (kp[i] - kc[i]) * muk[i]; v[i] = vc[i] + (vp[i] - vc[i]) * muv[i]; kkv[i] = k[i] * ckk[i]; ss += kkv[i] * kkv[i]; } \
            ss = red8(ss); const float inv = __builtin_amdgcn_rsqf(fmaxf(ss, L2_EPS * L2_EPS)); \
            float al[8], be[8], ka[8], rh[8]; float bon = 0.f; \
            _Pragma("unroll") for (int i = 0; i < 8; ++i) { const float kn = kkv[i] * inv, k2 = k[i] * (1.0f + (ai[i] - 1.0f) * cka[i]); bon += r[i] * k2 * crk[i]; \
                const float g_ = __builtin_amdgcn_exp2f(lam[i]), gi = __builtin_amdgcn_exp2f(-lam[i]), gm1 = __builtin_amdgcn_exp2f(lamp[i]); \
                al[i] = -kn * gm1; be[i] = kn * ai[i] * gi; ka[i] = k2 * gi; rh[i] = r[i] * g_; } \
            bon = red8(bon); \
            const size_t o = blob * 4096 + t * 128 + l8 * 16; \
            *(GAS v4u*)(IA + o) = pk8(al); *(GAS v4u*)(IB + o) = pk8(be); *(GAS v4u*)(IK + o) = pk8(ka); *(GAS v4u*)(IR + o) = pk8(rh); *(GAS v4u*)(IV + o) = pk8(v); \
            if (l8 == 0) BONo[blob * 32 + t] = bon; \
            if (t == 31) { *(GAS f32x4*)(LCo + blob * 64 + 8 * l8) = l0; *(GAS f32x4*)(LCo + blob * 64 + 8 * l8 + 4) = l1; } } while (0)
        PRE_PASS(0, prv);
        PRE_PASS(1, cur[0]);
        PRE_PASS(2, cur[1]);
        PRE_PASS(3, cur[2]);
#undef PRE_PASS
#undef PRE_DMA
    }
}
}

namespace rwkv {
constexpr int TC = 32, NCH = T / TC;
constexpr int SCM = 72;
constexpr int I_A = 0, I_B = 4096, I_K = 8192, I_R = 12288, I_V = 16384, I_BP = 20480, I_KP = 24576, IMG_BYTES = 28672;
constexpr int O_TM = 0;
constexpr int O_S0 = O_TM + 3 * 32 * SCM;
constexpr int O_YS = O_S0 + 2 * 64 * 136;
constexpr int O_NAB = O_YS + 2 * 4096;
constexpr int O_LC = O_NAB + 2 * 32 * 144;
constexpr int O_INV = O_LC + 1024;
constexpr int O_IMG = O_INV + 512;
constexpr int L_BYTES = O_IMG + 4 * IMG_BYTES;
static_assert(L_BYTES <= RING_BYTES, "scan LDS");
__device__ __forceinline__ int crow(int r, int hi) { return (r & 3) + 8 * (r >> 2) + 4 * hi; }
__device__ __forceinline__ int swz(int row, int chunk) { return row * 128 + ((chunk ^ ((row >> 1) & 7)) << 4); }
__device__ __forceinline__ bf16x8 ld_tok(const LAS unsigned char* base, int row, int ks, int h) { return *(const LAS bf16x8*)(base + swz(row, 2 * ks + h)); }
__device__ __forceinline__ bf16x8 ld_perm(const LAS unsigned char* base, int stride, int row, int s, int h) {
    const v2u lo = *(const LAS v2u*)(base + row * stride + (16 * s + 4 * h) * 2), hi2 = *(const LAS v2u*)(base + row * stride + (16 * s + 8 + 4 * h) * 2);
    return __builtin_bit_cast(bf16x8, (v4u){lo.x, lo.y, hi2.x, hi2.y});
}
typedef short v4i16_t __attribute__((ext_vector_type(4)));
__device__ __forceinline__ v2u tr4(const LAS unsigned char* img, int blk, int tok0, int lane) {
    const LAS unsigned char* p = img + swz(tok0 + ((lane & 15) >> 2), 4 * blk + 2 * ((lane >> 4) & 1) + ((lane & 3) >> 1)) + 8 * (lane & 1);
    return __builtin_bit_cast(v2u, __builtin_amdgcn_ds_read_tr16_b64_v4i16((LAS v4i16_t*)p));
}
__device__ __forceinline__ bf16x8 ld_tr(const LAS unsigned char* img, int blk, int s, int lane) {
    const int h = lane >> 5; const v2u lo = tr4(img, blk, 16 * s + 4 * h, lane), hi2 = tr4(img, blk, 16 * s + 8 + 4 * h, lane);
    return __builtin_bit_cast(bf16x8, (v4u){lo.x, lo.y, hi2.x, hi2.y});
}
__device__ __forceinline__ bf16x8 acc_frag(const f32x16& x, int s) {
    return __builtin_bit_cast(bf16x8, (v4u){cvtpk(x[8 * s], x[8 * s + 1]), cvtpk(x[8 * s + 2], x[8 * s + 3]), cvtpk(x[8 * s + 4], x[8 * s + 5]), cvtpk(x[8 * s + 6], x[8 * s + 7])});
}
#define RW_MFMA(a, b, c) __builtin_amdgcn_mfma_f32_32x32x16_bf16(a, b, c, 0, 0, 0)
__device__ __forceinline__ f32x16 gram(const LAS unsigned char* X, const LAS unsigned char* Y, int r32, int h) {
    f32x16 acc = {};
#pragma unroll
    for (int ks = 0; ks < 4; ++ks) acc = RW_MFMA(ld_tok(X, r32, ks, h), ld_tok(Y, r32, ks, h), acc);
    return acc;
}
__device__ __forceinline__ void unpack4(float (&o)[4], v2u w) { o[0] = bf2f((unsigned short)w.x); o[1] = bf2f((unsigned short)(w.x >> 16)); o[2] = bf2f((unsigned short)w.y); o[3] = bf2f((unsigned short)(w.y >> 16)); }

template <int QHI, int QLO>
__device__ __forceinline__ void invert_quads(float (&tmh)[16], const LAS unsigned char* nabs, LAS unsigned char* tmout, int lane) {
    const int hi = lane >> 5, r32 = lane & 31;
    const LAS unsigned char* nrow0 = nabs; const LAS unsigned char* nrowh = nabs + 16 * hi; LAS unsigned char* tmo = tmout + 2 * r32;
#pragma unroll
    for (int Q = QHI; Q >= QLO; --Q) {
        float part[4] = {0.f, 0.f, 0.f, 0.f}; f32x4 wq[4];
#pragma unroll
        for (int rr_ = 0; rr_ < 4; ++rr_) wq[rr_] = *(const LAS f32x4*)(nrow0 + (4 * Q + rr_) * 144 + 16 * Q);
#pragma unroll
        for (int pp = ((Q + 1) >> 1); pp < 4; pp += 2) {
            f32x4 nq[4][2];
#pragma unroll
            for (int rr_ = 0; rr_ < 4; ++rr_)
#pragma unroll
                for (int d = 0; d < 2; ++d) if (pp + d < 4) nq[rr_][d] = *(const LAS f32x4*)(nrowh + (4 * Q + rr_) * 144 + 32 * (pp + d));
            __builtin_amdgcn_sched_barrier(0);
#pragma unroll
            for (int d = 0; d < 2; ++d) if (pp + d < 4)
#pragma unroll
                for (int rr_ = 0; rr_ < 4; ++rr_) { const f32x4 n4 = nq[rr_][d]; const int p = pp + d;
                    part[rr_] = fmaf(n4.x, tmh[4 * p], part[rr_]); part[rr_] = fmaf(n4.y, tmh[4 * p + 1], part[rr_]); part[rr_] = fmaf(n4.z, tmh[4 * p + 2], part[rr_]); part[rr_] = fmaf(n4.w, tmh[4 * p + 3], part[rr_]); }
            __builtin_amdgcn_sched_barrier(0);
        }
        float tot[4];
#pragma unroll
        for (int rr_ = 0; rr_ < 4; ++rr_) { const auto sw = __builtin_amdgcn_permlane32_swap(__float_as_uint(part[rr_]), __float_as_uint(part[rr_]), false, false);
            tot[rr_] = __uint_as_float(sw[0]) + __uint_as_float(sw[1]) + ((r32 == 4 * Q + rr_) ? 1.f : 0.f); }
        tot[2] = fmaf(wq[2].w, tot[3], tot[2]);
        tot[1] = fmaf(wq[1].z, tot[2], fmaf(wq[1].w, tot[3], tot[1]));
        tot[0] = fmaf(wq[0].y, tot[1], fmaf(wq[0].z, tot[2], fmaf(wq[0].w, tot[3], tot[0])));
        const bool own = (hi == (Q & 1));
#pragma unroll
        for (int rr_ = 0; rr_ < 4; ++rr_) { const int idx = 4 * (Q >> 1) + rr_; tmh[idx] = own ? tot[rr_] : tmh[idx];
            *(LAS unsigned short*)(tmo + (4 * Q + rr_) * SCM) = (unsigned short)(cvtpk(tot[rr_], tot[rr_]) & 0xffffu); }
        asm volatile("" ::: "memory");
    }
}
__device__ __forceinline__ void invert_first(float (&tmh)[16], const LAS unsigned char* img, LAS unsigned char* nabs, LAS unsigned char* tmout, int lane) {
    const int hi = lane >> 5, r32 = lane & 31;
    { f32x16 nab = gram(img + I_B, img + I_A, r32, hi);
#pragma unroll
      for (int q = 0; q < 16; ++q) *(LAS float*)(nabs + crow(q, hi) * 144 + 4 * r32) = (crow(q, hi) < r32) ? nab[q] : 0.f; }
    asm volatile("s_waitcnt lgkmcnt(0)" ::: "memory");
#pragma unroll
    for (int i = 0; i < 16; ++i) tmh[i] = 0.f;
    invert_quads<7, 4>(tmh, nabs, tmout, lane);
}
__device__ __forceinline__ void invert_second(float (&tmh)[16], const LAS unsigned char* nabs, LAS unsigned char* tmout, int lane) { invert_quads<3, 0>(tmh, nabs, tmout, lane); }

__device__ __forceinline__ void unit(Frame& F, int b, int h, int probe) {
    LAS unsigned char* L = F.lds + RING_OFF;
    bf16* MIX = (bf16*)(F.ws + WS_MIX);
    const unsigned char* IA = (const unsigned char*)F.out; const unsigned char* IV = F.ws + WS_XN; const unsigned char* IG = IV + 32 * MiB;
    const float* LCi = (const float*)(F.ws + WS_SCR); const float* BONi = LCi + 8192 * 64;
    const int lane = F.lane, w = F.wave, hi = lane >> 5, r32 = lane & 31;
    const size_t rowbase = (size_t)b * T; const size_t blob0 = (size_t)(b * 8 + h) * 64;
    int te = F.tid >> 4, cq = F.tid & 15, c0 = h * 64 + 4 * cq;
    if (F.tid < 128) ((LAS float*)(L + O_INV))[F.tid] = (F.tid < 64 ? F.in[I_LNG] : F.in[I_LNB])[h * 64 + (F.tid & 63)];
    for (int i = F.tid; i < 2 * 64 * 136 / 4; i += NWAVES * 64) ((LAS unsigned*)(L + O_S0))[i] = 0u;
    const unsigned lds0 = (unsigned)(uintptr_t)(F.lds + RING_OFF);
#define RW_DMA(c_, set_) do { int ln_ = lane; asm volatile("" : "+v"(ln_)); _Pragma("unroll") for (int j_ = w; j_ < 20; j_ += 8) { const int im_ = j_ >> 2, row_ = 8 * (j_ & 3) + (ln_ >> 3); \
        const unsigned char* src_ = (im_ < 4 ? IA + (size_t)im_ * (32 * MiB) : IV) + (blob0 + (c_)) * 4096 + row_ * 128 + (((ln_ & 7) ^ ((row_ >> 1) & 7)) << 4); \
        attn_body::glds16(src_, (unsigned)__builtin_amdgcn_readfirstlane(lds0 + O_IMG + (set_) * IMG_BYTES + im_ * 4096 + (j_ & 3) * 1024)); } } while (0)
#define RW_GEN(set_, lc4_) do { LAS unsigned char* is_ = L + O_IMG + (set_) * IMG_BYTES + swz(te, cq >> 1) + 8 * (cq & 1); float b4_[4], k4_[4]; unpack4(b4_, *(const LAS v2u*)(is_ + I_B)); unpack4(k4_, *(const LAS v2u*)(is_ + I_K)); \
        const float g0_ = __builtin_amdgcn_exp2f((lc4_).x), g1_ = __builtin_amdgcn_exp2f((lc4_).y), g2_ = __builtin_amdgcn_exp2f((lc4_).z), g3_ = __builtin_amdgcn_exp2f((lc4_).w); \
        *(LAS v2u*)(is_ + I_BP) = (v2u){cvtpk(b4_[0] * g0_, b4_[1] * g1_), cvtpk(b4_[2] * g2_, b4_[3] * g3_)}; *(LAS v2u*)(is_ + I_KP) = (v2u){cvtpk(k4_[0] * g0_, k4_[1] * g1_), cvtpk(k4_[2] * g2_, k4_[3] * g3_)}; \
        if (te == 0) *(LAS f32x4*)((LAS float*)(L + O_LC) + (set_) * 64 + 4 * cq) = (lc4_); } while (0)
    float tmh[16];
    RW_DMA(0, 0); RW_DMA(1, 1); RW_DMA(2, 2);
    f32x4 lcn = *(const GAS f32x4*)(LCi + blob0 * 64 + 4 * cq);
    asm volatile("s_waitcnt vmcnt(0)" ::: "memory");
    __syncthreads();
    RW_GEN(0, lcn);
    lcn = *(const GAS f32x4*)(LCi + (blob0 + 1) * 64 + 4 * cq);
    if (w == 0) { invert_first(tmh, L + O_IMG, L + O_NAB, L + O_TM, lane); invert_second(tmh, L + O_NAB, L + O_TM, lane); }
    else if (w == 3) invert_first(tmh, L + O_IMG + IMG_BYTES, L + O_NAB + 32 * 144, L + O_TM + 32 * SCM, lane);
    __syncthreads();
    v2u gst[2] = {(v2u){0u, 0u}, (v2u){0u, 0u}}, vst[2] = {(v2u){0u, 0u}, (v2u){0u, 0u}}; float bst[2] = {0.f, 0.f};
    int i3 = 0;
    asm volatile(".p2align 7\n\ts_nop 0\n\ts_nop 0\n\ts_nop 0\n\ts_nop 0\n\ts_nop 0");
    for (int c = 0; c <= NCH; ++c) {
        const int pb = c & 1, nb = pb ^ 1; const int i3n = (i3 == 2) ? 0 : i3 + 1, i3nn = (i3n == 2) ? 0 : i3n + 1;
        asm volatile("" : "+v"(te), "+v"(cq));  c0 = h * 64 + 4 * cq;
        if (c + 1 < NCH && c < NCH) RW_GEN((c + 1) & 3, lcn);
        if (c > 0 && w < 4 && !(probe & 16)) {
#pragma unroll
            for (int e = 0; e < 2; ++e) { const int tr = (te & 15) + 16 * e;
                f32x4 y; { float y_[4]; unpack4(y_, *(const LAS v2u*)(L + O_YS + nb * 4096 + tr * 128 + 8 * cq)); y = (f32x4){y_[0], y_[1], y_[2], y_[3]}; }
                const float mean = red16((y.x + y.y) + (y.z + y.w)) * (1.f / 64.f);
                const f32x4 dy = y - mean;
                const float var = red16((dy.x * dy.x + dy.y * dy.y) + (dy.z * dy.z + dy.w * dy.w)) * (1.f / 64.f);
                const float rstd = __builtin_amdgcn_rsqf(var + GN_EPS);
                float vv_[4], gg_[4]; unpack4(vv_, vst[e]); unpack4(gg_, gst[e]);
                const f32x4 lg4 = *(const LAS f32x4*)(L + O_INV + 16 * cq), lb4 = *(const LAS f32x4*)(L + O_INV + 256 + 16 * cq);
                const f32x4 o = ((dy * rstd) * lg4 + lb4 + (f32x4){vv_[0], vv_[1], vv_[2], vv_[3]} * bst[e]) * (f32x4){gg_[0], gg_[1], gg_[2], gg_[3]};
                if (!(probe & 12)) *(GAS v2u*)(MIX + (rowbase + (c - 1) * TC + tr) * 1024 + 512 + c0) = (v2u){cvtpk(o.x, o.y), cvtpk(o.z, o.w)}; }
        }
        if (c == NCH) break;
        if (c + 3 < NCH && !(probe & 32)) RW_DMA(c + 3, (c + 3) & 3);
        { const size_t bl = blob0 + c;
          if (w < 4) {
#pragma unroll
              for (int e = 0; e < 2; ++e) { const int tr = (te & 15) + 16 * e; gst[e] = *(const GAS v2u*)(IG + bl * 4096 + tr * 128 + 8 * cq); vst[e] = *(const GAS v2u*)(IV + bl * 4096 + tr * 128 + 8 * cq); bst[e] = BONi[bl * 32 + tr]; } }
          lcn = *(const GAS f32x4*)(LCi + (blob0 + (c + 2 < NCH ? c + 2 : c)) * 64 + 4 * cq); }
        const LAS unsigned char* img = L + O_IMG + (c & 3) * IMG_BYTES; const LAS unsigned char* tmc = L + O_TM + i3 * 32 * SCM;
        if ((w == 0 || w == 3) && (probe & 4)) {} else if (w == 0 || w == 3) {
            LAS unsigned char* nabw = L + O_NAB + (w == 3 ? 32 * 144 : 0);
            if ((w == 3) == ((c & 1) != 0)) { if (c + 2 < NCH) { asm volatile("s_waitcnt lgkmcnt(0)" ::: "memory"); invert_first(tmh, L + O_IMG + ((c + 2) & 3) * IMG_BYTES, nabw, L + O_TM + i3nn * 32 * SCM, lane); } }
            else { if (c + 1 < NCH) invert_second(tmh, nabw, L + O_TM + i3n * 32 * SCM, lane); }
        } else if ((w == 1 || w == 2) && !(probe & 8)) {
            const int vb = w - 1; int r32l = r32, hil = hi, lanel = lane; asm volatile("" : "+v"(r32l), "+v"(hil), "+v"(lanel));
            bf16x8 fB[4], fR[4], fK[4], fA[4], fT[2];
#pragma unroll
            for (int ks = 0; ks < 4; ++ks) { fB[ks] = ld_tok(img + I_B, r32l, ks, hil); fR[ks] = ld_tok(img + I_R, r32l, ks, hil); fK[ks] = ld_tok(img + I_K, r32l, ks, hil); fA[ks] = ld_tok(img + I_A, r32l, ks, hil); }
#pragma unroll
            for (int s_ = 0; s_ < 2; ++s_) fT[s_] = ld_perm(tmc, SCM, r32l, s_, hil);
            __builtin_amdgcn_sched_barrier(0);
            f32x16 t1 = {}, qy = {}, t2 = {};
#pragma unroll
            for (int ks = 0; ks < 4; ++ks) { t1 = RW_MFMA(fB[ks], fR[ks], t1); qy = RW_MFMA(fK[ks], fR[ks], qy); t2 = RW_MFMA(fA[ks], fK[ks], t2); }
            bf16x8 fV[2], fAt[2][2], fS[4]; v2u cR[2][4];
#pragma unroll
            for (int s_ = 0; s_ < 2; ++s_) { fV[s_] = ld_tr(img + I_V, vb, s_, lanel); fAt[0][s_] = ld_tr(img + I_A, 0, s_, lanel); fAt[1][s_] = ld_tr(img + I_A, 1, s_, lanel); }
#pragma unroll
            for (int s4 = 0; s4 < 4; ++s4) fS[s4] = ld_perm(L + O_S0 + pb * 64 * 136, 136, 32 * vb + r32l, s4, hil);
#pragma unroll
            for (int kb = 0; kb < 2; ++kb)
#pragma unroll
                for (int g = 0; g < 4; ++g) cR[kb][g] = *(const LAS v2u*)(img + I_R + swz(r32l, 4 * kb + g) + 8 * hil);
            __builtin_amdgcn_sched_barrier(0);
#pragma unroll
            for (int q = 0; q < 16; ++q) { const int cr_ = crow(q, hil); t1[q] = (cr_ <= r32l) ? t1[q] : 0.f; t2[q] = (r32l < cr_) ? t2[q] : 0.f; qy[q] = (cr_ <= r32l) ? qy[q] : 0.f; }
            f32x16 X = {};
#pragma unroll
            for (int s_ = 0; s_ < 2; ++s_) X = RW_MFMA(fT[s_], acc_frag(t1, s_), X);
#pragma unroll
            for (int s_ = 0; s_ < 2; ++s_) qy = RW_MFMA(acc_frag(t2, s_), acc_frag(X, s_), qy);
            f32x16 y = {};
#pragma unroll
            for (int kb = 0; kb < 2; ++kb) { f32x16 py;
#pragma unroll
                for (int g = 0; g < 4; ++g) { float c4[4]; unpack4(c4, cR[kb][g]); py[4 * g] = c4[0]; py[4 * g + 1] = c4[1]; py[4 * g + 2] = c4[2]; py[4 * g + 3] = c4[3]; }
#pragma unroll
                for (int s_ = 0; s_ < 2; ++s_) py = RW_MFMA(fAt[kb][s_], acc_frag(X, s_), py);
#pragma unroll
                for (int s_ = 0; s_ < 2; ++s_) y = RW_MFMA(fS[2 * kb + s_], acc_frag(py, s_), y); }
#pragma unroll
            for (int s_ = 0; s_ < 2; ++s_) y = RW_MFMA(fV[s_], acc_frag(qy, s_), y);
#pragma unroll
            for (int g = 0; g < 4; ++g) *(LAS v2u*)(L + O_YS + pb * 4096 + r32l * 128 + (32 * vb + 8 * g + 4 * hil) * 2) = (v2u){cvtpk(y[4 * g], y[4 * g + 1]), cvtpk(y[4 * g + 2], y[4 * g + 3])};
        } else if (w >= 4 && !(probe & 8)) {
            const int vb = (w >> 1) & 1, cb = w & 1; int r32l = r32, hil = hi, lanel = lane; asm volatile("" : "+v"(r32l), "+v"(hil), "+v"(lanel));
            bf16x8 fA[4], fK[4], fT[2], fBp[2], fV[2], fAt[2][2], fS[4]; v2u cK[4];
#pragma unroll
            for (int ks = 0; ks < 4; ++ks) { fA[ks] = ld_tok(img + I_A, r32l, ks, hil); fK[ks] = ld_tok(img + I_K, r32l, ks, hil); }
#pragma unroll
            for (int s_ = 0; s_ < 2; ++s_) { fT[s_] = ld_perm(tmc, SCM, r32l, s_, hil); fBp[s_] = ld_tr(img + I_BP, cb, s_, lanel); }
            __builtin_amdgcn_sched_barrier(0);
            f32x16 t2 = {}, Z = {};
#pragma unroll
            for (int ks = 0; ks < 4; ++ks) t2 = RW_MFMA(fA[ks], fK[ks], t2);
#pragma unroll
            for (int s_ = 0; s_ < 2; ++s_) Z = RW_MFMA(fT[s_], fBp[s_], Z);
#pragma unroll
            for (int s_ = 0; s_ < 2; ++s_) { fV[s_] = ld_tr(img + I_V, vb, s_, lanel); fAt[0][s_] = ld_tr(img + I_A, 0, s_, lanel); fAt[1][s_] = ld_tr(img + I_A, 1, s_, lanel); }
#pragma unroll
            for (int s4 = 0; s4 < 4; ++s4) fS[s4] = ld_perm(L + O_S0 + pb * 64 * 136, 136, 32 * vb + r32l, s4, hil);
#pragma unroll
            for (int g = 0; g < 4; ++g) cK[g] = tr4(img + I_KP, cb, 8 * g + 4 * hil, lanel);
            const float gC = __builtin_amdgcn_exp2f(((const LAS float*)(L + O_LC))[(c & 3) * 64 + 32 * cb + r32l]);
            __builtin_amdgcn_sched_barrier(0);
#pragma unroll
            for (int q = 0; q < 16; ++q) t2[q] = (r32l < crow(q, hil)) ? t2[q] : 0.f;
            f32x16 sres = {};
            { f32x16 hc;
#pragma unroll
              for (int g = 0; g < 4; ++g) { float c4[4]; unpack4(c4, cK[g]); hc[4 * g] = c4[0]; hc[4 * g + 1] = c4[1]; hc[4 * g + 2] = c4[2]; hc[4 * g + 3] = c4[3]; }
#pragma unroll
              for (int s_ = 0; s_ < 2; ++s_) hc = RW_MFMA(acc_frag(t2, s_), acc_frag(Z, s_), hc);
#pragma unroll
              for (int s_ = 0; s_ < 2; ++s_) sres = RW_MFMA(fV[s_], acc_frag(hc, s_), sres); }
#pragma unroll
            for (int kb = 0; kb < 2; ++kb) { f32x16 gc;
#pragma unroll
                for (int q = 0; q < 16; ++q) gc[q] = (kb == cb && crow(q, hil) == r32l) ? gC : 0.f;
#pragma unroll
                for (int s_ = 0; s_ < 2; ++s_) gc = RW_MFMA(fAt[kb][s_], acc_frag(Z, s_), gc);
#pragma unroll
                for (int s_ = 0; s_ < 2; ++s_) sres = RW_MFMA(fS[2 * kb + s_], acc_frag(gc, s_), sres); }
#pragma unroll
            for (int q = 0; q < 16; q += 2) { const unsigned pkd = cvtpk(sres[q], sres[q + 1]);
                *(LAS unsigned short*)(L + O_S0 + nb * 64 * 136 + (32 * vb + crow(q, hil)) * 136 + (32 * cb + r32l) * 2) = (unsigned short)(pkd & 0xffffu);
                *(LAS unsigned short*)(L + O_S0 + nb * 64 * 136 + (32 * vb + crow(q + 1, hil)) * 136 + (32 * cb + r32l) * 2) = (unsigned short)(pkd >> 16); }
        }
        i3 = i3n;
        if (w < 4) asm volatile("s_waitcnt vmcnt(7)" ::: "memory"); else asm volatile("s_waitcnt vmcnt(1)" ::: "memory");
        __syncthreads();
    }
#undef RW_DMA
#undef RW_GEN
#undef RW_MFMA
}
}

__device__ __forceinline__ void seam_weights(Frame& F, int seam) {
    if (seam == 2) {
        const int half = F.G >> 1;
        if (F.wave >= 1 && (F.vcu & 1) && F.vcu < 2 * half) { for (int bh = F.vcu >> 1; bh < BATCH * FOXH; bh += half) fox_prep_part<NWAVES - 1>(F, bh >> 3, bh & 7, F.wave - 1, F.tid - 64);
            asm volatile("s_waitcnt vmcnt(0)" ::: "memory"); }
        return; }
    const int it = WI_EARLY + seam * (F.G * (NWAVES - 1)) + F.vcu * (NWAVES - 1) + (F.wave - 1);
    if (F.wave >= 1 && it < WI_ALL) { LAS float* scr = (LAS float*)(F.lds + RING_OFF + F.wave * 16384);
        const WItem a = w_decode(F, it); float v[64]; w_load(a, F.lane, v); __builtin_amdgcn_sched_barrier(0); w_store(a, v, scr, F.lane); }
}
__device__ __forceinline__ void xcd_barrier_fill(const XcdBarrier& b, Frame& F, int seam) {
    asm volatile("s_waitcnt vmcnt(0)" ::: "memory");
    __syncthreads();
    if (threadIdx.x == 0) {
        unsigned* bar = b.bar;
        __builtin_amdgcn_s_waitcnt(0);
        unsigned nloc = b.st[0], nx = b.st[1];
        if (nloc == 0u) { xcd_barrier_complete(bar, b.x, nloc, nx); b.st[0] = nloc; b.st[1] = nx; }
        const unsigned old = xb_add(&bar[XB_XSUB(b.x)], 1u);
        const unsigned gen = old / nloc;
        if (old + 1u == (gen + 1u) * nloc) {
            __builtin_amdgcn_fence(__ATOMIC_RELEASE, "agent");
            asm volatile("s_waitcnt vmcnt(0)" ::: "memory");
            const unsigned og = xb_add(&bar[XB_TOP], 1u);
            const unsigned tg = og / nx;
            if (og + 1u == (tg + 1u) * nx) xb_add(&bar[XB_TOPGEN], 1u);
            else XB_SPIN(xb_ld(&bar[XB_TOPGEN]) == tg, bar);
            __builtin_amdgcn_fence(__ATOMIC_ACQUIRE, "agent");
            xb_add(&bar[XB_XGEN(b.x)], 1u);
            asm volatile("s_waitcnt vmcnt(0)" ::: "memory");
        } else {
            if (old == gen * nloc || old == gen * nloc + (nloc >> 1)) { __builtin_amdgcn_fence(__ATOMIC_RELEASE, "agent"); asm volatile("s_waitcnt vmcnt(0)" ::: "memory"); }
            XB_SPIN(xb_ld(&bar[XB_XGEN(b.x)]) == gen, bar);
            __builtin_amdgcn_fence(__ATOMIC_ACQUIRE, "agent");
            asm volatile("s_waitcnt vmcnt(0)" ::: "memory");
        }
    } else if (threadIdx.x >= 64) seam_weights(F, seam);
    __syncthreads();
}
#ifndef PROBE_REP
#define PROBE_REP 0
#endif
#ifndef PROBE_SKIP
#define PROBE_SKIP 0
#endif
#ifndef BAR_REP
#define BAR_REP 1
#endif
#ifndef PROBE_N
#define PROBE_N 1
#endif
struct Args { const float* in[25]; float* out; unsigned char* ws; int ph_lo, ph_hi, li, pad; };
__global__ void __launch_bounds__(NWAVES * 64, 2) skel_fwd(Args args) {
    extern __shared__ __attribute__((aligned(16))) unsigned char lds[];
    Frame F;
    F.lds = (LAS unsigned char*)lds;
    F.MISC = (volatile LAS unsigned*)(F.lds + MISC_OFF);
    F.tid = threadIdx.x; F.lane = F.tid & 63; F.wave = __builtin_amdgcn_readfirstlane(F.tid >> 6);
    F.G = gridDim.x; { const int bx = blockIdx.x; F.vcu = (F.G % 8 == 0) ? (bx % 8) * (F.G / 8) + bx / 8 : bx; }
#define GRID_BAR_FILL(seam, fs) do { if (BOTH(seam) && N_LAUNCHES != PER_PHASE) xcd_barrier_fill(bar, F, fs); else { __syncthreads(); seam_weights(F, fs); if (BOTH(seam)) GRID_BAR(seam); } } while (0)
#define GRID_BAR(seam) do { if (N_LAUNCHES == PER_PHASE) { if (F.tid == 0) __hip_atomic_store(F.ctl + CW_TMO, 0xBADBA0u | (unsigned)(seam), RLX_AGENT); } \
    else { for (int r_ = 0; r_ < BAR_REP; ++r_) xcd_barrier(bar); } } while (0)
    unsigned char* ws = args.ws; F.ws = ws;
    F.ctl = (gu32*)(ws + WS_CTL);
#pragma unroll
    for (int i = 0; i < 25; ++i) F.in[i] = args.in[i];
    F.out = args.out;
    for (int u = F.tid; u < (LDS_BYTES - LDSCTL_OFF) / 4; u += NWAVES * 64) ((LAS unsigned*)(F.lds + LDSCTL_OFF))[u] = 0u;
    __syncthreads();
    XcdBarrier bar; bar.bar = (unsigned*)(F.ctl + CW_BAR); bar.x = 0; bar.st = nullptr;
    if (N_LAUNCHES != PER_PHASE) bar = xcd_barrier_post((unsigned*)(F.ctl + CW_BAR), F.MISC + 8);

    const int lo = args.ph_lo, hi = args.ph_hi;
#define IN(k) (lo <= (k) && (k) < hi)
#define BOTH(k) (IN(k) && IN((k) + 1))
    const float* modp = (const float*)(ws + WS_MOD);

    if (IN(0)) { p0_prologue(F, args.pad); if (BOTH(0)) GRID_BAR(0); }
    if (IN(1)) { xn_pass<false>(F, F.in[I_X], F.in[I_N1G], 0, 1024); GRID_BAR_FILL(1, 0); }
    if (IN(2)) {
        pg8::Gemm g{(const bf16*)(ws + WS_XN), (const bf16*)(ws + WS_WIN), M, NIN, D}; pg8::StaticOrder S; S.init(M, NIN, F.G, (int)blockIdx.x);
        pg8::EpiBf16<0> E{(bf16*)(ws + WS_P), NIN, nullptr, 0, 0, 1.f};
        pg8::gemm_phase<pg8::EpiBf16<0>, pg8::StaticOrder, PG8_ALIGN, PG8_SP2>(F.lds + RING_OFF, g, S, E);
        GRID_BAR_FILL(2, 1);
    }
    if (IN(3)) { if (!(args.pad & 128)) rwprep::run(F); GRID_BAR_FILL(3, 2); }
    if (IN(4)) {
        const int half = F.G >> 1, me = F.vcu >> 1;
        if ((F.vcu & 1) == 0 && F.vcu < 2 * half) { if (!(args.pad & 1))
            for (int bh = me; bh < BATCH * RWKVH; bh += half) rwkv::unit(F, bh >> 3, bh & 7, args.pad);
        } else if (F.vcu < 2 * half && !(args.pad & 2)) {
            static_assert(attn_body::ATTN_LDS_BYTES <= RING_BYTES, "attention LDS");
            const attn_body::AttnTensors AT{(const attn_body::bf16*)(ws + WS_QN), (const attn_body::bf16*)(ws + WS_KN), (const attn_body::bf16*)(ws + WS_P) + PC_V, (attn_body::bf16*)(ws + WS_MIX),
                                            (const float*)(ws + WS_CUM), (const float*)(ws + WS_LQ)};
            const attn_body::StaticOrder S(me, half);
            attn_body::attn_phase<attn_body::StaticOrder>((char*)lds + RING_OFF, AT, S);
        }
        for (int it = WI_EARLY + 2 * F.G * (NWAVES - 1) + F.vcu * NWAVES + F.wave; it < WI_ALL; it += F.G * NWAVES) {
            LAS float* scr = (LAS float*)(F.lds + RING_OFF + F.wave * 16384); const WItem a = w_decode(F, it); float v[64]; w_load(a, F.lane, v); __builtin_amdgcn_sched_barrier(0); w_store(a, v, scr, F.lane); }
        if (BOTH(4)) GRID_BAR(4);
    }
    if (IN(5)) {
        pg8::Gemm g{(const bf16*)(ws + WS_MIX), (const bf16*)(ws + WS_WOUT), M, D, D}; pg8::StaticOrder S; S.init(M, D, F.G, (int)blockIdx.x);
        pg8::EpiResGate<false, true> E{F.in[I_X], ws + WS_X1, modp + 2048, D, 6144};
        pg8::gemm_phase<pg8::EpiResGate<false, true>, pg8::StaticOrder, PG8_ALIGN, PG8_SP2>(F.lds + RING_OFF, g, S, E);
        if (BOTH(5)) GRID_BAR(5);
    }
    if (IN(6)) { xn_pass<true>(F, ws + WS_X1, F.in[I_N2G], 3072, 4096); if (BOTH(6)) GRID_BAR(6); }
    if (IN(7)) {
        pg8::Gemm g{(const bf16*)(ws + WS_XN), (const bf16*)(ws + WS_WGU), M, NGU, D}; pg8::StaticOrder S; S.init(M, NGU, F.G, (int)blockIdx.x);
        pg8::EpiSwiGLU E{(bf16*)(ws + WS_HH), FF};
        pg8::gemm_phase<pg8::EpiSwiGLU, pg8::StaticOrder, PG8_ALIGN, PG8_SP2>(F.lds + RING_OFF, g, S, E);
        if (BOTH(7)) GRID_BAR(7);
    }
    if (IN(8)) {
        pg8::Gemm g{(const bf16*)(ws + WS_HH), (const bf16*)(ws + WS_WDN), M, D, FF}; pg8::StaticOrder S; S.init(M, D, F.G, (int)blockIdx.x);
        pg8::EpiResGate<true, false> E{ws + WS_X1, F.out, modp + 5120, D, 6144};
        pg8::gemm_phase<pg8::EpiResGate<true, false>, pg8::StaticOrder, PG8_ALIGN, PG8_SP2>(F.lds + RING_OFF, g, S, E);
    }
#undef IN
#undef BOTH
}

extern "C" void kernel_launch(void* const* d_in, const int* in_sizes, int n_in, void* d_out, int out_size, void* d_ws, size_t ws_size, hipStream_t stream) {
    static int grid = 0;
    if (grid == 0) {
        if (n_in != 25 || in_sizes[0] != M * D || out_size != M * D || ws_size < WS_END) { fprintf(stderr, "kernel_launch: unexpected shapes (n_in %d, in0 %d, out %d, ws %zu); nothing launched\n", n_in, n_in > 0 ? in_sizes[0] : -1, out_size, ws_size); grid = -1; return; }
        int dev = 0, cus = 0, per_cu = 0;
        if (hipGetDevice(&dev) != hipSuccess || hipDeviceGetAttribute(&cus, hipDeviceAttributeMultiprocessorCount, dev) != hipSuccess) { fprintf(stderr, "kernel_launch: device query failed\n"); grid = -1; return; }
        if (hipFuncSetAttribute((const void*)skel_fwd, hipFuncAttributeMaxDynamicSharedMemorySize, LDS_BYTES) != hipSuccess) { fprintf(stderr, "kernel_launch: hipFuncSetAttribute failed\n"); grid = -1; return; }
        if (hipOccupancyMaxActiveBlocksPerMultiprocessor(&per_cu, (const void*)skel_fwd, NWAVES * 64, LDS_BYTES) != hipSuccess || per_cu < 1)
            fprintf(stderr, "kernel_launch: note: occupancy query reports %d workgroups per CU\n", per_cu);
        (void)hipGetLastError();
        grid = cus;
    }
    if (grid < 0) return;
    if (hipMemsetAsync((char*)d_ws + WS_CTL, 0, CTL_ZERO_BYTES, stream) != hipSuccess) { fprintf(stderr, "kernel_launch: hipMemsetAsync failed\n"); return; }
    Args a{};
    for (int i = 0; i < 25; ++i) a.in[i] = (const float*)d_in[i];
    a.out = (float*)d_out; a.ws = (unsigned char*)d_ws;
#ifdef MK_SPLIT
    constexpr int NL_HOST = PER_PHASE;
#else
    constexpr int NL_HOST = N_LAUNCHES;
#endif
    for (int li = 0; li < NL_HOST; ++li) {
        a.ph_lo = (NL_HOST == PER_PHASE) ? li : 0; a.ph_hi = (NL_HOST == PER_PHASE) ? li + 1 : PER_PHASE; a.li = li;
        if (li > 0 && N_LAUNCHES != PER_PHASE) (void)hipMemsetAsync((char*)d_ws + WS_CTL, 0, CTL_ZERO_BYTES, stream);
        if (NL_HOST == PER_PHASE && ((PROBE_REP >> li) & 1)) { a.pad = PROBE_SKIP;
            for (int rep = 0; rep < PROBE_N; ++rep) { hipLaunchKernelGGL(skel_fwd, dim3(grid), dim3(NWAVES * 64), LDS_BYTES, stream, a); if (N_LAUNCHES != PER_PHASE) (void)hipMemsetAsync((char*)d_ws + WS_CTL, 0, CTL_ZERO_BYTES, stream); }
            a.pad = 0; }
        hipLaunchKernelGGL(skel_fwd, dim3(grid), dim3(NWAVES * 64), LDS_BYTES, stream, a);
        const hipError_t le = hipPeekAtLastError();
        if (le != hipSuccess) { fprintf(stderr, "kernel_launch: launch %d failed: %s\n", li, hipGetErrorName(le)); break; }
    }
}
```
